# Optimizing an MI355X kernel written in HIP

```python
import jax, jax.numpy as jnp
from jax import lax
import numpy as np

D_MODEL = 1024
BATCH = 2
SEQ = 8192
DEPTH = 4

GRID_W = 64
CTX_LEN = 256
EPS = 1e-6
ROPE_BASE = 10000.0

A_HEADS = 8
A_KV_HEADS = 2
A_HEAD_DIM = 64
A_WINDOW = 128
A_BLOCK = 128
A_Q = A_HEADS * A_HEAD_DIM
A_KV = A_KV_HEADS * A_HEAD_DIM
A_OUT = A_Q

B_HEADS = 8
B_Q_RANK = 256
B_KV_RANK = 128
B_NOPE_DIM = 64
B_ROPE_DIM = 32
B_V_DIM = 64
B_QBLOCK = 128
B_OUT = B_HEADS * B_V_DIM

C_HEADS = 4
C_KEY_DIM = 64
C_VAL_DIM = 128
C_GATE_RANK = 16
C_GATE_TAU = 16.0
C_CHUNK = 64
C_QK = C_HEADS * C_KEY_DIM
C_V = C_HEADS * C_VAL_DIM
C_OUT = C_V

FFN_DIM = 2816
CONV_W = 3

IN_DIM = A_Q + 2 * A_KV + B_Q_RANK + B_KV_RANK + B_ROPE_DIM + 2 * C_QK + 2 * C_V + 2 * C_GATE_RANK + 3 * D_MODEL

kernel_name = 'hybrid_dit_gqa_mla_gla_convffn'


def _rmsnorm(x, w):
    xf = x.astype(jnp.float32)
    y = xf * lax.rsqrt(jnp.mean(xf * xf, axis=-1, keepdims=True) + EPS)
    return (y * w.astype(jnp.float32)).astype(x.dtype)


def _rope_2d(n_tokens, rot_dim):
    rows = n_tokens // GRID_W
    row = jnp.broadcast_to(jnp.arange(rows)[:, None], (rows, GRID_W)).reshape(-1).astype(jnp.float32)
    col = jnp.broadcast_to(jnp.arange(GRID_W)[None, :], (rows, GRID_W)).reshape(-1).astype(jnp.float32)
    n_freq = rot_dim // 4
    inv = ROPE_BASE ** (-jnp.arange(n_freq, dtype=jnp.float32) / n_freq)
    ang = jnp.concatenate([row[:, None] * inv, col[:, None] * inv], axis=-1)
    return jnp.cos(ang), jnp.sin(ang)


def _apply_rope(t, cos, sin):
    half = t.shape[-1] // 2
    tf = t.astype(jnp.float32)
    t1, t2 = tf[..., :half], tf[..., half:]
    return jnp.concatenate([t1 * cos - t2 * sin, t1 * sin + t2 * cos], axis=-1).astype(t.dtype)


def _split_in(proj):
    sizes = [A_Q, A_KV, A_KV, B_Q_RANK, B_KV_RANK, B_ROPE_DIM, C_QK, C_QK, C_V, C_V, 2 * C_GATE_RANK]
    return jnp.split(proj, np.cumsum(sizes).tolist(), axis=-1)


def _sink_softmax(s, sink):
    m = jnp.maximum(jnp.max(s, axis=-1, keepdims=True), sink)
    p = jnp.exp(s - m)
    return p / (jnp.sum(p, axis=-1, keepdims=True) + jnp.exp(sink - m))


def _window_gqa(q, k, v, kc, vc, sink):
    B, S, Hq, Dh = q.shape
    Hkv = k.shape[2]
    G = Hq // Hkv
    nb = S // A_BLOCK
    scale = Dh ** -0.5
    qb = q.reshape(B, nb, A_BLOCK, Hkv, G, Dh)

    def band(t):
        tp = jnp.pad(t, ((0, 0), (A_BLOCK, A_BLOCK), (0, 0), (0, 0))).reshape(B, nb + 2, A_BLOCK, Hkv, Dh)
        return jnp.concatenate([tp[:, :-2], tp[:, 1:-1], tp[:, 2:]], axis=2)

    kb, vb = band(k), band(v)
    s_loc = jnp.einsum('bnqhgd,bnkhd->bnhgqk', qb, kb, preferred_element_type=jnp.float32) * scale
    s_ctx = jnp.einsum('bnqhgd,bkhd->bnhgqk', qb, kc, preferred_element_type=jnp.float32) * scale
    n_loc = 3 * A_BLOCK
    rel = jnp.arange(n_loc)[None, :] - A_BLOCK - jnp.arange(A_BLOCK)[:, None]
    kpos = jnp.arange(nb)[:, None] * A_BLOCK - A_BLOCK + jnp.arange(n_loc)[None, :]
    valid = (jnp.abs(rel) <= A_WINDOW)[None] & ((kpos >= 0) & (kpos < S))[:, None, :]
    s_loc = jnp.where(valid[None, :, None, None], s_loc, -jnp.inf)
    p = _sink_softmax(jnp.concatenate([s_loc, s_ctx], axis=-1),
                      sink.astype(jnp.float32).reshape(1, 1, Hkv, G, 1, 1)).astype(v.dtype)
    o = (jnp.einsum('bnhgqk,bnkhd->bnqhgd', p[..., :n_loc], vb)
         + jnp.einsum('bnhgqk,bkhd->bnqhgd', p[..., n_loc:], vc))
    return o.reshape(B, S, Hq * Dh)


def _ctx_gqa(qc, kc, vc, sink):
    B, L, Hq, Dh = qc.shape
    Hkv = kc.shape[2]
    G = Hq // Hkv
    q = qc.reshape(B, L, Hkv, G, Dh)
    s = jnp.einsum('bqhgd,bkhd->bhgqk', q, kc, preferred_element_type=jnp.float32) * (Dh ** -0.5)
    p = _sink_softmax(s, sink.astype(jnp.float32).reshape(1, Hkv, G, 1, 1)).astype(vc.dtype)
    return jnp.einsum('bhgqk,bkhd->bqhgd', p, vc).reshape(B, L, Hq * Dh)


def _mla_queries(cq, P):
    B, T, _ = cq.shape
    q = (_rmsnorm(cq, P['b_q_norm']) @ P['b_w_uq']).reshape(B, T, B_HEADS, B_NOPE_DIM + B_ROPE_DIM)
    return q[..., :B_NOPE_DIM], q[..., B_NOPE_DIM:]


def _mla_keys_values(ckv, P):
    B, T, _ = ckv.shape
    kv = (_rmsnorm(ckv, P['b_kv_norm']) @ P['b_w_ukv']).reshape(B, T, B_HEADS, B_NOPE_DIM + B_V_DIM)
    return kv[..., :B_NOPE_DIM], kv[..., B_NOPE_DIM:]


def _mla_attend(qn, qr, kn, kr, v):
    s = (jnp.einsum('bqhd,bkhd->bhqk', qn, kn, preferred_element_type=jnp.float32)
         + jnp.einsum('bqhd,bkd->bhqk', qr, kr, preferred_element_type=jnp.float32)) * ((B_NOPE_DIM + B_ROPE_DIM) ** -0.5)
    p = jax.nn.softmax(s, axis=-1).astype(v.dtype)
    return jnp.einsum('bhqk,bkhd->bqhd', p, v)


def _mla_latent(qn, qr, kn, kr, v, kn_c, kr_c, v_c):
    B, S, H, _ = qn.shape
    nb = S // B_QBLOCK
    keys_n = jnp.concatenate([kn_c, kn], axis=1)
    keys_r = jnp.concatenate([kr_c, kr], axis=1)
    vals = jnp.concatenate([v_c, v], axis=1)

    def to_blocks(t):
        return jnp.moveaxis(t.reshape(B, nb, B_QBLOCK, *t.shape[2:]), 1, 0)

    o = lax.map(lambda a: _mla_attend(a[0], a[1], keys_n, keys_r, vals), (to_blocks(qn), to_blocks(qr)))
    return jnp.moveaxis(o, 0, 1).reshape(B, S, H * B_V_DIM)


def _heads(t, H):
    B, T, _ = t.shape
    return t.reshape(B, T, H, -1).transpose(0, 2, 1, 3).astype(jnp.float32)


def _flip(t):
    return jnp.flip(t, axis=2)


def _gla_log_decay(g_low, P, d):
    logit = g_low @ P['c_w_gate'][d] + P['c_b_gate'][d]
    return _heads(jax.nn.log_sigmoid(logit.astype(jnp.float32)) / C_GATE_TAU, C_HEADS)


def _gla_scan(q, k, v, g, s0, with_out):
    B, H, T, _ = q.shape
    nc = T // C_CHUNK
    causal = jnp.tril(jnp.ones((C_CHUNK, C_CHUNK), dtype=bool))

    def chunks(t):
        return t.reshape(B, H, nc, C_CHUNK, t.shape[-1]).transpose(2, 0, 1, 3, 4)

    def step(state, inp):
        qc, kc, vc, gc = inp
        b = jnp.cumsum(gc, axis=-2)
        b_last = b[..., -1:, :]
        new_state = (jnp.exp(b_last)[..., 0, :, None] * state
                     + jnp.einsum('bhcd,bhce->bhde', kc * jnp.exp(b_last - b), vc))
        if not with_out:
            return new_state, None
        o_inter = jnp.einsum('bhcd,bhde->bhce', qc * jnp.exp(b), state)
        diff = b[..., :, None, :] - b[..., None, :, :]
        decay = jnp.exp(jnp.where(causal[:, :, None], diff, -jnp.inf))
        att = jnp.einsum('bhid,bhjd,bhijd->bhij', qc, kc, decay)
        return new_state, o_inter + jnp.einsum('bhij,bhje->bhie', att, vc)

    s_fin, o = lax.scan(step, s0, (chunks(q), chunks(k), chunks(v), chunks(g)))
    if with_out:
        o = o.transpose(1, 2, 0, 3, 4).reshape(B, H, T, v.shape[-1])
    return s_fin, o


def _gla_out(o, r, gain):
    B, H, T, dv = o.shape
    o = o.transpose(0, 2, 1, 3)
    o = o * lax.rsqrt(jnp.mean(o * o, axis=-1, keepdims=True) + EPS) * gain.astype(jnp.float32).reshape(H, dv)
    return (o.reshape(B, T, H * dv) * jax.nn.silu(r.astype(jnp.float32))).astype(r.dtype)


def _merge(ya, yb, yc, gate_logits, P):
    ga, gb, gc = jnp.split(jax.nn.sigmoid(gate_logits), 3, axis=-1)
    m = ga * (ya @ P['w_br_a']) + gb * (yb @ P['w_br_b']) + gc * (yc @ P['w_br_c'])
    return m @ P['w_out']


def _mixer(hl, hc, P, rope_a, rope_b, ctx_out):
    B, S, _ = hl.shape
    Lc = hc.shape[1]
    aq_l, ak_l, av_l, bq_l, bkv_l, bkr_l, cq_l, ck_l, cv_l, cr_l, cg_l, gate_l = _split_in(hl @ P['w_in'])
    aq_c, ak_c, av_c, bq_c, bkv_c, bkr_c, cq_c, ck_c, cv_c, cr_c, cg_c, gate_c = _split_in(hc @ P['w_in'])

    cos_a, sin_a = rope_a
    qa = _apply_rope(aq_l.reshape(B, S, A_HEADS, A_HEAD_DIM), cos_a[:, None], sin_a[:, None])
    ka = _apply_rope(ak_l.reshape(B, S, A_KV_HEADS, A_HEAD_DIM), cos_a[:, None], sin_a[:, None])
    va = av_l.reshape(B, S, A_KV_HEADS, A_HEAD_DIM)
    ka_c = ak_c.reshape(B, Lc, A_KV_HEADS, A_HEAD_DIM)
    va_c = av_c.reshape(B, Lc, A_KV_HEADS, A_HEAD_DIM)
    ya_l = _window_gqa(qa, ka, va, ka_c, va_c, P['a_sink'])

    cos_b, sin_b = rope_b
    qn_l, qr_l = _mla_queries(bq_l, P)
    qr_l = _apply_rope(qr_l, cos_b[:, None], sin_b[:, None])
    kn_l, vb_l = _mla_keys_values(bkv_l, P)
    kr_l = _apply_rope(bkr_l, cos_b, sin_b)
    kn_c, vb_c = _mla_keys_values(bkv_c, P)
    yb_l = _mla_latent(qn_l, qr_l, kn_l, kr_l, vb_l, kn_c, bkr_c, vb_c)

    qs = C_KEY_DIM ** -0.5
    q_l, k_l, v_l = _heads(cq_l, C_HEADS) * qs, _heads(ck_l, C_HEADS), _heads(cv_l, C_HEADS)
    q_c, k_c, v_c = _heads(cq_c, C_HEADS) * qs, _heads(ck_c, C_HEADS), _heads(cv_c, C_HEADS)
    gf_l = _gla_log_decay(cg_l[..., :C_GATE_RANK], P, 0)
    gb_l = _gla_log_decay(cg_l[..., C_GATE_RANK:], P, 1)
    gf_c = _gla_log_decay(cg_c[..., :C_GATE_RANK], P, 0)
    gb_c = _gla_log_decay(cg_c[..., C_GATE_RANK:], P, 1)
    s0 = jnp.zeros((B, C_HEADS, C_KEY_DIM, C_VAL_DIM), jnp.float32)
    sf_c, of_c = _gla_scan(q_c, k_c, v_c, gf_c, s0, ctx_out)
    sb_c, ob_c = _gla_scan(_flip(q_c), _flip(k_c), _flip(v_c), _flip(gb_c), s0, ctx_out)
    _, of_l = _gla_scan(q_l, k_l, v_l, gf_l, sf_c, True)
    _, ob_l = _gla_scan(_flip(q_l), _flip(k_l), _flip(v_l), _flip(gb_l), sb_c, True)
    yc_l = _gla_out(of_l + _flip(ob_l), cr_l, P['c_head_norm'])

    y_l = _merge(ya_l, yb_l, yc_l, gate_l, P)
    if not ctx_out:
        return y_l, None
    ya_c = _ctx_gqa(aq_c.reshape(B, Lc, A_HEADS, A_HEAD_DIM), ka_c, va_c, P['a_sink'])
    qn_c, qr_c = _mla_queries(bq_c, P)
    yb_c = _mla_attend(qn_c, qr_c, kn_c, bkr_c, vb_c).reshape(B, Lc, B_OUT)
    yc_c = _gla_out(of_c + _flip(ob_c), cr_c, P['c_head_norm'])
    y_c = _merge(ya_c, yb_c, yc_c, gate_c, P)
    return y_l, y_c


def _conv_ffn(h, P):
    u = h @ P['w_up']
    up = jnp.pad(u, ((0, 0), (1, 1), (0, 0)))
    cw = P['conv_w']
    u = up[:, :-2] * cw[0] + up[:, 1:-1] * cw[1] + up[:, 2:] * cw[2] + P['conv_b']
    g, val = jnp.split(u, 2, axis=-1)
    return (jax.nn.silu(g) * val) @ P['w_down']


def _layer(xl, xc, mod_l, mod_c, P, rope_a, rope_b, ctx_out):
    sh1, sc1, g1, sh2, sc2, g2 = jnp.split(mod_l, 6, axis=-1)
    csh1, csc1, cg1, csh2, csc2, cg2 = jnp.split(mod_c, 6, axis=-1)
    hl = _rmsnorm(xl, P['norm_mix']) * (1 + sc1) + sh1
    hc = _rmsnorm(xc, P['norm_mix']) * (1 + csc1) + csh1
    y_l, y_c = _mixer(hl, hc, P, rope_a, rope_b, ctx_out)
    xl = xl + g1 * y_l
    xl = xl + g2 * _conv_ffn(_rmsnorm(xl, P['norm_ffn']) * (1 + sc2) + sh2, P)
    if ctx_out:
        xc = xc + cg1 * y_c
        xc = xc + cg2 * _conv_ffn(_rmsnorm(xc, P['norm_ffn']) * (1 + csc2) + csh2, P)
    return xl, xc


def setup_inputs(seed: int = 0) -> dict:
    key = jax.random.key(seed)
    ks = jax.random.split(key, 28)
    L, D = DEPTH, D_MODEL

    def nrm(k, shape, scale):
        return jax.random.normal(k, shape, jnp.float32) * scale

    def gain(k, shape):
        return 1.0 + 0.1 * jax.random.normal(k, shape, jnp.float32)

    return {
        'x': nrm(ks[0], (BATCH, SEQ, D), 1.0),
        'c': nrm(ks[1], (BATCH, D), 1.0),
        'ctx': nrm(ks[2], (BATCH, CTX_LEN, D), 1.0),
        'c_ctx': nrm(ks[3], (D,), 1.0),
        'w_mod': nrm(ks[4], (L, D, 6 * D), 0.5 * D ** -0.5),
        'b_mod': nrm(ks[5], (L, 6 * D), 0.02),
        'norm_mix': gain(ks[6], (L, D)),
        'norm_ffn': gain(ks[7], (L, D)),
        'w_in': nrm(ks[8], (L, D, IN_DIM), D ** -0.5),
        'a_sink': nrm(ks[9], (L, A_HEADS), 0.5),
        'b_q_norm': gain(ks[10], (L, B_Q_RANK)),
        'b_kv_norm': gain(ks[11], (L, B_KV_RANK)),
        'b_w_uq': nrm(ks[12], (L, B_Q_RANK, B_HEADS * (B_NOPE_DIM + B_ROPE_DIM)), B_Q_RANK ** -0.5),
        'b_w_ukv': nrm(ks[13], (L, B_KV_RANK, B_HEADS * (B_NOPE_DIM + B_V_DIM)), B_KV_RANK ** -0.5),
        'c_w_gate': nrm(ks[14], (L, 2, C_GATE_RANK, C_QK), C_GATE_RANK ** -0.5),
        'c_b_gate': nrm(ks[15], (L, 2, C_QK), 0.02),
        'c_head_norm': gain(ks[16], (L, C_V)),
        'w_br_a': nrm(ks[17], (L, A_OUT, D), A_OUT ** -0.5),
        'w_br_b': nrm(ks[18], (L, B_OUT, D), B_OUT ** -0.5),
        'w_br_c': nrm(ks[19], (L, C_OUT, D), C_OUT ** -0.5),
        'w_out': nrm(ks[20], (L, D, D), D ** -0.5),
        'w_up': nrm(ks[21], (L, D, 2 * FFN_DIM), D ** -0.5),
        'conv_w': nrm(ks[22], (L, CONV_W, 2 * FFN_DIM), CONV_W ** -0.5),
        'conv_b': nrm(ks[23], (L, 2 * FFN_DIM), 0.02),
        'w_down': nrm(ks[24], (L, FFN_DIM, D), FFN_DIM ** -0.5),
        'final_norm': gain(ks[25], (D,)),
    }


def reference(x, c, ctx, c_ctx, w_mod, b_mod, norm_mix, norm_ffn, w_in, a_sink, b_q_norm, b_kv_norm,
              b_w_uq, b_w_ukv, c_w_gate, c_b_gate, c_head_norm, w_br_a, w_br_b, w_br_c, w_out,
              w_up, conv_w, conv_b, w_down, final_norm):
    S = x.shape[1]
    rope_a = _rope_2d(S, A_HEAD_DIM)
    rope_b = _rope_2d(S, B_ROPE_DIM)
    silu_c = jax.nn.silu(c)
    silu_cc = jax.nn.silu(c_ctx)
    xl, xc = x, ctx
    for l in range(DEPTH):
        P = {'norm_mix': norm_mix[l], 'norm_ffn': norm_ffn[l], 'w_in': w_in[l], 'a_sink': a_sink[l],
             'b_q_norm': b_q_norm[l], 'b_kv_norm': b_kv_norm[l], 'b_w_uq': b_w_uq[l], 'b_w_ukv': b_w_ukv[l],
             'c_w_gate': c_w_gate[l], 'c_b_gate': c_b_gate[l], 'c_head_norm': c_head_norm[l],
             'w_br_a': w_br_a[l], 'w_br_b': w_br_b[l], 'w_br_c': w_br_c[l], 'w_out': w_out[l],
             'w_up': w_up[l], 'conv_w': conv_w[l], 'conv_b': conv_b[l], 'w_down': w_down[l]}
        mod_l = (silu_c @ w_mod[l] + b_mod[l])[:, None, :]
        mod_c = (silu_cc @ w_mod[l] + b_mod[l])[None, None, :]
        xl, xc = _layer(xl, xc, mod_l, mod_c, P, rope_a, rope_b, l < DEPTH - 1)
    return _rmsnorm(xl, final_norm)
```

```cpp
#include <hip/hip_runtime.h>
#include <hip/hip_cooperative_groups.h>
#include <cstdio>
#include <cstdint>
namespace cg = cooperative_groups;
#ifndef ONE_LAUNCH
#define ONE_LAUNCH 1
#endif
namespace pg8 {
#define PG8_LAS __attribute__((address_space(3)))
typedef unsigned short bf16_t;
typedef short bf16x8 __attribute__((ext_vector_type(8)));
typedef float f32x4 __attribute__((ext_vector_type(4)));
typedef unsigned u32x4 __attribute__((ext_vector_type(4)));
constexpr int BM = 256, BK = 64, HALF = 128, HTB = HALF * BK * 2  , STAGE_BYTES = 8 * HTB, NXCD = 8, WGM = 8;

__host__ __device__ __forceinline__ int lds_byte(int r, int c) { const int st = (r >> 4) * 2 + (c >> 5), rr = r & 15, cc = c & 31, ob = rr * 64 + cc * 2; return st * 1024 + (ob ^ (((ob >> 9) & 1) << 5)); }
__host__ __device__ __forceinline__ void stage_rc(int b, int& R, int& C) { const int st = b / 1024, sb = b % 1024, swz = sb ^ (((sb >> 9) & 1) << 5); R = (st >> 1) * 16 + swz / 64; C = (st & 1) * 32 + (swz % 64) / 2; }
__host__ __device__ __forceinline__ int perm32(int rho) { const int n = rho >> 4, i = rho & 15; return 8 * (i >> 2) + 4 * n + (i & 3); }

struct Unit { int pm, pn, kb; };
struct Gemm { const bf16_t* A; const bf16_t* Bt; int M, N, K, Kloop; };

struct StaticOrder {
    int nM, nN, nwg, G, c;
    __host__ __device__ void init(int M, int N, int G_, int c_) { nM = M / BM; nN = N / BM; nwg = nM * nN; G = G_; c = c_; }
    __host__ __device__ bool next(int i, Unit& u) const {
        const long L = (long)i * G + c; if (L >= nwg) return false;
        int wgid = (int)L; { const int q = nwg / NXCD, r = nwg % NXCD, xcd = wgid % NXCD, off = wgid / NXCD; wgid = (xcd < r ? xcd * (q + 1) : r * (q + 1) + (xcd - r) * q) + off; }
        const int nig = WGM * nN, gid = wgid / nig, fm = gid * WGM, gsz = (nM - fm) < WGM ? (nM - fm) : WGM;
        u.pm = fm + ((wgid % nig) % gsz); u.pn = (wgid % nig) / gsz; u.kb = 0; return true;
    }
    __device__ __forceinline__ void a_ready(const Unit&) const {}
    __device__ __forceinline__ void done(const Unit&) const {}
};

__device__ __forceinline__ unsigned cvt_pk_bf16(float lo, float hi) { unsigned r; asm volatile("v_cvt_pk_bf16_f32 %0, %1, %2" : "=v"(r) : "v"(lo), "v"(hi)); return r; }
template <class Epi, class Sched, bool ALIGN_EPI = false, bool SP2 = false>
__device__ __forceinline__ void gemm_phase(PG8_LAS unsigned char* lds, const Gemm g, const Sched& S, const Epi& E) {
    int tid_ = threadIdx.x; asm volatile("" : "+v"(tid_));
    const int tid = tid_, wid = __builtin_amdgcn_readfirstlane(tid >> 6), lane = tid & 63, wr = wid >> 2, wc = wid & 3, fr = lane & 15, fq = lane >> 4;
    const int K = g.K, nt = g.Kloop / BK;
    unsigned voffA[2], voffB[2];
#pragma unroll
    for (int i = 0; i < 2; ++i) { int R, C; stage_rc(tid * 16 + i * 8192, R, C); const int Rb = Epi::PERM ? ((R & ~31) + perm32(R & 31)) : R;
        voffA[i] = (unsigned)(R * K + C) * 2u; voffB[i] = (unsigned)(Rb * K + C) * 2u; }
    const size_t kstep = (size_t)(BK * 2);
    const size_t hstep = (size_t)HALF * K * 2;
    const size_t tstep = 2 * hstep;
    const unsigned ldsw = (unsigned)wid * 1024u;
    const int aoff = lds_byte(wr * 64 + fr, fq * 8), boff = lds_byte(wc * 32 + fr, fq * 8);
#define PG8_SA(b, h) (((b) * 2 + (h)) * HTB)
#define PG8_SB(b, h) ((4 + (b) * 2 + (h)) * HTB)
#define PG8_STAGE(bufoff, gbase, voff) do { _Pragma("unroll") for (int _i = 0; _i < 2; ++_i) \
        __builtin_amdgcn_global_load_lds((const unsigned*)((const char*)(gbase) + (voff)[_i]), (PG8_LAS unsigned*)(lds + (bufoff) + ldsw + _i * 8192), 16, 0, 0); } while (0)
#define PG8_LDA(dst, b, h) do { _Pragma("unroll") for (int m = 0; m < 4; ++m) _Pragma("unroll") for (int k = 0; k < 2; ++k) dst[m][k] = *(const PG8_LAS bf16x8*)(lds + PG8_SA(b, h) + aoff + m * 2048 + k * 1024); } while (0)
#define PG8_LDB(dst, b, h) do { _Pragma("unroll") for (int n = 0; n < 2; ++n) _Pragma("unroll") for (int k = 0; k < 2; ++k) dst[n][k] = *(const PG8_LAS bf16x8*)(lds + PG8_SB(b, h) + boff + n * 2048 + k * 1024); } while (0)
#define PG8_MMA(ai, bj, At, Bt) do { __builtin_amdgcn_s_setprio(1); _Pragma("unroll") for (int m = 0; m < 4; ++m) _Pragma("unroll") for (int n = 0; n < 2; ++n) _Pragma("unroll") for (int k = 0; k < 2; ++k) \
        acc[ai][bj][m][n] = __builtin_amdgcn_mfma_f32_16x16x32_bf16(Bt[n][k], At[m][k], acc[ai][bj][m][n], 0, 0, 0); __builtin_amdgcn_s_setprio(0); } while (0)
#define PG8_WAIT_V(n) asm volatile("s_waitcnt vmcnt(" #n ")" ::: "memory")
#define PG8_WAIT_L(n) asm volatile("s_waitcnt lgkmcnt(" #n ")" ::: "memory")
#define PG8_BAR __builtin_amdgcn_s_barrier()
#define PG8_SCHED __builtin_amdgcn_sched_barrier(0)
    Unit cur, nxt; int ui = 0;
    if (!S.next(0, cur)) return;
    f32x4 acc[2][2][4][2];
#pragma unroll
    for (int a = 0; a < 2; ++a)
#pragma unroll
        for (int b = 0; b < 2; ++b)
#pragma unroll
            for (int m = 0; m < 4; ++m)
#pragma unroll
                for (int n = 0; n < 2; ++n) acc[a][b][m][n] = (f32x4){0.f, 0.f, 0.f, 0.f};
    bf16x8 At[4][2], B0[2][2], B1[2][2];
    const char* cA = (const char*)g.A + (size_t)cur.pm * tstep + cur.kb; const char* cB = (const char*)g.Bt + (size_t)cur.pn * tstep + cur.kb;
    S.a_ready(cur);
    if constexpr (SP2) {
        PG8_STAGE(PG8_SB(0, 0), cB, voffB); PG8_STAGE(PG8_SB(0, 1), cB + hstep, voffB); PG8_STAGE(PG8_SA(0, 0), cA, voffA); PG8_STAGE(PG8_SA(0, 1), cA + hstep, voffA);
        if (wr == 1) PG8_BAR;
        PG8_WAIT_V(2); PG8_BAR;
        PG8_STAGE(PG8_SB(1, 0), cB + kstep, voffB); PG8_STAGE(PG8_SA(1, 0), cA + kstep, voffA); PG8_STAGE(PG8_SB(1, 1), cB + hstep + kstep, voffB);
        PG8_WAIT_V(6); PG8_BAR;
    } else {
        PG8_STAGE(PG8_SB(0, 0), cB, voffB); PG8_STAGE(PG8_SA(0, 0), cA, voffA); PG8_STAGE(PG8_SB(0, 1), cB + hstep, voffB); PG8_STAGE(PG8_SA(0, 1), cA + hstep, voffA);
        if (wr == 1) PG8_BAR;
        PG8_WAIT_V(4); PG8_BAR;
        PG8_STAGE(PG8_SB(1, 0), cB + kstep, voffB); PG8_STAGE(PG8_SA(1, 0), cA + kstep, voffA); PG8_STAGE(PG8_SB(1, 1), cB + hstep + kstep, voffB);
        PG8_WAIT_V(6); PG8_BAR;
    }
    for (;;) {
        const bool has_next = S.next(ui + 1, nxt);
        const char* nA = has_next ? (const char*)g.A + (size_t)nxt.pm * tstep + nxt.kb : cA; const char* nB = has_next ? (const char*)g.Bt + (size_t)nxt.pn * tstep + nxt.kb : cB;
        for (int t = 0; t < nt; t += 2) {
            const bool last = (t == nt - 2);
            const char* a1 = cA + (size_t)(t + 1) * kstep;
            const char* a2 = last ? nA : cA + (size_t)(t + 2) * kstep; const char* b2 = last ? nB : cB + (size_t)(t + 2) * kstep;
            const char* a3 = a2 + kstep; const char* b3 = b2 + kstep;
            if (last && has_next) S.a_ready(nxt);
            if constexpr (SP2) {
            PG8_LDB(B0, 0, 0); PG8_LDB(B1, 0, 1); PG8_SCHED; PG8_LDA(At, 0, 0); PG8_STAGE(PG8_SA(1, 1), a1 + hstep, voffA);
            PG8_WAIT_V(8); PG8_WAIT_L(0); PG8_BAR; PG8_MMA(0, 0, At, B0); PG8_MMA(0, 1, At, B1); PG8_BAR; PG8_SCHED;
            PG8_LDA(At, 0, 1); PG8_STAGE(PG8_SB(0, 0), b2, voffB); PG8_STAGE(PG8_SB(0, 1), b2 + hstep, voffB); PG8_STAGE(PG8_SA(0, 0), a2, voffA);
            PG8_WAIT_V(8); PG8_WAIT_L(0); PG8_BAR; PG8_MMA(1, 0, At, B0); PG8_MMA(1, 1, At, B1); PG8_BAR; PG8_SCHED;
            PG8_LDB(B0, 1, 0); PG8_LDB(B1, 1, 1); PG8_SCHED; PG8_LDA(At, 1, 0); PG8_STAGE(PG8_SA(0, 1), a2 + hstep, voffA);
            PG8_WAIT_V(8); PG8_WAIT_L(0); PG8_BAR; PG8_MMA(0, 0, At, B0); PG8_MMA(0, 1, At, B1); PG8_BAR; PG8_SCHED;
            PG8_LDA(At, 1, 1); PG8_STAGE(PG8_SB(1, 0), b3, voffB); PG8_STAGE(PG8_SB(1, 1), b3 + hstep, voffB); PG8_STAGE(PG8_SA(1, 0), a3, voffA);
            PG8_WAIT_V(8); PG8_WAIT_L(0); PG8_BAR; PG8_MMA(1, 0, At, B0); PG8_MMA(1, 1, At, B1); PG8_BAR; PG8_SCHED;
            } else {
            PG8_LDB(B0, 0, 0); PG8_SCHED; PG8_LDA(At, 0, 0); PG8_STAGE(PG8_SA(1, 1), a1 + hstep, voffA);
            PG8_WAIT_L(8); PG8_BAR; PG8_WAIT_L(0); PG8_MMA(0, 0, At, B0); PG8_BAR; PG8_SCHED;
            PG8_LDB(B1, 0, 1); PG8_STAGE(PG8_SB(0, 0), b2, voffB);
            PG8_BAR; PG8_WAIT_L(0); PG8_MMA(0, 1, At, B1); PG8_BAR;
            PG8_LDA(At, 0, 1); PG8_STAGE(PG8_SA(0, 0), a2, voffA);
            PG8_BAR; PG8_WAIT_L(0); PG8_MMA(1, 0, At, B0); PG8_BAR; PG8_SCHED;
            PG8_STAGE(PG8_SB(0, 1), b2 + hstep, voffB);
            PG8_WAIT_V(6); PG8_BAR; PG8_MMA(1, 1, At, B1); PG8_BAR;
            PG8_LDB(B0, 1, 0); PG8_SCHED; PG8_LDA(At, 1, 0); PG8_STAGE(PG8_SA(0, 1), a2 + hstep, voffA);
            PG8_WAIT_L(8); PG8_BAR; PG8_WAIT_L(0); PG8_MMA(0, 0, At, B0); PG8_BAR; PG8_SCHED;
            PG8_LDB(B1, 1, 1); PG8_STAGE(PG8_SB(1, 0), b3, voffB);
            PG8_BAR; PG8_WAIT_L(0); PG8_MMA(0, 1, At, B1); PG8_BAR;
            PG8_LDA(At, 1, 1); PG8_STAGE(PG8_SA(1, 0), a3, voffA);
            PG8_BAR; PG8_WAIT_L(0); PG8_MMA(1, 0, At, B0); PG8_BAR; PG8_SCHED;
            PG8_STAGE(PG8_SB(1, 1), b3 + hstep, voffB);
            PG8_WAIT_V(6); PG8_BAR; PG8_MMA(1, 1, At, B1); PG8_BAR;
            }
        }
        if constexpr (ALIGN_EPI) { if (wr == 0) PG8_BAR; }
        if constexpr (!Epi::AFTER_DRAIN) { E(acc, cur, wr, wc, fr, fq); S.done(cur); }
        if (!has_next) break;
#pragma unroll
        for (int a = 0; a < 2; ++a)
#pragma unroll
            for (int b = 0; b < 2; ++b)
#pragma unroll
                for (int m = 0; m < 4; ++m)
#pragma unroll
                    for (int n = 0; n < 2; ++n) acc[a][b][m][n] = (f32x4){0.f, 0.f, 0.f, 0.f};
        cur = nxt; cA = nA; cB = nB; ++ui;
        if constexpr (ALIGN_EPI) { if (wr == 1) PG8_BAR; }
    }
    PG8_WAIT_V(0);
    if constexpr (!ALIGN_EPI) { if (wr == 0) PG8_BAR; }
    PG8_BAR;
    if constexpr (Epi::AFTER_DRAIN) { E.fused(acc, cur, wr, wc, fr, fq, lds, wid, lane); S.done(cur); }
#undef PG8_SA
#undef PG8_SB
#undef PG8_STAGE
#undef PG8_LDA
#undef PG8_LDB
#undef PG8_MMA
#undef PG8_WAIT_V
#undef PG8_WAIT_L
#undef PG8_BAR
#undef PG8_SCHED
}
}
#define LASX __attribute__((address_space(3)))
#define XB_TMO      128
#define XB_XCNT(j)  (256  + 64 * (j))
#define XB_XSUB(j)  (1280 + 64 * (j))
#define XB_XGEN(j)  (2304 + 64 * (j))
#define XB_TOP      3328
#define XB_TOPGEN   3392
#define XCD_BAR_WORDS 3456
#define XB_SPIN_CAP (1u << 18)

__device__ __forceinline__ unsigned xb_ld(unsigned* p)              { return __hip_atomic_load(p, __ATOMIC_RELAXED, __HIP_MEMORY_SCOPE_AGENT); }
__device__ __forceinline__ unsigned xb_add(unsigned* p, unsigned v) { return __hip_atomic_fetch_add(p, v, __ATOMIC_RELAXED, __HIP_MEMORY_SCOPE_AGENT); }
__device__ __forceinline__ unsigned xb_xcc_id() { return (unsigned)__builtin_amdgcn_s_getreg((3 << 11) | 20) & 0xFu; }
#define XB_SPIN(cond, bar) do { unsigned _sp = 0; while (cond) { __builtin_amdgcn_s_sleep(1); \
    if ((++_sp & 255u) == 0u) { if (xb_ld(&(bar)[XB_TMO])) break; if (_sp > XB_SPIN_CAP) { atomicAdd(&(bar)[XB_TMO], 1u); break; } } } } while (0)

struct XcdBarrier {
    unsigned* bar; unsigned x;
    volatile LASX unsigned* st;
};

__device__ __forceinline__ XcdBarrier xcd_barrier_post(unsigned* bar, volatile LASX unsigned* st) {
    XcdBarrier b; b.bar = bar; b.x = xb_xcc_id(); b.st = st;
    if (threadIdx.x == 0) (void)xb_add(&bar[XB_XCNT(b.x)], 1u);
    return b;
}
__device__ __forceinline__ void xcd_barrier_complete(unsigned* bar, unsigned x, unsigned& nloc, unsigned& nx) {
    const unsigned G = gridDim.x * gridDim.y * gridDim.z;
    unsigned sum, cnt, mine, sp = 0u;
    for (;;) {
        sum = 0u; cnt = 0u; mine = 0u;
#pragma unroll
        for (unsigned j = 0; j < 16; ++j) { const unsigned c = xb_ld(&bar[XB_XCNT(j)]); sum += c; cnt += (c > 0u) ? 1u : 0u; mine = (j == x) ? c : mine; }
        if (sum == G) break;
        __builtin_amdgcn_s_sleep(1);
        if ((++sp & 255u) == 0u) { if (xb_ld(&bar[XB_TMO])) break; if (sp > XB_SPIN_CAP) { atomicAdd(&bar[XB_TMO], 1u); break; } }
    }
    nloc = mine > 0u ? mine : 1u; nx = cnt > 0u ? cnt : 1u;
}

__device__ __forceinline__ void xcd_barrier(const XcdBarrier& b) {
    asm volatile("s_waitcnt vmcnt(0)" ::: "memory");
    __syncthreads();
    if (threadIdx.x == 0) {
        unsigned* bar = b.bar;
        __builtin_amdgcn_s_waitcnt(0);
        unsigned nloc = b.st[0], nx = b.st[1];
        if (nloc == 0u) { xcd_barrier_complete(bar, b.x, nloc, nx); b.st[0] = nloc; b.st[1] = nx; }
        const unsigned old = xb_add(&bar[XB_XSUB(b.x)], 1u);
        const unsigned gen = old / nloc;
        if (old + 1u == (gen + 1u) * nloc) {
            __builtin_amdgcn_fence(__ATOMIC_RELEASE, "agent");
            asm volatile("s_waitcnt vmcnt(0)" ::: "memory");
            const unsigned og = xb_add(&bar[XB_TOP], 1u);
            const unsigned tg = og / nx;
            if (og + 1u == (tg + 1u) * nx) xb_add(&bar[XB_TOPGEN], 1u);
            else XB_SPIN(xb_ld(&bar[XB_TOPGEN]) == tg, bar);
            __builtin_amdgcn_fence(__ATOMIC_ACQUIRE, "agent");
            xb_add(&bar[XB_XGEN(b.x)], 1u);
            asm volatile("s_waitcnt vmcnt(0)" ::: "memory");
        } else {
            XB_SPIN(xb_ld(&bar[XB_XGEN(b.x)]) == gen, bar);
            __builtin_amdgcn_fence(__ATOMIC_ACQUIRE, "agent");
            asm volatile("s_waitcnt vmcnt(0)" ::: "memory");
        }
    }
    __syncthreads();
}

#ifndef PROBE_OD
#define PROBE_OD 0
#endif
#ifndef PROBE_GC
#define PROBE_GC 0
#endif
#ifndef PROBE_AA
#define PROBE_AA 0
#endif
#ifndef XEXP
#define XEXP 0
#endif
typedef unsigned short bf16_t;
typedef short bf16x8 __attribute__((ext_vector_type(8)));
typedef float f32x4 __attribute__((ext_vector_type(4)));
typedef unsigned u32x4 __attribute__((ext_vector_type(4)));
typedef unsigned u32x2 __attribute__((ext_vector_type(2)));
#define LAS __attribute__((address_space(3)))

constexpr int NB = 2, SEQ = 8192, LC = 256, TB = SEQ + LC, MT = NB * TB, DM = 1024, NL = 4;
constexpr int IN_DIM = 5824, NPIN = 5888, FF = 2816, FF2 = 5632;
constexpr float EPS = 1e-6f, LOG2E = 1.4426950408889634f;
constexpr int NTHR = 512, NWAVES = 8;
constexpr int LDS_BYTES = 147456;
enum { I_X = 0, I_C, I_CTX, I_CCTX, I_WMOD, I_BMOD, I_NMIX, I_NFFN, I_WIN, I_SINK, I_QNORM, I_KVNORM, I_WUQ, I_WUKV, I_WGATE, I_BGATE, I_HNORM,
       I_WBRA, I_WBRB, I_WBRC, I_WOUT, I_WUP, I_CONVW, I_CONVB, I_WDOWN, I_FNORM, N_IN };

constexpr size_t O_MOD = 0;
constexpr size_t O_BAR = 384 * 1024;
constexpr size_t O_ROPEA = 512 * 1024;
constexpr size_t O_ROPEB = O_ROPEA + 2 * 1024 * 1024;
constexpr size_t O_SSQ = O_ROPEB + 1024 * 1024;
constexpr size_t O_GD = O_SSQ + 256 * 1024;
constexpr size_t O_X = O_GD + 1024 * 1024;
constexpr size_t SZ_X = (size_t)MT * DM * 4;
constexpr size_t O_WIN = O_X + SZ_X;
constexpr size_t O_WUQ = O_WIN + (size_t)NPIN * 1024 * 2;
constexpr size_t O_WUKV = O_WUQ + (size_t)768 * 256 * 2;
constexpr size_t O_WBR = O_WUKV + (size_t)1024 * 256 * 2;
constexpr size_t O_WOUT = O_WBR + (size_t)3 * 1024 * 512 * 2;
constexpr size_t O_WUP = O_WOUT + (size_t)1024 * 1024 * 2;
constexpr size_t O_WDOWN = O_WUP + (size_t)FF2 * 1024 * 2;
constexpr size_t O_HM = O_WDOWN + (size_t)1024 * FF * 2;
constexpr size_t O_MIX = O_HM + (size_t)MT * 1024 * 2;
constexpr size_t O_QA = O_MIX;
constexpr size_t O_KA = O_QA + (size_t)MT * 512 * 2;
constexpr size_t O_VAT = O_KA + (size_t)MT * 128 * 2;
constexpr size_t O_CQB = O_VAT + (size_t)2 * 2 * 64 * TB * 2;
constexpr size_t O_CKVB = O_CQB + (size_t)MT * 256 * 2;
constexpr size_t O_QB = O_CKVB + (size_t)MT * 256 * 2;
constexpr size_t O_KB = O_QB + (size_t)MT * 768 * 2;
constexpr size_t O_VBT = O_KB + (size_t)MT * 768 * 2;
constexpr size_t O_CQ = O_VBT + (size_t)2 * 8 * 64 * TB * 2;
constexpr size_t O_CK = O_CQ + (size_t)MT * 256 * 2;
constexpr size_t O_CV = O_CK + (size_t)MT * 256 * 2;
constexpr size_t O_CR = O_CV + (size_t)MT * 512 * 2;
constexpr size_t O_GLOW = O_CR + (size_t)MT * 512 * 2;
constexpr size_t O_GATES = O_GLOW + (size_t)MT * 32 * 4;
constexpr size_t O_YB = O_GATES + (size_t)MT * 3072 * 2;
constexpr size_t O_END = O_YB + (size_t)MT * 512 * 2;
constexpr size_t O_MACC = O_QB;
static_assert(O_CQ - O_QB == (size_t)MT * 1024 * 4, "MACC overlay");
constexpr size_t O_U = O_MIX;
constexpr size_t O_ACT = O_U + (size_t)MT * FF2 * 2;
static_assert(O_ACT + (size_t)MT * FF * 2 <= O_END, "U|ACT overlay");
constexpr size_t O_ST = O_HM;
static_assert((size_t)2112 * 8192 * 2 <= (size_t)MT * 1024 * 2, "ST overlay");
static_assert(O_END <= (size_t)448 * 1024 * 1024, "workspace budget");

__device__ __forceinline__ unsigned f2bf(float f) { unsigned u = __float_as_uint(f); return (u + 0x7fffu + ((u >> 16) & 1u)) >> 16; }
typedef float f32x2_t __attribute__((ext_vector_type(2))); typedef __bf16 bf16x2_t __attribute__((ext_vector_type(2)));
__device__ __forceinline__ unsigned pk2(float lo, float hi) { f32x2_t v = {lo, hi}; bf16x2_t b = __builtin_convertvector(v, bf16x2_t); return __builtin_bit_cast(unsigned, b); }
__device__ __forceinline__ float bflo(unsigned w) { return __uint_as_float(w << 16); }
__device__ __forceinline__ float bfhi(unsigned w) { return __uint_as_float(w & 0xffff0000u); }
__device__ __forceinline__ float bf2f(bf16_t h) { return __uint_as_float(((unsigned)h) << 16); }
__device__ __forceinline__ u32x4 pack8(const float* v) { u32x4 w; w.x = pk2(v[0], v[1]); w.y = pk2(v[2], v[3]); w.z = pk2(v[4], v[5]); w.w = pk2(v[6], v[7]); return w; }
__device__ __forceinline__ void unpack8(u32x4 w, float* v) { v[0] = bflo(w.x); v[1] = bfhi(w.x); v[2] = bflo(w.y); v[3] = bfhi(w.y); v[4] = bflo(w.z); v[5] = bfhi(w.z); v[6] = bflo(w.w); v[7] = bfhi(w.w); }
__device__ __forceinline__ float wave_sum(float v) {
#pragma unroll
    for (int o = 1; o < 64; o <<= 1) v += __shfl_xor(v, o);
    return v;
}
__device__ __forceinline__ float sigmoidf_(float x) { return 1.f / (1.f + __expf(-x)); }
__device__ __forceinline__ float siluf_(float x) { return x / (1.f + __expf(-x)); }

struct Args { const float* in[N_IN]; float* out; unsigned char* ws; int ph_lo, ph_hi; };

enum { MAT_IN = 0, MAT_UQ, MAT_UKV, MAT_PLAIN };
__device__ __forceinline__ int srcmap(int mat, int p) {
    if (mat == MAT_IN) {
        if (p < 640) { const int w = p & 63; return (p & ~63) + (w >> 1) + 32 * (w & 1); }
        if (p < 1152) return p;
        if (p < 1184) { const int w = p - 1152; return 1152 + (w >> 1) + 16 * (w & 1); }
        if (p < 1216) return 2720 + (p - 1184);
        if (p < 1280) return -1;
        if (p < 2816) return 1184 + (p - 1280);
        return 2752 + (p - 2816);
    }
    if (mat == MAT_UQ) { const int h = p / 96, w = p - h * 96; if (w < 64) return p; const int ww = w - 64; return h * 96 + 64 + (ww >> 1) + 16 * (ww & 1); }
    return p;
}
__device__ __forceinline__ void transpose_item(const float* __restrict__ W, int K, int N, bf16_t* WT, int KD, int item, int mat, const float* __restrict__ ks, float* scr, int lane) {
    const int nkb = KD / 64, pb = item / nkb, kb = item - pb * nkb, p0 = pb * 32, k0 = kb * 64;
    const int src = srcmap(mat, p0 + (lane & 31));
    float tv[32];
#pragma unroll
    for (int i = 0; i < 32; ++i) {
        const int k = k0 + 2 * i + (lane >> 5);
        float v = 0.f;
        if (src >= 0 && k < K) { v = __builtin_nontemporal_load(W + (size_t)k * N + src); if (ks) v *= ks[k]; }
        tv[i] = v;
    }
#pragma unroll
    for (int i = 0; i < 32; ++i) scr[(2 * i + (lane >> 5)) * 33 + (lane & 31)] = tv[i];
    __builtin_amdgcn_fence(__ATOMIC_RELEASE, "workgroup"); __builtin_amdgcn_wave_barrier();
    const int c = lane & 7;
#pragma unroll
    for (int j = 0; j < 4; ++j) {
        const int n = (lane >> 3) + 8 * j; const float* s = scr + (8 * c) * 33 + n;
        u32x4 o; o.x = pk2(s[0 * 33], s[1 * 33]); o.y = pk2(s[2 * 33], s[3 * 33]); o.z = pk2(s[4 * 33], s[5 * 33]); o.w = pk2(s[6 * 33], s[7 * 33]);
        *(u32x4*)(WT + (size_t)(p0 + n) * KD + k0 + 8 * c) = o;
    }
    __builtin_amdgcn_fence(__ATOMIC_RELEASE, "workgroup"); __builtin_amdgcn_wave_barrier();
}

#define EPI_LOOP_BEGIN \
    int fr_l = fr, fq_l = fq; asm volatile("" : "+v"(fr_l), "+v"(fq_l)); \
    _Pragma("unroll") for (int bj = 0; bj < 2; ++bj) { const int c0 = u.pn * 256 + bj * 128 + wc * 32 + 8 * fq_l; \
    _Pragma("unroll") for (int ai = 0; ai < 2; ++ai) _Pragma("unroll") for (int m = 0; m < 4; ++m) { const int t = u.pm * 256 + ai * 128 + wr * 64 + m * 16 + fr_l; \
        float v[8]; { const f32x4 a0 = acc[ai][bj][m][0], a1 = acc[ai][bj][m][1]; v[0] = a0[0]; v[1] = a0[1]; v[2] = a0[2]; v[3] = a0[3]; v[4] = a1[0]; v[5] = a1[1]; v[6] = a1[2]; v[7] = a1[3]; }
#define EPI_LOOP_END asm volatile("" ::: "memory"); } }

struct EpiIn {
    static constexpr bool PERM = true, AFTER_DRAIN = false;
    unsigned char* ws;
    __device__ __forceinline__ void operator()(const f32x4 (&acc)[2][2][4][2], const pg8::Unit& u, int wr, int wc, int fr, int fq) const {
        EPI_LOOP_BEGIN
            const int b = (t >= TB) ? 1 : 0, i = t - b * TB; const bool lat = i >= LC; const int pos = i - LC;
            if (c0 < 640) {
                if (lat) { const float* cs = (const float*)(ws + O_ROPEA) + (size_t)pos * 64 + ((c0 & 63) >> 1);
#pragma unroll
                    for (int p = 0; p < 4; ++p) { const float c = cs[p], s = cs[32 + p], a = v[2 * p], bb = v[2 * p + 1]; v[2 * p] = a * c - bb * s; v[2 * p + 1] = a * s + bb * c; } }
                if (c0 < 512) {
#pragma unroll
                    for (int e = 0; e < 8; ++e) v[e] *= 0.125f * LOG2E;
                    *(u32x4*)((bf16_t*)(ws + O_QA) + (size_t)t * 512 + c0) = pack8(v);
                } else *(u32x4*)((bf16_t*)(ws + O_KA) + (size_t)t * 128 + (c0 - 512)) = pack8(v);
            } else if (c0 < 768) {
                const int cc = c0 - 640, kvh = cc >> 6, d0 = cc & 63;
                bf16_t* dst = (bf16_t*)(ws + O_VAT) + ((size_t)(b * 2 + kvh) * 64 + d0) * TB + i;
#pragma unroll
                for (int e = 0; e < 8; ++e) dst[(size_t)e * TB] = (bf16_t)f2bf(v[e]);
            } else if (c0 < 1152) {
                float s = 0.f;
#pragma unroll
                for (int e = 0; e < 8; ++e) s += v[e] * v[e];
                s += __shfl_xor(s, 16); s += __shfl_xor(s, 32);
                if (c0 < 1024) { *(u32x4*)((bf16_t*)(ws + O_CQB) + (size_t)t * 256 + (c0 - 768)) = pack8(v); if (fq_l == 0) unsafeAtomicAdd((float*)(ws + O_SSQ) + t * 2, s); }
                else { bf16_t* d = (bf16_t*)(ws + O_CKVB) + (size_t)t * 256 + (c0 - 1024); *(u32x4*)d = pack8(v); *(u32x4*)(d + 128) = (u32x4){0u, 0u, 0u, 0u}; if (fq_l == 0) unsafeAtomicAdd((float*)(ws + O_SSQ) + t * 2 + 1, s); }
            } else if (c0 < 1184) {
                if (lat) { const float* cs = (const float*)(ws + O_ROPEB) + (size_t)pos * 32 + ((c0 - 1152) >> 1);
#pragma unroll
                    for (int p = 0; p < 4; ++p) { const float c = cs[p], s = cs[16 + p], a = v[2 * p], bb = v[2 * p + 1]; v[2 * p] = a * c - bb * s; v[2 * p + 1] = a * s + bb * c; } }
                const u32x4 w = pack8(v); bf16_t* d = (bf16_t*)(ws + O_KB) + (size_t)t * 768 + 64 + (c0 - 1152);
#pragma unroll
                for (int h = 0; h < 8; ++h) *(u32x4*)(d + h * 96) = w;
            } else if (c0 < 1216) {
                float* d = (float*)(ws + O_GLOW) + (size_t)t * 32 + (c0 - 1184);
                *(f32x4*)d = (f32x4){v[0], v[1], v[2], v[3]}; *(f32x4*)(d + 4) = (f32x4){v[4], v[5], v[6], v[7]};
            } else if (c0 < 1280) {
            } else if (c0 < 1536) {
#pragma unroll
                for (int e = 0; e < 8; ++e) v[e] *= 0.125f;
                *(u32x4*)((bf16_t*)(ws + O_CQ) + (size_t)t * 256 + (c0 - 1280)) = pack8(v);
            } else if (c0 < 1792) { *(u32x4*)((bf16_t*)(ws + O_CK) + (size_t)t * 256 + (c0 - 1536)) = pack8(v);
            } else if (c0 < 2304) { *(u32x4*)((bf16_t*)(ws + O_CV) + (size_t)t * 512 + (c0 - 1792)) = pack8(v);
            } else if (c0 < 2816) { *(u32x4*)((bf16_t*)(ws + O_CR) + (size_t)t * 512 + (c0 - 2304)) = pack8(v);
            } else {
#pragma unroll
                for (int e = 0; e < 8; ++e) v[e] = sigmoidf_(v[e]);
                *(u32x4*)((bf16_t*)(ws + O_GATES) + (size_t)t * 3072 + (c0 - 2816)) = pack8(v);
            }
        EPI_LOOP_END
    }
};

struct EpiUq {
    static constexpr bool PERM = true, AFTER_DRAIN = false;
    unsigned char* ws;
    __device__ __forceinline__ void operator()(const f32x4 (&acc)[2][2][4][2], const pg8::Unit& u, int wr, int wc, int fr, int fq) const {
        EPI_LOOP_BEGIN
            const int b = (t >= TB) ? 1 : 0, i = t - b * TB; const bool lat = i >= LC; const int pos = i - LC;
            const float rstd = rsqrtf(((const float*)(ws + O_SSQ))[t * 2] * (1.f / 256.f) + EPS) * (0.10206207261596575f * LOG2E);
#pragma unroll
            for (int e = 0; e < 8; ++e) v[e] *= rstd;
            const int h = c0 / 96, w = c0 - h * 96;
            if (w >= 64 && lat) { const float* cs = (const float*)(ws + O_ROPEB) + (size_t)pos * 32 + ((w - 64) >> 1);
#pragma unroll
                for (int p = 0; p < 4; ++p) { const float c = cs[p], s = cs[16 + p], a = v[2 * p], bb = v[2 * p + 1]; v[2 * p] = a * c - bb * s; v[2 * p + 1] = a * s + bb * c; } }
            *(u32x4*)((bf16_t*)(ws + O_QB) + (size_t)t * 768 + c0) = pack8(v);
        EPI_LOOP_END
    }
};
struct EpiUkv {
    static constexpr bool PERM = true, AFTER_DRAIN = false;
    unsigned char* ws;
    __device__ __forceinline__ void operator()(const f32x4 (&acc)[2][2][4][2], const pg8::Unit& u, int wr, int wc, int fr, int fq) const {
        EPI_LOOP_BEGIN
            const int b = (t >= TB) ? 1 : 0, i = t - b * TB;
            const float rstd = rsqrtf(((const float*)(ws + O_SSQ))[t * 2 + 1] * (1.f / 128.f) + EPS);
#pragma unroll
            for (int e = 0; e < 8; ++e) v[e] *= rstd;
            const int h = c0 >> 7, w = c0 & 127;
            if (w < 64) *(u32x4*)((bf16_t*)(ws + O_KB) + (size_t)t * 768 + h * 96 + w) = pack8(v);
            else { bf16_t* dst = (bf16_t*)(ws + O_VBT) + ((size_t)(b * 8 + h) * 64 + (w - 64)) * TB + i;
#pragma unroll
                for (int e = 0; e < 8; ++e) dst[(size_t)e * TB] = (bf16_t)f2bf(v[e]); }
        EPI_LOOP_END
    }
};
template <int PASS> struct EpiMerge {
    static constexpr bool PERM = true, AFTER_DRAIN = false;
    unsigned char* ws;
    __device__ __forceinline__ void operator()(const f32x4 (&acc)[2][2][4][2], const pg8::Unit& u, int wr, int wc, int fr, int fq) const {
        EPI_LOOP_BEGIN
            float g[8]; unpack8(*(const u32x4*)((const bf16_t*)(ws + O_GATES) + (size_t)t * 3072 + PASS * 1024 + c0), g);
            bf16_t* mp = (bf16_t*)(ws + O_HM) + (size_t)t * 1024 + c0;
            if (PASS > 0) { float pv[8]; unpack8(*(const u32x4*)mp, pv);
#pragma unroll
                for (int e = 0; e < 8; ++e) v[e] = pv[e] + g[e] * v[e];
            } else {
#pragma unroll
                for (int e = 0; e < 8; ++e) v[e] *= g[e];
            }
            *(u32x4*)mp = pack8(v);
        EPI_LOOP_END
    }
};
template <int PASS> struct EpiMergePart {
    static constexpr bool PERM = true, AFTER_DRAIN = false;
    unsigned char* ws; int kbstep;
    __device__ __forceinline__ void operator()(const f32x4 (&acc)[2][2][4][2], const pg8::Unit& u, int wr, int wc, int fr, int fq) const {
        const int ks = u.kb / kbstep;
        EPI_LOOP_BEGIN
            float g[8]; unpack8(*(const u32x4*)((const bf16_t*)(ws + O_GATES) + (size_t)t * 3072 + PASS * 1024 + c0), g);
            const int cr = (t >= TB) ? (t - TB + 256) : t;
            float* pp = (float*)(ws + O_CQ) + ((size_t)((PASS * 2 + ks) * 512 + cr)) * 1024 + c0;
            *(f32x4*)pp = (f32x4){g[0] * v[0], g[1] * v[1], g[2] * v[2], g[3] * v[3]}; *(f32x4*)(pp + 4) = (f32x4){g[4] * v[4], g[5] * v[5], g[6] * v[6], g[7] * v[7]};
        EPI_LOOP_END
    }
};
struct EpiResid {
    static constexpr bool PERM = true, AFTER_DRAIN = false;
    unsigned char* ws; const float* modl; int goff;
    __device__ __forceinline__ void operator()(const f32x4 (&acc)[2][2][4][2], const pg8::Unit& u, int wr, int wc, int fr, int fq) const {
        EPI_LOOP_BEGIN
            const int b = (t >= TB) ? 1 : 0, i = t - b * TB; const int r = (i >= LC) ? b : 2;
            const float* gp = modl + r * 6144 + goff + c0;
            const f32x4 g0 = *(const f32x4*)gp, g1 = *(const f32x4*)(gp + 4);
            float* xp = (float*)(ws + O_X) + (size_t)t * 1024 + c0;
            f32x4 x0 = *(const f32x4*)xp, x1 = *(const f32x4*)(xp + 4);
            x0[0] += g0[0] * v[0]; x0[1] += g0[1] * v[1]; x0[2] += g0[2] * v[2]; x0[3] += g0[3] * v[3];
            x1[0] += g1[0] * v[4]; x1[1] += g1[1] * v[5]; x1[2] += g1[2] * v[6]; x1[3] += g1[3] * v[7];
            *(f32x4*)xp = x0; *(f32x4*)(xp + 4) = x1;
        EPI_LOOP_END
    }
};
struct EpiPartial {
    static constexpr bool PERM = true, AFTER_DRAIN = false;
    float* P; int kbstep;
    __device__ __forceinline__ void operator()(const f32x4 (&acc)[2][2][4][2], const pg8::Unit& u, int wr, int wc, int fr, int fq) const {
        const int ks = u.kb / kbstep;
        EPI_LOOP_BEGIN
            const int cr = (t >= TB) ? (t - TB + 256) : t;
            float* pp = P + ((size_t)(ks * 512 + cr)) * 1024 + c0;
            *(f32x4*)pp = (f32x4){v[0], v[1], v[2], v[3]}; *(f32x4*)(pp + 4) = (f32x4){v[4], v[5], v[6], v[7]};
        EPI_LOOP_END
    }
};
struct EpiNull {
    static constexpr bool PERM = true, AFTER_DRAIN = false;
    float* sink;
    __device__ __forceinline__ void operator()(const f32x4 (&acc)[2][2][4][2], const pg8::Unit& u, int wr, int wc, int fr, int fq) const {
        float sacc = 0.f;
        EPI_LOOP_BEGIN
            sacc += v[0] + v[1] + v[2] + v[3] + v[4] + v[5] + v[6] + v[7] + (float)(t + c0) * 1e-30f;
        EPI_LOOP_END
        if (sacc == 1.2345e30f) sink[threadIdx.x] = sacc;
    }
};
struct EpiStore {
    static constexpr bool PERM = true, AFTER_DRAIN = false;
    bf16_t* O; int ldc;
    __device__ __forceinline__ void operator()(const f32x4 (&acc)[2][2][4][2], const pg8::Unit& u, int wr, int wc, int fr, int fq) const {
        EPI_LOOP_BEGIN
            *(u32x4*)(O + (size_t)t * ldc + c0) = pack8(v);
        EPI_LOOP_END
    }
};

template <class Epi> __device__ __forceinline__ void run_gemm(unsigned char* lds, const bf16_t* A, const bf16_t* Bt, int M, int N, int K, const Epi& E) {
    asm volatile("" : "+s"(K), "+s"(M), "+s"(N));
    int gd_ = (int)gridDim.x, bi_ = (int)blockIdx.x; asm volatile("" : "+s"(gd_), "+s"(bi_));
    pg8::Gemm g{A, Bt, M, N, K, K}; pg8::StaticOrder S; S.init(M, N, gd_, bi_);
    pg8::gemm_phase<Epi, pg8::StaticOrder, true, true>((PG8_LAS unsigned char*)lds, g, S, E);
}

struct MainOrder {
    pg8::StaticOrder S;
    __device__ void init(int N, int G_, int c_) { S.init(64 * 256, N, G_, c_); }
    __device__ bool next(int i, pg8::Unit& u) const { if (!S.next(i, u)) return false; u.pm = (u.pm < 32) ? u.pm + 1 : u.pm + 2; return true; }
    __device__ __forceinline__ void a_ready(const pg8::Unit&) const {}
    __device__ __forceinline__ void done(const pg8::Unit&) const {}
};
struct CtxSplitOrder {
    int nN, nsplit, kloop, G, c;
    __device__ bool next(int i, pg8::Unit& u) const {
        const int L = i * G + c; if (L >= 2 * nN * nsplit) return false;
        const int ks = L % nsplit, r = L / nsplit; u.pn = r % nN; u.pm = (r / nN) ? 33 : 0; u.kb = ks * kloop * 2; return true;
    }
    __device__ __forceinline__ void a_ready(const pg8::Unit&) const {}
    __device__ __forceinline__ void done(const pg8::Unit&) const {}
};
template <class Epi> __device__ __forceinline__ void run_gemm_main(unsigned char* lds, const bf16_t* A, const bf16_t* Bt, int N, int K, const Epi& E) {
    asm volatile("" : "+s"(K), "+s"(N));
    int gd_ = (int)gridDim.x, bi_ = (int)blockIdx.x; asm volatile("" : "+s"(gd_), "+s"(bi_));
    pg8::Gemm g{A, Bt, MT, N, K, K}; MainOrder S; S.init(N, gd_, bi_);
    pg8::gemm_phase<Epi, MainOrder, true, true>((PG8_LAS unsigned char*)lds, g, S, E);
}
template <class Epi> __device__ __forceinline__ void run_gemm_ctx(unsigned char* lds, const bf16_t* A, const bf16_t* Bt, int N, int K, int nsplit, const Epi& E, int rot = 0) {
    asm volatile("" : "+s"(K), "+s"(N), "+s"(nsplit));
    int gd_ = (int)gridDim.x, bi_ = (int)blockIdx.x; asm volatile("" : "+s"(gd_), "+s"(bi_));
    bi_ = (bi_ + gd_ - (rot % gd_)) % gd_;
    const int kloop = K / nsplit;
    pg8::Gemm g{A, Bt, MT, N, K, kloop}; CtxSplitOrder S{N / 256, nsplit, kloop, gd_, bi_};
    pg8::gemm_phase<Epi, CtxSplitOrder, true, true>((PG8_LAS unsigned char*)lds, g, S, E);
}

struct NormRow { f32x4 v[4]; float s; };
struct NormPar { const float* src; float* cp; const float* part; const float* gv; const float* sc; const float* sh; bf16_t* orow; int nsl; };
__device__ __forceinline__ void norm_load(NormRow& R, const NormPar& P, int lane) {
    const f32x4* xr = (const f32x4*)P.src + lane; R.s = 0.f;
#pragma unroll
    for (int j = 0; j < 4; ++j) { R.v[j] = xr[64 * j];
        if (P.part) { f32x4 a = (f32x4){0.f, 0.f, 0.f, 0.f};
            for (int q = 0; q < P.nsl; ++q) a = a + ((const f32x4*)(P.part + (size_t)q * 512 * 1024))[64 * j + lane];
            R.v[j] = R.v[j] + ((const f32x4*)P.gv)[64 * j + lane] * a; }
        R.s += (R.v[j][0] * R.v[j][0] + R.v[j][1] * R.v[j][1]) + (R.v[j][2] * R.v[j][2] + R.v[j][3] * R.v[j][3]); }
}
__device__ __forceinline__ void norm_finish(const NormRow& R, const NormPar& P, const float* nw, int lane) {
    if (P.cp) {
#pragma unroll
        for (int j = 0; j < 4; ++j) ((f32x4*)P.cp)[64 * j + lane] = R.v[j];
    }
    const float rstd = rsqrtf(wave_sum(R.s) * (1.f / 1024.f) + EPS);
#pragma unroll
    for (int j = 0; j < 4; ++j) {
        const int idx = 64 * j + lane;
        const f32x4 w = ((const f32x4*)nw)[idx], a = ((const f32x4*)P.sc)[idx], bsh = ((const f32x4*)P.sh)[idx];
        const float y0 = R.v[j][0] * rstd * w[0] * (1.f + a[0]) + bsh[0], y1 = R.v[j][1] * rstd * w[1] * (1.f + a[1]) + bsh[1];
        const float y2 = R.v[j][2] * rstd * w[2] * (1.f + a[2]) + bsh[2], y3 = R.v[j][3] * rstd * w[3] * (1.f + a[3]) + bsh[3];
        u32x2 o; o.x = pk2(y0, y1); o.y = pk2(y2, y3);
        ((u32x2*)P.orow)[idx] = o;
    }
}

#define ATT_THR 4.0f
template <int DQK, bool MASK, int NQ>
__device__ __forceinline__ void attn_unit(unsigned char* lds, const bf16_t* Qg, int ldq, const bf16_t* Kg, int ldk, const bf16_t* Vtg, bf16_t* Og, int ldo,
                                          int qi0, int a0, int n1, int b0, int n2, float m0, bool sink) {
    constexpr int KP = DQK + 8, KBYTES = 64 * KP * 2, VP = 72, VBYTES = 64 * VP * 2, NC = DQK / 32, KCH = DQK / 8, WR = 16 * NQ;
    constexpr int KOFF = 0, VOFF = 2 * KBYTES;
    int tid_ = threadIdx.x; asm volatile("" : "+v"(tid_));
    const int tid = tid_, lane = tid & 63, wid = tid >> 6, ql = lane & 15, g = lane >> 4;
    const int qw0 = qi0 + wid * WR;
    bf16x8 qf[NQ][NC];
#pragma unroll
    for (int qb = 0; qb < NQ; ++qb)
#pragma unroll
        for (int c = 0; c < NC; ++c) qf[qb][c] = *(const bf16x8*)(Qg + (size_t)(qw0 + qb * 16 + ql) * ldq + c * 32 + g * 8);
    f32x4 o[4][NQ];
#pragma unroll
    for (int eb = 0; eb < 4; ++eb)
#pragma unroll
        for (int qb = 0; qb < NQ; ++qb) o[eb][qb] = (f32x4){0.f, 0.f, 0.f, 0.f};
    float mrow[NQ]; f32x4 negm[NQ], ol[NQ];
#pragma unroll
    for (int qb = 0; qb < NQ; ++qb) { mrow[qb] = sink ? m0 : 0.f; const float l0 = sink ? 1.f : 0.f; ol[qb] = (f32x4){l0, l0, l0, l0}; negm[qb] = (f32x4){-mrow[qb], -mrow[qb], -mrow[qb], -mrow[qb]}; }
    const bf16x8 ones = (bf16x8){0x3F80, 0x3F80, 0x3F80, 0x3F80, 0x3F80, 0x3F80, 0x3F80, 0x3F80};
    bool first = !sink;
    int nt = n1 + n2; asm volatile("" : "+s"(nt));
    const int kr0 = tid / KCH, kc0 = tid - kr0 * KCH;
    const int ci1 = tid + 512, kr1 = ci1 / KCH, kc1 = ci1 - kr1 * KCH;
    const bool has1 = (KCH * 64 > 512) && (ci1 < KCH * 64);
    const int ve = tid >> 3, vc = tid & 7;
    u32x4 kreg0, kreg1 = (u32x4){0u, 0u, 0u, 0u}, vreg;
#define ATT_TILE(tt) (((tt) < n1) ? (a0 + (tt)) : (b0 + (tt) - n1))
#define ATT_SKIP(kt) (MASK && ((kt) >= 4) && (((kt) * 64 > qw0 + (WR - 1) + 128) || ((kt) * 64 + 63 < qw0 - 128)))
#define ATT_ISSUE(kt) do { kreg0 = *(const u32x4*)(Kg + (size_t)((kt) * 64 + kr0) * ldk + kc0 * 8); \
        if (has1) kreg1 = *(const u32x4*)(Kg + (size_t)((kt) * 64 + kr1) * ldk + kc1 * 8); \
        vreg = *(const u32x4*)(Vtg + (size_t)ve * TB + (kt) * 64 + vc * 8); } while (0)
#define ATT_COMMIT(buf) do { unsigned char* kb_ = lds + KOFF + (buf) * KBYTES; *(u32x4*)(kb_ + kr0 * (KP * 2) + kc0 * 16) = kreg0; \
        if (has1) *(u32x4*)(kb_ + kr1 * (KP * 2) + kc1 * 16) = kreg1; \
        *(u32x4*)(lds + VOFF + (buf) * VBYTES + ve * (VP * 2) + vc * 16) = vreg; } while (0)
    { const int kt0 = ATT_TILE(0); ATT_ISSUE(kt0); ATT_COMMIT(0); }
    __syncthreads();
#pragma unroll 1
    for (int tt = 0; tt < nt; ++tt) {
        const int kt = ATT_TILE(tt);
        if (tt + 1 < nt) { const int ktn = ATT_TILE(tt + 1); ATT_ISSUE(ktn); }
        if (!ATT_SKIP(kt)) {
#pragma unroll 1
          for (int hb = 0; hb < 2; ++hb) {
            f32x4 sc[2][NQ];
            { const unsigned char* kb_ = lds + KOFF + (tt & 1) * KBYTES + hb * (32 * KP * 2);
              __builtin_amdgcn_s_setprio(1);
#pragma unroll
              for (int k2 = 0; k2 < 2; ++k2) {
#pragma unroll
                  for (int c = 0; c < NC; ++c) {
                      const bf16x8 kf = *(const bf16x8*)(kb_ + (k2 * 16 + ql) * (KP * 2) + (c * 32 + g * 8) * 2);
#pragma unroll
                      for (int qb = 0; qb < NQ; ++qb) sc[k2][qb] = __builtin_amdgcn_mfma_f32_16x16x32_bf16(kf, qf[qb][c], c == 0 ? negm[qb] : sc[k2][qb], 0, 0, 0);
                  } }
              __builtin_amdgcn_s_setprio(0); }
            if (MASK) { if (kt >= 4) { int dl = kt * 64 + hb * 32 + g * 4 - qw0 - ql; asm volatile("" : "+v"(dl));
#pragma unroll
                for (int k2 = 0; k2 < 2; ++k2)
#pragma unroll
                    for (int qb = 0; qb < NQ; ++qb)
#pragma unroll
                        for (int j = 0; j < 4; ++j) { const int d = dl + (k2 * 16 + j - qb * 16); if (d > 128 || d < -128) sc[k2][qb][j] = -1e30f; } } }
            float am = fmaxf(fmaxf(sc[0][0][0], sc[0][0][1]), sc[0][0][2]); am = fmaxf(fmaxf(am, sc[0][0][3]), sc[1][0][0]); am = fmaxf(fmaxf(am, sc[1][0][1]), sc[1][0][2]); am = fmaxf(am, sc[1][0][3]);
#pragma unroll
            for (int qb = 1; qb < NQ; ++qb) { am = fmaxf(fmaxf(am, sc[0][qb][0]), sc[0][qb][1]); am = fmaxf(fmaxf(am, sc[0][qb][2]), sc[0][qb][3]);
                am = fmaxf(fmaxf(am, sc[1][qb][0]), sc[1][qb][1]); am = fmaxf(fmaxf(am, sc[1][qb][2]), sc[1][qb][3]); }
            if (__any(first || (am > ATT_THR))) {
#pragma unroll
                for (int qb = 0; qb < NQ; ++qb) {
                    float a = fmaxf(fmaxf(sc[0][qb][0], sc[0][qb][1]), sc[0][qb][2]);
                    a = fmaxf(fmaxf(a, sc[0][qb][3]), sc[1][qb][0]); a = fmaxf(fmaxf(a, sc[1][qb][1]), sc[1][qb][2]); a = fmaxf(a, sc[1][qb][3]);
                    { auto r16 = __builtin_amdgcn_permlane16_swap(__float_as_uint(a), __float_as_uint(a), false, false); a = fmaxf(__uint_as_float(r16[0]), __uint_as_float(r16[1])); }
                    { auto r32 = __builtin_amdgcn_permlane32_swap(__float_as_uint(a), __float_as_uint(a), false, false); a = fmaxf(__uint_as_float(r32[0]), __uint_as_float(r32[1])); }
                    const float dlt = first ? a : fmaxf(a, 0.f);
                    mrow[qb] += dlt; negm[qb] = (f32x4){-mrow[qb], -mrow[qb], -mrow[qb], -mrow[qb]};
                    sc[0][qb] = sc[0][qb] - dlt; sc[1][qb] = sc[1][qb] - dlt;
                    if (!first) { const float alpha = __builtin_amdgcn_exp2f(-dlt); ol[qb] = ol[qb] * alpha;
#pragma unroll
                        for (int eb = 0; eb < 4; ++eb) o[eb][qb] = o[eb][qb] * alpha; } }
                first = false; }
            bf16x8 pf[NQ];
#pragma unroll
            for (int qb = 0; qb < NQ; ++qb) {
#pragma unroll
                for (int k2 = 0; k2 < 2; ++k2)
#pragma unroll
                    for (int j = 0; j < 4; ++j) sc[k2][qb][j] = __builtin_amdgcn_exp2f(sc[k2][qb][j]);
                u32x4 w; w.x = pk2(sc[0][qb][0], sc[0][qb][1]); w.y = pk2(sc[0][qb][2], sc[0][qb][3]); w.z = pk2(sc[1][qb][0], sc[1][qb][1]); w.w = pk2(sc[1][qb][2], sc[1][qb][3]);
                pf[qb] = __builtin_bit_cast(bf16x8, w); }
            { const unsigned char* vb_ = lds + VOFF + (tt & 1) * VBYTES + hb * 64;
#pragma unroll
              for (int eb = 0; eb < 4; ++eb) {
                  const unsigned char* vp = vb_ + (eb * 16 + ql) * (VP * 2) + (g * 4) * 2;
                  const u32x2 lo = *(const u32x2*)vp, hi = *(const u32x2*)(vp + 32); const u32x4 w = (u32x4){lo.x, lo.y, hi.x, hi.y};
                  const bf16x8 vf = __builtin_bit_cast(bf16x8, w);
#pragma unroll
                  for (int qb = 0; qb < NQ; ++qb) o[eb][qb] = __builtin_amdgcn_mfma_f32_16x16x32_bf16(vf, pf[qb], o[eb][qb], 0, 0, 0);
              }
#pragma unroll
              for (int qb = 0; qb < NQ; ++qb) ol[qb] = __builtin_amdgcn_mfma_f32_16x16x32_bf16(ones, pf[qb], ol[qb], 0, 0, 0); }
          }
        }
        if (tt + 1 < nt) ATT_COMMIT((tt + 1) & 1);
        __syncthreads();
    }
#undef ATT_TILE
#undef ATT_SKIP
#undef ATT_ISSUE
#undef ATT_COMMIT
#pragma unroll
    for (int qb = 0; qb < NQ; ++qb) {
        const float inv = 1.f / ol[qb][0];
        bf16_t* op = Og + (size_t)(qw0 + qb * 16 + ql) * ldo + g * 4;
        if (Og)
#pragma unroll
        for (int eb = 0; eb < 4; ++eb) { u32x2 w; w.x = pk2(o[eb][qb][0] * inv, o[eb][qb][1] * inv); w.y = pk2(o[eb][qb][2] * inv, o[eb][qb][3] * inv); *(u32x2*)(op + eb * 16) = w; }
    }
}

constexpr int GL_BS = 0;
constexpr int GL_TOT = GL_BS + 64 * 65 * 4;
constexpr int GL_QE = GL_TOT + 8 * 64 * 4;
constexpr int GL_KE = GL_QE + 64 * 72 * 2;
constexpr int GL_ATT = GL_KE + 64 * 72 * 2;
constexpr int GL_VT = GL_ATT + 64 * 72 * 2;
constexpr int GL_O = GL_VT + 128 * 72 * 2;
constexpr int GL_END = GL_O + 64 * 132 * 4;
static_assert(GL_END <= 131072 && (GL_QE % 16) == 0 && (GL_VT % 16) == 0 && (GL_O % 16) == 0, "GLA LDS map");

__device__ __forceinline__ void gla_decay(unsigned char* lds, const float* glow_t0, const float* Wg  , const float* bg  , int dir) {
    float* Bs = (float*)(lds + GL_BS); float* Tot = (float*)(lds + GL_TOT); float* GLs = (float*)(lds + GL_O);
    int tid_ = threadIdx.x; asm volatile("" : "+v"(tid_)); const int tid = tid_;
    { const int s = tid >> 3, q = tid & 7;
      const float* gp = glow_t0 + (size_t)s * 32 + dir * 16 + q * 2;
      GLs[s * 16 + q * 2] = gp[0]; GLs[s * 16 + q * 2 + 1] = gp[1]; }
    const int d = tid & 63, seg = tid >> 6;
    float w[16];
#pragma unroll
    for (int r = 0; r < 16; ++r) w[r] = Wg[r * 256 + d];
    const float bias = bg[d];
    __syncthreads();
    float loc[8];
#pragma unroll
    for (int k = 0; k < 8; ++k) { const float* gl = GLs + (seg * 8 + k) * 16; float a = bias;
#pragma unroll
        for (int r = 0; r < 16; ++r) a += gl[r] * w[r];
        loc[k] = (fminf(a, 0.f) - __logf(1.f + __expf(-fabsf(a)))) * (1.f / 16.f); }
    float run = 0.f;
    if (dir == 0) {
#pragma unroll
        for (int k = 0; k < 8; ++k) { run += loc[k]; loc[k] = run; }
    } else {
#pragma unroll
        for (int k = 7; k >= 0; --k) { run += loc[k]; loc[k] = run; }
    }
    Tot[seg * 64 + d] = run;
    __syncthreads();
    float off = 0.f;
#pragma unroll
    for (int sg = 0; sg < 8; ++sg) { const float tv = Tot[sg * 64 + d]; if (dir == 0 ? (sg < seg) : (sg > seg)) off += tv; }
#pragma unroll
    for (int k = 0; k < 8; ++k) Bs[(seg * 8 + k) * 65 + d] = loc[k] + off;
    __syncthreads();
}
__device__ __forceinline__ void gla_load_vt(unsigned char* lds, const bf16_t* cv_t0  ) {
    bf16_t* Vt = (bf16_t*)(lds + GL_VT);
    int tid_ = threadIdx.x; asm volatile("" : "+v"(tid_)); const int tid = tid_;
#pragma unroll
    for (int r = 0; r < 2; ++r) { const int ci = tid + 512 * r, s = ci >> 4, eg = ci & 15;
        const u32x4 w = *(const u32x4*)(cv_t0 + (size_t)s * 512 + eg * 8);
        bf16_t* dst = Vt + (eg * 8) * 72 + s;
        dst[0 * 72] = (bf16_t)(w.x & 0xffffu); dst[1 * 72] = (bf16_t)(w.x >> 16); dst[2 * 72] = (bf16_t)(w.y & 0xffffu); dst[3 * 72] = (bf16_t)(w.y >> 16);
        dst[4 * 72] = (bf16_t)(w.z & 0xffffu); dst[5 * 72] = (bf16_t)(w.z >> 16); dst[6 * 72] = (bf16_t)(w.w & 0xffffu); dst[7 * 72] = (bf16_t)(w.w >> 16); }
}
__device__ __forceinline__ int gla_ord(int dir, int k) { return dir == 0 ? k : (k < 4 ? 3 - k : 135 - k); }

__device__ __forceinline__ void gla_state_item(unsigned char* lds, unsigned char* ws, const float* wgate, const float* bgate, int l, int item) {
    const int c = item % 132, dir = (item / 132) & 1, h = (item / 264) & 3, b = item / 1056;
    const int t0 = b * TB + c * 64;
    int tid_ = threadIdx.x; asm volatile("" : "+v"(tid_));
    const int tid = tid_, lane = tid & 63, wid = tid >> 6, ql = lane & 15, g = lane >> 4;
    const u32x4 kraw = *(const u32x4*)((const bf16_t*)(ws + O_CK) + (size_t)(t0 + (tid >> 3)) * 256 + h * 64 + (tid & 7) * 8);
    gla_load_vt(lds, (const bf16_t*)(ws + O_CV) + (size_t)t0 * 512 + h * 128);
    gla_decay(lds, (const float*)(ws + O_GLOW) + (size_t)t0 * 32, wgate + (size_t)((l * 2 + dir) * 16) * 256 + h * 64, bgate + (l * 2 + dir) * 256 + h * 64, dir);
    const float* Bs = (const float*)(lds + GL_BS); bf16_t* KDt = (bf16_t*)(lds + GL_KE);
    const int iend = dir == 0 ? 63 : 0;
    { const int s = tid >> 3, dg = tid & 7;
      float kv[8]; unpack8(kraw, kv);
#pragma unroll
      for (int e = 0; e < 8; ++e) { const int d = dg * 8 + e; KDt[d * 72 + s] = (bf16_t)f2bf(kv[e] * __expf(Bs[iend * 65 + d] - Bs[s * 65 + d])); } }
    if (tid < 64) ((float*)(ws + O_GD))[(size_t)item * 64 + tid] = __expf(Bs[iend * 65 + tid]);
    __syncthreads();
    const bf16_t* Vt = (const bf16_t*)(lds + GL_VT);
    f32x4 acc[4];
#pragma unroll
    for (int cb = 0; cb < 4; ++cb) acc[cb] = (f32x4){0.f, 0.f, 0.f, 0.f};
#pragma unroll
    for (int kk = 0; kk < 2; ++kk) {
        const bf16x8 a = *(const bf16x8*)(Vt + (wid * 16 + ql) * 72 + kk * 32 + g * 8);
#pragma unroll
        for (int cb = 0; cb < 4; ++cb) { const bf16x8 bb = *(const bf16x8*)(KDt + (cb * 16 + ql) * 72 + kk * 32 + g * 8); acc[cb] = __builtin_amdgcn_mfma_f32_16x16x32_bf16(a, bb, acc[cb], 0, 0, 0); }
    }
    bf16_t* st = (bf16_t*)(ws + O_ST) + (size_t)item * 8192;
#pragma unroll
    for (int cb = 0; cb < 4; ++cb)
#pragma unroll
        for (int j = 0; j < 4; ++j) st[(wid * 16 + g * 4 + j) * 64 + cb * 16 + ql] = (bf16_t)f2bf(acc[cb][j]);
    __syncthreads();
}

__device__ __forceinline__ void gla_scan(unsigned char* ws, int bid, int tid, int G) {
    bf16_t* ST = (bf16_t*)(ws + O_ST); const float* GD = (const float*)(ws + O_GD);
    for (int gidx = bid * NTHR + tid; gidx < 16 * 8192; gidx += G * NTHR) {
        const int seq = gidx >> 13, idx = gidx & 8191, d = idx & 63, dir = seq & 1;
        float s = 0.f;
        for (int k0 = 0; k0 < 132; k0 += 33) {
            float uv[33], dv[33];
#pragma unroll
            for (int u = 0; u < 33; ++u) { const int c = gla_ord(dir, k0 + u); uv[u] = bf2f(ST[(size_t)(seq * 132 + c) * 8192 + idx]); dv[u] = GD[(size_t)(seq * 132 + c) * 64 + d]; }
#pragma unroll
            for (int u = 0; u < 33; ++u) { const int c = gla_ord(dir, k0 + u); ST[(size_t)(seq * 132 + c) * 8192 + idx] = (bf16_t)f2bf(s); s = dv[u] * s + uv[u]; }
        }
    }
}

__device__ __forceinline__ void gla_out_item(unsigned char* lds, unsigned char* ws, const float* wgate, const float* bgate, const float* hnorm, int l, int item, bool dowrite = true) {
    const int c = item % 132, h = (item / 132) & 3, b = item / 528;
    const int t0 = b * TB + c * 64;
    int tid_ = threadIdx.x; asm volatile("" : "+v"(tid_));
    const int tid = tid_, lane = tid & 63, wid = tid >> 6, ql = lane & 15, g = lane >> 4;
    const float* Bs = (const float*)(lds + GL_BS);
    bf16_t* QE = (bf16_t*)(lds + GL_QE); bf16_t* KE = (bf16_t*)(lds + GL_KE); bf16_t* ATT = (bf16_t*)(lds + GL_ATT); const bf16_t* Vt = (const bf16_t*)(lds + GL_VT);
    const u32x4 qraw = *(const u32x4*)((const bf16_t*)(ws + O_CQ) + (size_t)(t0 + (tid >> 3)) * 256 + h * 64 + (tid & 7) * 8);
    const u32x4 kraw = *(const u32x4*)((const bf16_t*)(ws + O_CK) + (size_t)(t0 + (tid >> 3)) * 256 + h * 64 + (tid & 7) * 8);
    bf16x8 sfr[2][2];
#pragma unroll
    for (int dd = 0; dd < 2; ++dd)
#pragma unroll
        for (int kk = 0; kk < 2; ++kk) sfr[dd][kk] = *(const bf16x8*)((const bf16_t*)(ws + O_ST) + (size_t)(((b * 4 + h) * 2 + dd) * 132 + c) * 8192 + (wid * 16 + ql) * 64 + kk * 32 + g * 8);
    const u32x4 rraw0 = *(const u32x4*)((const bf16_t*)(ws + O_CR) + (size_t)(t0 + (tid >> 3)) * 512 + h * 128 + (tid & 7) * 16);
    const u32x4 rraw1 = *(const u32x4*)((const bf16_t*)(ws + O_CR) + (size_t)(t0 + (tid >> 3)) * 512 + h * 128 + (tid & 7) * 16 + 8);
    gla_load_vt(lds, (const bf16_t*)(ws + O_CV) + (size_t)t0 * 512 + h * 128);
    f32x4 oacc[4];
#pragma unroll
    for (int rb = 0; rb < 4; ++rb) oacc[rb] = (f32x4){0.f, 0.f, 0.f, 0.f};
    for (int dir = 0; dir < 2; ++dir) {
        gla_decay(lds, (const float*)(ws + O_GLOW) + (size_t)t0 * 32, wgate + (size_t)((l * 2 + dir) * 16) * 256 + h * 64, bgate + (l * 2 + dir) * 256 + h * 64, dir);
        { const int s = tid >> 3, dg = tid & 7;
          float qv[8], kv[8];
          unpack8(qraw, qv);
          unpack8(kraw, kv);
#pragma unroll
          for (int e = 0; e < 8; ++e) { const float bv = Bs[s * 65 + dg * 8 + e]; qv[e] *= __expf(bv); kv[e] *= __expf(-bv); }
          *(u32x4*)(QE + s * 72 + dg * 8) = pack8(qv); *(u32x4*)(KE + s * 72 + dg * 8) = pack8(kv); }
        __syncthreads();
        { const int rb = wid >> 1;
#pragma unroll
          for (int cc = 0; cc < 2; ++cc) { const int cb = (wid & 1) * 2 + cc; f32x4 a4 = (f32x4){0.f, 0.f, 0.f, 0.f};
#pragma unroll
              for (int kk = 0; kk < 2; ++kk) { const bf16x8 a = *(const bf16x8*)(QE + (rb * 16 + ql) * 72 + kk * 32 + g * 8); const bf16x8 bb = *(const bf16x8*)(KE + (cb * 16 + ql) * 72 + kk * 32 + g * 8);
                  a4 = __builtin_amdgcn_mfma_f32_16x16x32_bf16(a, bb, a4, 0, 0, 0); }
#pragma unroll
              for (int j = 0; j < 4; ++j) { const int i = rb * 16 + g * 4 + j, ip = cb * 16 + ql; const bool keep = dir == 0 ? (ip <= i) : (ip >= i); ATT[i * 72 + ip] = (bf16_t)f2bf(keep ? a4[j] : 0.f); } } }
        __syncthreads();
        { const int sidx = ((b * 4 + h) * 2 + dir) * 132 + c;
          const bf16_t* st = (const bf16_t*)(ws + O_ST) + (size_t)sidx * 8192;
#pragma unroll
          for (int kk = 0; kk < 2; ++kk) {
              const bf16x8 bv = *(const bf16x8*)(Vt + (wid * 16 + ql) * 72 + kk * 32 + g * 8);
              const bf16x8 bs = dir == 0 ? sfr[0][kk] : sfr[1][kk];
#pragma unroll
              for (int rb = 0; rb < 4; ++rb) {
                  const bf16x8 a1 = *(const bf16x8*)(ATT + (rb * 16 + ql) * 72 + kk * 32 + g * 8);
                  const bf16x8 a2 = *(const bf16x8*)(QE + (rb * 16 + ql) * 72 + kk * 32 + g * 8);
                  oacc[rb] = __builtin_amdgcn_mfma_f32_16x16x32_bf16(a1, bv, oacc[rb], 0, 0, 0);
                  oacc[rb] = __builtin_amdgcn_mfma_f32_16x16x32_bf16(a2, bs, oacc[rb], 0, 0, 0);
              } } }
        __syncthreads();
    }
    float* Os = (float*)(lds + GL_O);
#pragma unroll
    for (int rb = 0; rb < 4; ++rb)
#pragma unroll
        for (int j = 0; j < 4; ++j) Os[(rb * 16 + g * 4 + j) * 132 + wid * 16 + ql] = oacc[rb][j];
    __syncthreads();
    { const int i = tid >> 3, eg = tid & 7;
      float ov[16]; float ss = 0.f;
#pragma unroll
      for (int e = 0; e < 16; ++e) { ov[e] = Os[i * 132 + eg * 16 + e]; ss += ov[e] * ov[e]; }
      ss += __shfl_xor(ss, 1); ss += __shfl_xor(ss, 2); ss += __shfl_xor(ss, 4);
      const float rstd = rsqrtf(ss * (1.f / 128.f) + EPS);
      const float* gn = hnorm + l * 512 + h * 128 + eg * 16;
      bf16_t* rp = (bf16_t*)(ws + O_CR) + (size_t)(t0 + i) * 512 + h * 128 + eg * 16;
#pragma unroll
      for (int hh = 0; hh < 2; ++hh) { float rv[8]; unpack8(hh == 0 ? rraw0 : rraw1, rv);
#pragma unroll
          for (int e = 0; e < 8; ++e) rv[e] = ov[hh * 8 + e] * rstd * gn[hh * 8 + e] * siluf_(rv[e]);
          if (dowrite) *(u32x4*)(rp + hh * 8) = pack8(rv); } }
    __syncthreads();
}

#ifndef REPK
#define REPK 0
#endif
#ifndef REP_SYNC
#define REP_SYNC 0
#endif
#ifndef ASEL
#define ASEL 31
#endif
#ifndef PM
#define PM 0xffff
#endif
#define ON(k) (((PM) >> (k)) & 1)
typedef const __attribute__((address_space(4))) Args* CArgsP;
__global__ void __launch_bounds__(NTHR, 2) mk_fwd(Args args) {
    extern __shared__ __attribute__((aligned(16))) unsigned char lds[];
    cg::grid_group grid = cg::this_grid();
    volatile LASX unsigned* misc = (volatile LASX unsigned*)((LASX unsigned char*)lds + 131072 + 512);
    if (threadIdx.x < 16) misc[threadIdx.x] = 0u;
    __syncthreads();
    XcdBarrier xbar = xcd_barrier_post((unsigned*)(args.ws + O_BAR), misc + 8);
    if (args.ph_hi < 0) grid.sync();
    int rep = 0;
    for (int ph = args.ph_lo; ph < args.ph_hi; ) {
        int tid_k = threadIdx.x; asm volatile("" : "+v"(tid_k));
        const int tid = tid_k, lane = tid & 63, wid = __builtin_amdgcn_readfirstlane(tid >> 6);
        int G_k = gridDim.x, bid_k = blockIdx.x; asm volatile("" : "+s"(G_k), "+s"(bid_k));
        const int G = G_k, bid = bid_k, gw = bid * NWAVES + wid, NGW = G * NWAVES;
        CArgsP ap = (CArgsP)__builtin_amdgcn_kernarg_segment_ptr(); asm volatile("" : "+s"(ap));
        unsigned char* ws = ap->ws;
        float* MOD = (float*)(ws + O_MOD); float* X = (float*)(ws + O_X); bf16_t* HM = (bf16_t*)(ws + O_HM);
        if (ON(11) && ph == 0) {
            float* sv = (float*)lds; float* red = sv + 3072;
            for (int item = bid; item < 4 * 48; item += G) {
                const int l = item / 48, n0 = (item % 48) * 128;
                for (int idx = tid; idx < 3072; idx += NTHR) { const int r = idx >> 10, k = idx & 1023; const float cv = (r < 2) ? ap->in[I_C][r * 1024 + k] : ap->in[I_CCTX][k]; sv[idx] = siluf_(cv); }
                __syncthreads();
                const int kq = tid >> 7, nn = tid & 127; float a0 = 0.f, a1 = 0.f, a2 = 0.f;
                const float* wp = ap->in[I_WMOD] + ((size_t)l * 1024 + kq * 256) * 6144 + n0 + nn;
#pragma unroll 32
                for (int k = 0; k < 256; ++k) { const float w = __builtin_nontemporal_load(wp + (size_t)k * 6144); a0 += sv[kq * 256 + k] * w; a1 += sv[1024 + kq * 256 + k] * w; a2 += sv[2048 + kq * 256 + k] * w; }
                red[(kq * 3 + 0) * 128 + nn] = a0; red[(kq * 3 + 1) * 128 + nn] = a1; red[(kq * 3 + 2) * 128 + nn] = a2;
                __syncthreads();
                if (tid < 384) { const int r = tid >> 7, n2 = tid & 127; float a = ap->in[I_BMOD][l * 6144 + n0 + n2];
                    for (int q = 0; q < 4; ++q) a += red[(q * 3 + r) * 128 + n2];
                    MOD[(l * 3 + r) * 6144 + n0 + n2] = a; }
                __syncthreads();
            }
            float* RA = (float*)(ws + O_ROPEA); float* RB = (float*)(ws + O_ROPEB);
            for (int idx = bid * NTHR + tid; idx < 8192 * 32; idx += G * NTHR) { const int pos = idx >> 5, j = idx & 31;
                const float inv = exp2f(-(float)(j & 15) * (13.287712379549449f / 16.f)); const float p = (j < 16) ? (float)(pos >> 6) : (float)(pos & 63); const float ang = p * inv;
                RA[pos * 64 + j] = __cosf(ang); RA[pos * 64 + 32 + j] = __sinf(ang); }
            for (int idx = bid * NTHR + tid; idx < 8192 * 16; idx += G * NTHR) { const int pos = idx >> 4, j = idx & 15;
                const float inv = exp2f(-(float)(j & 7) * (13.287712379549449f / 8.f)); const float p = (j < 8) ? (float)(pos >> 6) : (float)(pos & 63); const float ang = p * inv;
                RB[pos * 32 + j] = __cosf(ang); RB[pos * 32 + 16 + j] = __sinf(ang); }
        } else if (ON(12) && ph == 45) {
            for (int r = gw; r < NB * SEQ; r += NGW) { const int b = r >> 13, s = r & 8191;
                const f32x4* xr = (const f32x4*)(X + (size_t)(b * TB + LC + s) * 1024) + lane; f32x4 v[4]; float ss = 0.f;
#pragma unroll
                for (int j = 0; j < 4; ++j) { v[j] = xr[64 * j]; ss += (v[j][0] * v[j][0] + v[j][1] * v[j][1]) + (v[j][2] * v[j][2] + v[j][3] * v[j][3]); }
                const float rstd = rsqrtf(wave_sum(ss) * (1.f / 1024.f) + EPS);
#pragma unroll
                for (int j = 0; j < 4; ++j) { const f32x4 w = ((const f32x4*)ap->in[I_FNORM])[64 * j + lane]; f32x4 o; o[0] = v[j][0] * rstd * w[0]; o[1] = v[j][1] * rstd * w[1]; o[2] = v[j][2] * rstd * w[2]; o[3] = v[j][3] * rstd * w[3];
                    ((f32x4*)(ap->out + (size_t)r * 1024))[64 * j + lane] = o; } }
        } else {
            const int l = (ph - 1) / 11, k = (ph - 1) % 11;
            const float* modl = MOD + l * 3 * 6144;
            if (ON(0) && k == 0) {
                float* scr = (float*)lds + wid * (64 * 33);
                constexpr int I0 = 184 * 16, I1 = I0 + 24 * 4, I2 = I1 + 32 * 4, I3 = I2 + 3 * 32 * 8, I4 = I3 + 32 * 16, I5 = I4 + 176 * 16, I6 = I5 + 32 * 44;
                for (int it = gw; it < I6; it += NGW) {
                    if (it < I0) transpose_item(ap->in[I_WIN] + (size_t)l * 1024 * IN_DIM, 1024, IN_DIM, (bf16_t*)(ws + O_WIN), 1024, it, MAT_IN, nullptr, scr, lane);
                    else if (it < I1) transpose_item(ap->in[I_WUQ] + (size_t)l * 256 * 768, 256, 768, (bf16_t*)(ws + O_WUQ), 256, it - I0, MAT_UQ, ap->in[I_QNORM] + l * 256, scr, lane);
                    else if (it < I2) transpose_item(ap->in[I_WUKV] + (size_t)l * 128 * 1024, 128, 1024, (bf16_t*)(ws + O_WUKV), 256, it - I1, MAT_PLAIN, ap->in[I_KVNORM] + l * 128, scr, lane);
                    else if (it < I3) { const int r = it - I2, br = r / 256; const float* src = (br == 0 ? ap->in[I_WBRA] : (br == 1 ? ap->in[I_WBRB] : ap->in[I_WBRC])) + (size_t)l * 512 * 1024;
                        transpose_item(src, 512, 1024, (bf16_t*)(ws + O_WBR) + (size_t)br * 1024 * 512, 512, r - br * 256, MAT_PLAIN, nullptr, scr, lane); }
                    else if (it < I4) transpose_item(ap->in[I_WOUT] + (size_t)l * 1024 * 1024, 1024, 1024, (bf16_t*)(ws + O_WOUT), 1024, it - I3, MAT_PLAIN, nullptr, scr, lane);
                    else if (it < I5) transpose_item(ap->in[I_WUP] + (size_t)l * 1024 * FF2, 1024, FF2, (bf16_t*)(ws + O_WUP), 1024, it - I4, MAT_PLAIN, nullptr, scr, lane);
                    else transpose_item(ap->in[I_WDOWN] + (size_t)l * FF * 1024, FF, 1024, (bf16_t*)(ws + O_WDOWN), FF, it - I5, MAT_PLAIN, nullptr, scr, lane);
                }
                for (int idx = bid * NTHR + tid; idx < MT * 2; idx += G * NTHR) ((float*)(ws + O_SSQ))[idx] = 0.f;
#define NORM1_PAR(P, t) do { const int b = ((t) >= TB) ? 1 : 0, i = (t) - b * TB, r = (i >= LC) ? b : 2; \
                    P.src = X + (size_t)(t) * 1024; P.cp = nullptr; P.part = nullptr; P.gv = nullptr; P.nsl = 11; \
                    if (l == 0) { P.src = (i >= LC) ? ap->in[I_X] + ((size_t)b * SEQ + (i - LC)) * 1024 : ap->in[I_CTX] + ((size_t)b * LC + i) * 1024; P.cp = X + (size_t)(t) * 1024; } \
                    if (l > 0 && i < LC) { P.part = (const float*)(ws + O_U) + (size_t)(b * 256 + i) * 1024; P.gv = MOD + ((l - 1) * 3 + 2) * 6144 + 5120; P.cp = X + (size_t)(t) * 1024; } \
                    P.sc = modl + r * 6144 + 1024; P.sh = modl + r * 6144; P.orow = HM + (size_t)(t) * 1024; } while (0)
                for (int t = gw; t < MT; t += 2 * NGW) {
                    const int tB = t + NGW; const bool hb = tB < MT;
                    const int tBc = hb ? tB : t;
                    NormPar PA, PB; NormRow RA, RB; NORM1_PAR(PA, t); NORM1_PAR(PB, tBc);
                    norm_load(RA, PA, lane); norm_load(RB, PB, lane);
                    norm_finish(RA, PA, ap->in[I_NMIX] + l * 1024, lane); if (hb) norm_finish(RB, PB, ap->in[I_NMIX] + l * 1024, lane);
                }
#undef NORM1_PAR
            } else if (ON(1) && k == 1) {
                EpiIn E{ws}; run_gemm(lds, HM, (const bf16_t*)(ws + O_WIN), MT, NPIN, 1024, E);
            } else if (ON(2) && k == 2) {
                if (ON(13)) { EpiUq E{ws}; run_gemm(lds, (const bf16_t*)(ws + O_CQB), (const bf16_t*)(ws + O_WUQ), MT, 768, 256, E); }
                if (ON(14)) { EpiUkv E{ws}; run_gemm(lds, (const bf16_t*)(ws + O_CKVB), (const bf16_t*)(ws + O_WUKV), MT, 1024, 256, E); }
                if (ON(15)) for (int item = bid; item < 2112; item += G) gla_state_item(lds, ws, ap->in[I_WGATE], ap->in[I_BGATE], l, item);
            } else if (ON(3) && k == 3) {
                if ((ASEL & 16) && rep == 0) gla_scan(ws, bid, tid, G);
                for (int L = bid; L < (rep == 0 ? 544 : 256); L += G) {
                    const int npass = (PROBE_AA && L >= 256 && L < 768) ? 2 : 1;
                    for (int pass = 0; pass < npass; ++pass) {
                    if ((ASEL & 1) && L < 256) { const int bh_ = (L & 7) + 8 * ((L >> 3) & 1), b = bh_ >> 3, h = bh_ & 7, qs = L >> 4;
                        attn_unit<96, false, 4>(lds, (const bf16_t*)(ws + O_QB) + (size_t)b * TB * 768 + h * 96, 768, (const bf16_t*)(ws + O_KB) + (size_t)b * TB * 768 + h * 96, 768,
                                             (const bf16_t*)(ws + O_VBT) + (size_t)(b * 8 + h) * 64 * TB, (bf16_t*)(ws + O_YB) + (size_t)b * TB * 512 + h * 64, 512, LC + qs * 512, 0, 132, 0, 0, 0.f, false);
                    } else if ((ASEL & 2) && L >= 256 && L < 512) { const int L2 = L - 256, bh_ = (L2 & 7) + 8 * ((L2 >> 3) & 1), b = bh_ >> 3, h = bh_ & 7, qs = L2 >> 4, kvh = h >> 2;
                        const int p0 = qs * 512, lo = (p0 - 128 < 0) ? 0 : p0 - 128, hi = (p0 + 640 > SEQ) ? SEQ : p0 + 640;
                        bf16_t* qo = (bf16_t*)(ws + O_QA) + (size_t)b * TB * 512 + h * 64;
                        attn_unit<64, true, 4>(lds, qo, 512, (const bf16_t*)(ws + O_KA) + (size_t)b * TB * 128 + kvh * 64, 128, (const bf16_t*)(ws + O_VAT) + (size_t)(b * 2 + kvh) * 64 * TB,
                                            qo, 512, LC + p0, 0, 4, (lo + LC) / 64, (hi - lo) / 64, ap->in[I_SINK][l * 8 + h] * LOG2E, true);
                    } else if ((ASEL & 4) && L >= 512 && L < 528) { const int L2 = L - 512, b = L2 >> 3, h = L2 & 7;
                        attn_unit<96, false, 2>(lds, (const bf16_t*)(ws + O_QB) + (size_t)b * TB * 768 + h * 96, 768, (const bf16_t*)(ws + O_KB) + (size_t)b * TB * 768 + h * 96, 768,
                                             (const bf16_t*)(ws + O_VBT) + (size_t)(b * 8 + h) * 64 * TB, (bf16_t*)(ws + O_YB) + (size_t)b * TB * 512 + h * 64, 512, 0, 0, 4, 0, 0, 0.f, false);
                    } else if ((ASEL & 8) && L >= 528) { const int L2 = L - 528, b = L2 >> 3, h = L2 & 7, kvh = h >> 2;
                        bf16_t* qo = (bf16_t*)(ws + O_QA) + (size_t)b * TB * 512 + h * 64;
                        attn_unit<64, false, 2>(lds, qo, 512, (const bf16_t*)(ws + O_KA) + (size_t)b * TB * 128 + kvh * 64, 128, (const bf16_t*)(ws + O_VAT) + (size_t)(b * 2 + kvh) * 64 * TB,
                                             qo, 512, 0, 0, 4, 0, 0, ap->in[I_SINK][l * 8 + h] * LOG2E, true);
                    }
                    }
                }
            } else if (ON(4) && k == 4) {
                if (PROBE_GC) for (int item = bid; item < 1056; item += G) gla_out_item(lds, ws, ap->in[I_WGATE], ap->in[I_BGATE], ap->in[I_HNORM], l, item, false);
                for (int item = bid; item < 1056; item += G) gla_out_item(lds, ws, ap->in[I_WGATE], ap->in[I_BGATE], ap->in[I_HNORM], l, item);
            } else if (ON(5) && k == 5) {
                { EpiMerge<0> E{ws}; run_gemm_main(lds, (const bf16_t*)(ws + O_QA), (const bf16_t*)(ws + O_WBR), 1024, 512, E); }
                { EpiMerge<1> E{ws}; run_gemm_main(lds, (const bf16_t*)(ws + O_YB), (const bf16_t*)(ws + O_WBR) + (size_t)1024 * 512, 1024, 512, E); }
                { EpiMerge<2> E{ws}; run_gemm_main(lds, (const bf16_t*)(ws + O_CR), (const bf16_t*)(ws + O_WBR) + (size_t)2 * 1024 * 512, 1024, 512, E); }
                { EpiMergePart<0> E{ws, 256 * 2}; run_gemm_ctx(lds, (const bf16_t*)(ws + O_QA), (const bf16_t*)(ws + O_WBR), 1024, 512, 2, E, 64); }
                { EpiMergePart<1> E{ws, 256 * 2}; run_gemm_ctx(lds, (const bf16_t*)(ws + O_YB), (const bf16_t*)(ws + O_WBR) + (size_t)1024 * 512, 1024, 512, 2, E, 96); }
                { EpiMergePart<2> E{ws, 256 * 2}; run_gemm_ctx(lds, (const bf16_t*)(ws + O_CR), (const bf16_t*)(ws + O_WBR) + (size_t)2 * 1024 * 512, 1024, 512, 2, E, 128); }
            } else if (ON(6) && k == 6) {
                for (int r = gw; r < 512; r += NGW) { const int t = (r < 256) ? r : (TB + r - 256);
                    const f32x4* sp = (const f32x4*)((const float*)(ws + O_CQ) + (size_t)r * 1024);
#pragma unroll
                    for (int j = 0; j < 4; ++j) { f32x4 a = sp[64 * j + lane];
#pragma unroll
                        for (int q = 1; q < 6; ++q) a = a + sp[(size_t)q * 512 * 256 + 64 * j + lane];
                        u32x2 o; o.x = pk2(a[0], a[1]); o.y = pk2(a[2], a[3]); ((u32x2*)(HM + (size_t)t * 1024))[64 * j + lane] = o; } }
                xcd_barrier(xbar);
                if (PROBE_OD) { EpiNull E{(float*)(ws + O_SSQ)}; run_gemm_main(lds, HM, (const bf16_t*)(ws + O_WOUT), 1024, 1024, E); run_gemm_ctx(lds, HM, (const bf16_t*)(ws + O_WOUT), 1024, 1024, 4, E); }
                { EpiResid E{ws, modl, 2048}; run_gemm_main(lds, HM, (const bf16_t*)(ws + O_WOUT), 1024, 1024, E); }
                { EpiPartial E{(float*)(ws + O_GATES), 256 * 2}; run_gemm_ctx(lds, HM, (const bf16_t*)(ws + O_WOUT), 1024, 1024, 4, E); }
            } else if (ON(7) && k == 7) {
#define NORM2_PAR(P, t) do { const int b = ((t) >= TB) ? 1 : 0, i = (t) - b * TB, r = (i >= LC) ? b : 2; \
                    P.src = X + (size_t)(t) * 1024; P.cp = nullptr; P.part = nullptr; P.gv = nullptr; P.nsl = 4; \
                    if (i < LC) { P.part = (const float*)(ws + O_GATES) + (size_t)(b * 256 + i) * 1024; P.gv = modl + 2 * 6144 + 2048; P.cp = X + (size_t)(t) * 1024; } \
                    P.sc = modl + r * 6144 + 4096; P.sh = modl + r * 6144 + 3072; P.orow = HM + (size_t)(t) * 1024; } while (0)
                for (int t = gw; t < MT; t += 2 * NGW) {
                    const int tB = t + NGW; const bool hb = tB < MT;
                    const int tBc = hb ? tB : t;
                    NormPar PA, PB; NormRow RA, RB; NORM2_PAR(PA, t); NORM2_PAR(PB, tBc);
                    norm_load(RA, PA, lane); norm_load(RB, PB, lane);
                    norm_finish(RA, PA, ap->in[I_NFFN] + l * 1024, lane); if (hb) norm_finish(RB, PB, ap->in[I_NFFN] + l * 1024, lane);
                }
#undef NORM2_PAR
            } else if (ON(8) && k == 8) {
                EpiStore E{(bf16_t*)(ws + O_U), FF2}; run_gemm(lds, HM, (const bf16_t*)(ws + O_WUP), MT, FF2, 1024, E);
            } else if (ON(9) && k == 9) {
                const bf16_t* U = (const bf16_t*)(ws + O_U); bf16_t* ACT = (bf16_t*)(ws + O_ACT);
                const float* cw = ap->in[I_CONVW] + (size_t)l * 3 * FF2; const float* cb = ap->in[I_CONVB] + (size_t)l * FF2;
#pragma unroll 1
                for (int idx = bid * NTHR + tid; idx < (MT / 16) * 352; idx += G * NTHR) {
                    const int tb = idx / 352, j0 = (idx - tb * 352) * 8; const int t0 = tb * 16; const int b = (t0 >= TB) ? 1 : 0, i0 = t0 - b * TB;
                    float wg0[8], wg1[8], wg2[8], bg[8], wv0[8], wv1[8], wv2[8], bv[8];
#pragma unroll
                    for (int e = 0; e < 8; ++e) { wg0[e] = cw[j0 + e]; wg1[e] = cw[FF2 + j0 + e]; wg2[e] = cw[2 * FF2 + j0 + e]; bg[e] = cb[j0 + e];
                        wv0[e] = cw[FF + j0 + e]; wv1[e] = cw[FF2 + FF + j0 + e]; wv2[e] = cw[2 * FF2 + FF + j0 + e]; bv[e] = cb[FF + j0 + e]; }
                    const bf16_t* up = U + (size_t)t0 * FF2 + j0;
                    u32x4 gp_ = (u32x4){0u, 0u, 0u, 0u}, vp_ = (u32x4){0u, 0u, 0u, 0u};
                    if (i0 != 0 && i0 != LC) { gp_ = *(const u32x4*)(up - FF2); vp_ = *(const u32x4*)(up - FF2 + FF); }
                    u32x4 gc_ = *(const u32x4*)up, vc_ = *(const u32x4*)(up + FF);
#pragma unroll 4
                    for (int r = 0; r < 16; ++r) {
                        u32x4 gn_ = (u32x4){0u, 0u, 0u, 0u}, vn_ = (u32x4){0u, 0u, 0u, 0u};
                        const int ii = i0 + r;
                        if (ii != LC - 1 && ii != TB - 1) { gn_ = *(const u32x4*)(up + (size_t)(r + 1) * FF2); vn_ = *(const u32x4*)(up + (size_t)(r + 1) * FF2 + FF); }
                        float gm[8], gc[8], gn[8], vm[8], vc[8], vn[8], o[8];
                        unpack8(gp_, gm); unpack8(gc_, gc); unpack8(gn_, gn); unpack8(vp_, vm); unpack8(vc_, vc); unpack8(vn_, vn);
#pragma unroll
                        for (int e = 0; e < 8; ++e) {
                            const float a = wg0[e] * gm[e] + wg1[e] * gc[e] + wg2[e] * gn[e] + bg[e];
                            const float v = wv0[e] * vm[e] + wv1[e] * vc[e] + wv2[e] * vn[e] + bv[e];
                            o[e] = siluf_(a) * v;
                        }
                        *(u32x4*)(ACT + (size_t)(t0 + r) * FF + j0) = pack8(o);
                        gp_ = gc_; vp_ = vc_; gc_ = gn_; vc_ = vn_;
                    }
                }
            } else if (ON(10) && k == 10) {
                if (PROBE_OD) { EpiNull E{(float*)(ws + O_SSQ)}; run_gemm_main(lds, (const bf16_t*)(ws + O_ACT), (const bf16_t*)(ws + O_WDOWN), 1024, FF, E); run_gemm_ctx(lds, (const bf16_t*)(ws + O_ACT), (const bf16_t*)(ws + O_WDOWN), 1024, FF, 11, E); }
                { EpiResid E{ws, modl, 5120}; run_gemm_main(lds, (const bf16_t*)(ws + O_ACT), (const bf16_t*)(ws + O_WDOWN), 1024, FF, E); }
                { EpiPartial E{(float*)(ws + O_U), 256 * 2}; run_gemm_ctx(lds, (const bf16_t*)(ws + O_ACT), (const bf16_t*)(ws + O_WDOWN), 1024, FF, 11, E); }
            }
        }
        { const int kk_ = (ph >= 1 && ph <= 44) ? (ph - 1) % 11 : 15;
          const bool again = (rep == 0) && (((REPK) >> kk_) & 1);
          if (again) rep = 1; else { rep = 0; ++ph; }
          if (again || ph < args.ph_hi) { xcd_barrier(xbar); if (REP_SYNC) xcd_barrier(xbar); } }
    }
}

constexpr int N_PHASES = 46;
extern "C" void kernel_launch(void* const* d_in, const int* in_sizes, int n_in, void* d_out, int out_size, void* d_ws, size_t ws_size, hipStream_t stream) {
    static int grid = 0;
    if (grid == 0) {
        if (n_in != N_IN || ws_size < O_END) { fprintf(stderr, "kernel_launch: bad shapes: n_in %d ws %zu (need %zu)\n", n_in, ws_size, (size_t)O_END); grid = -1; return; }
        int dev = 0, cus = 0, per_cu = 0;
        hipGetDevice(&dev); hipDeviceGetAttribute(&cus, hipDeviceAttributeMultiprocessorCount, dev);
        if (hipFuncSetAttribute((const void*)mk_fwd, hipFuncAttributeMaxDynamicSharedMemorySize, LDS_BYTES) != hipSuccess) { fprintf(stderr, "kernel_launch: hipFuncSetAttribute failed\n"); grid = -1; return; }
        hipOccupancyMaxActiveBlocksPerMultiprocessor(&per_cu, (const void*)mk_fwd, NTHR, LDS_BYTES);
        (void)hipGetLastError();
        if (per_cu < 1) per_cu = 1;
        grid = cus * 1;
        fprintf(stderr, "kernel_launch: cus %d per_cu %d grid %d\n", cus, per_cu, grid);
    }
    if (grid < 0) return;
    if (hipMemsetAsync((char*)d_ws + O_BAR, 0, 16384, stream) != hipSuccess) { fprintf(stderr, "kernel_launch: memset failed\n"); return; }
    Args a{};
    for (int i = 0; i < N_IN; ++i) a.in[i] = (const float*)d_in[i];
    a.out = (float*)d_out; a.ws = (unsigned char*)d_ws;
#if ONE_LAUNCH
    a.ph_lo = 0; a.ph_hi = N_PHASES;
    void* kargs[] = {&a};
    hipError_t e = hipLaunchCooperativeKernel((const void*)mk_fwd, dim3(grid), dim3(NTHR), kargs, LDS_BYTES, stream);
    if (e != hipSuccess) fprintf(stderr, "cooperative launch failed: %s (grid %d)\n", hipGetErrorString(e), grid);
#else
    for (int ph = 0; ph < N_PHASES; ++ph) { a.ph_lo = ph; a.ph_hi = ph + 1; hipLaunchKernelGGL(mk_fwd, dim3(grid), dim3(NTHR), LDS_BYTES, stream, a); }
#endif
}
```

```cpp
#include <hip/hip_runtime.h>
#include <hip/hip_cooperative_groups.h>
#include <cstdio>
#include <cstdint>
namespace cg = cooperative_groups;
#ifndef ONE_LAUNCH
#define ONE_LAUNCH 1
#endif
namespace pg8 {
#define PG8_LAS __attribute__((address_space(3)))
typedef unsigned short bf16_t;
typedef short bf16x8 __attribute__((ext_vector_type(8)));
typedef float f32x4 __attribute__((ext_vector_type(4)));
typedef unsigned u32x4 __attribute__((ext_vector_type(4)));
constexpr int BM = 256, BK = 64, HALF = 128, HTB = HALF * BK * 2  , STAGE_BYTES = 8 * HTB, NXCD = 8, WGM = 8;

__host__ __device__ __forceinline__ int lds_byte(int r, int c) { const int st = (r >> 4) * 2 + (c >> 5), rr = r & 15, cc = c & 31, ob = rr * 64 + cc * 2; return st * 1024 + (ob ^ (((ob >> 9) & 1) << 5)); }
__host__ __device__ __forceinline__ void stage_rc(int b, int& R, int& C) { const int st = b / 1024, sb = b % 1024, swz = sb ^ (((sb >> 9) & 1) << 5); R = (st >> 1) * 16 + swz / 64; C = (st & 1) * 32 + (swz % 64) / 2; }
__host__ __device__ __forceinline__ int perm32(int rho) { const int n = rho >> 4, i = rho & 15; return 8 * (i >> 2) + 4 * n + (i & 3); }

struct Unit { int pm, pn, kb; };
struct Gemm { const bf16_t* A; const bf16_t* Bt; int M, N, K, Kloop; };

struct StaticOrder {
    int nM, nN, nwg, G, c;
    __host__ __device__ void init(int M, int N, int G_, int c_) { nM = M / BM; nN = N / BM; nwg = nM * nN; G = G_; c = c_; }
    __host__ __device__ bool next(int i, Unit& u) const {
        const long L = (long)i * G + c; if (L >= nwg) return false;
        int wgid = (int)L; { const int q = nwg / NXCD, r = nwg % NXCD, xcd = wgid % NXCD, off = wgid / NXCD; wgid = (xcd < r ? xcd * (q + 1) : r * (q + 1) + (xcd - r) * q) + off; }
        const int nig = WGM * nN, gid = wgid / nig, fm = gid * WGM, gsz = (nM - fm) < WGM ? (nM - fm) : WGM;
        u.pm = fm + ((wgid % nig) % gsz); u.pn = (wgid % nig) / gsz; u.kb = 0; return true;
    }
    __device__ __forceinline__ void a_ready(const Unit&) const {}
    __device__ __forceinline__ void done(const Unit&) const {}
};

__device__ __forceinline__ unsigned cvt_pk_bf16(float lo, float hi) { unsigned r; asm volatile("v_cvt_pk_bf16_f32 %0, %1, %2" : "=v"(r) : "v"(lo), "v"(hi)); return r; }
template <class Epi, class Sched, bool ALIGN_EPI = false, bool SP2 = false>
__device__ __forceinline__ void gemm_phase(PG8_LAS unsigned char* lds, const Gemm g, const Sched& S, const Epi& E) {
    int tid_ = threadIdx.x; asm volatile("" : "+v"(tid_));
    const int tid = tid_, wid = __builtin_amdgcn_readfirstlane(tid >> 6), lane = tid & 63, wr = wid >> 2, wc = wid & 3, fr = lane & 15, fq = lane >> 4;
    const int K = g.K, nt = g.Kloop / BK;
    unsigned voffA[2], voffB[2];
#pragma unroll
    for (int i = 0; i < 2; ++i) { int R, C; stage_rc(tid * 16 + i * 8192, R, C); const int Rb = Epi::PERM ? ((R & ~31) + perm32(R & 31)) : R;
        voffA[i] = (unsigned)(R * K + C) * 2u; voffB[i] = (unsigned)(Rb * K + C) * 2u; }
    const size_t kstep = (size_t)(BK * 2);
    const size_t hstep = (size_t)HALF * K * 2;
    const size_t tstep = 2 * hstep;
    const unsigned ldsw = (unsigned)wid * 1024u;
    const int aoff = lds_byte(wr * 64 + fr, fq * 8), boff = lds_byte(wc * 32 + fr, fq * 8);
#define PG8_SA(b, h) (((b) * 2 + (h)) * HTB)
#define PG8_SB(b, h) ((4 + (b) * 2 + (h)) * HTB)
#define PG8_STAGE(bufoff, gbase, voff) do { _Pragma("unroll") for (int _i = 0; _i < 2; ++_i) \
        __builtin_amdgcn_global_load_lds((const unsigned*)((const char*)(gbase) + (voff)[_i]), (PG8_LAS unsigned*)(lds + (bufoff) + ldsw + _i * 8192), 16, 0, 0); } while (0)
#define PG8_LDA(dst, b, h) do { _Pragma("unroll") for (int m = 0; m < 4; ++m) _Pragma("unroll") for (int k = 0; k < 2; ++k) dst[m][k] = *(const PG8_LAS bf16x8*)(lds + PG8_SA(b, h) + aoff + m * 2048 + k * 1024); } while (0)
#define PG8_LDB(dst, b, h) do { _Pragma("unroll") for (int n = 0; n < 2; ++n) _Pragma("unroll") for (int k = 0; k < 2; ++k) dst[n][k] = *(const PG8_LAS bf16x8*)(lds + PG8_SB(b, h) + boff + n * 2048 + k * 1024); } while (0)
#define PG8_MMA(ai, bj, At, Bt) do { __builtin_amdgcn_s_setprio(1); _Pragma("unroll") for (int m = 0; m < 4; ++m) _Pragma("unroll") for (int n = 0; n < 2; ++n) _Pragma("unroll") for (int k = 0; k < 2; ++k) \
        acc[ai][bj][m][n] = __builtin_amdgcn_mfma_f32_16x16x32_bf16(Bt[n][k], At[m][k], acc[ai][bj][m][n], 0, 0, 0); __builtin_amdgcn_s_setprio(0); } while (0)
#define PG8_WAIT_V(n) asm volatile("s_waitcnt vmcnt(" #n ")" ::: "memory")
#define PG8_WAIT_L(n) asm volatile("s_waitcnt lgkmcnt(" #n ")" ::: "memory")
#define PG8_BAR __builtin_amdgcn_s_barrier()
#define PG8_SCHED __builtin_amdgcn_sched_barrier(0)
    Unit cur, nxt; int ui = 0;
    if (!S.next(0, cur)) return;
    f32x4 acc[2][2][4][2];
#pragma unroll
    for (int a = 0; a < 2; ++a)
#pragma unroll
        for (int b = 0; b < 2; ++b)
#pragma unroll
            for (int m = 0; m < 4; ++m)
#pragma unroll
                for (int n = 0; n < 2; ++n) acc[a][b][m][n] = (f32x4){0.f, 0.f, 0.f, 0.f};
    bf16x8 At[4][2], B0[2][2], B1[2][2];
    const char* cA = (const char*)g.A + (size_t)cur.pm * tstep + cur.kb; const char* cB = (const char*)g.Bt + (size_t)cur.pn * tstep + cur.kb;
    S.a_ready(cur);
    if constexpr (SP2) {
        PG8_STAGE(PG8_SB(0, 0), cB, voffB); PG8_STAGE(PG8_SB(0, 1), cB + hstep, voffB); PG8_STAGE(PG8_SA(0, 0), cA, voffA); PG8_STAGE(PG8_SA(0, 1), cA + hstep, voffA);
        if (wr == 1) PG8_BAR;
        PG8_WAIT_V(2); PG8_BAR;
        PG8_STAGE(PG8_SB(1, 0), cB + kstep, voffB); PG8_STAGE(PG8_SA(1, 0), cA + kstep, voffA); PG8_STAGE(PG8_SB(1, 1), cB + hstep + kstep, voffB);
        PG8_WAIT_V(6); PG8_BAR;
    } else {
        PG8_STAGE(PG8_SB(0, 0), cB, voffB); PG8_STAGE(PG8_SA(0, 0), cA, voffA); PG8_STAGE(PG8_SB(0, 1), cB + hstep, voffB); PG8_STAGE(PG8_SA(0, 1), cA + hstep, voffA);
        if (wr == 1) PG8_BAR;
        PG8_WAIT_V(4); PG8_BAR;
        PG8_STAGE(PG8_SB(1, 0), cB + kstep, voffB); PG8_STAGE(PG8_SA(1, 0), cA + kstep, voffA); PG8_STAGE(PG8_SB(1, 1), cB + hstep + kstep, voffB);
        PG8_WAIT_V(6); PG8_BAR;
    }
    for (;;) {
        const bool has_next = S.next(ui + 1, nxt);
        const char* nA = has_next ? (const char*)g.A + (size_t)nxt.pm * tstep + nxt.kb : cA; const char* nB = has_next ? (const char*)g.Bt + (size_t)nxt.pn * tstep + nxt.kb : cB;
        for (int t = 0; t < nt; t += 2) {
            const bool last = (t == nt - 2);
            const char* a1 = cA + (size_t)(t + 1) * kstep;
            const char* a2 = last ? nA : cA + (size_t)(t + 2) * kstep; const char* b2 = last ? nB : cB + (size_t)(t + 2) * kstep;
            const char* a3 = a2 + kstep; const char* b3 = b2 + kstep;
            if (last && has_next) S.a_ready(nxt);
            if constexpr (SP2) {
            PG8_LDB(B0, 0, 0); PG8_LDB(B1, 0, 1); PG8_SCHED; PG8_LDA(At, 0, 0); PG8_STAGE(PG8_SA(1, 1), a1 + hstep, voffA);
            PG8_WAIT_V(8); PG8_WAIT_L(0); PG8_BAR; PG8_MMA(0, 0, At, B0); PG8_MMA(0, 1, At, B1); PG8_BAR; PG8_SCHED;
            PG8_LDA(At, 0, 1); PG8_STAGE(PG8_SB(0, 0), b2, voffB); PG8_STAGE(PG8_SB(0, 1), b2 + hstep, voffB); PG8_STAGE(PG8_SA(0, 0), a2, voffA);
            PG8_WAIT_V(8); PG8_WAIT_L(0); PG8_BAR; PG8_MMA(1, 0, At, B0); PG8_MMA(1, 1, At, B1); PG8_BAR; PG8_SCHED;
            PG8_LDB(B0, 1, 0); PG8_LDB(B1, 1, 1); PG8_SCHED; PG8_LDA(At, 1, 0); PG8_STAGE(PG8_SA(0, 1), a2 + hstep, voffA);
            PG8_WAIT_V(8); PG8_WAIT_L(0); PG8_BAR; PG8_MMA(0, 0, At, B0); PG8_MMA(0, 1, At, B1); PG8_BAR; PG8_SCHED;
            PG8_LDA(At, 1, 1); PG8_STAGE(PG8_SB(1, 0), b3, voffB); PG8_STAGE(PG8_SB(1, 1), b3 + hstep, voffB); PG8_STAGE(PG8_SA(1, 0), a3, voffA);
            PG8_WAIT_V(8); PG8_WAIT_L(0); PG8_BAR; PG8_MMA(1, 0, At, B0); PG8_MMA(1, 1, At, B1); PG8_BAR; PG8_SCHED;
            } else {
            PG8_LDB(B0, 0, 0); PG8_SCHED; PG8_LDA(At, 0, 0); PG8_STAGE(PG8_SA(1, 1), a1 + hstep, voffA);
            PG8_WAIT_L(8); PG8_BAR; PG8_WAIT_L(0); PG8_MMA(0, 0, At, B0); PG8_BAR; PG8_SCHED;
            PG8_LDB(B1, 0, 1); PG8_STAGE(PG8_SB(0, 0), b2, voffB);
            PG8_BAR; PG8_WAIT_L(0); PG8_MMA(0, 1, At, B1); PG8_BAR;
            PG8_LDA(At, 0, 1); PG8_STAGE(PG8_SA(0, 0), a2, voffA);
            PG8_BAR; PG8_WAIT_L(0); PG8_MMA(1, 0, At, B0); PG8_BAR; PG8_SCHED;
            PG8_STAGE(PG8_SB(0, 1), b2 + hstep, voffB);
            PG8_WAIT_V(6); PG8_BAR; PG8_MMA(1, 1, At, B1); PG8_BAR;
            PG8_LDB(B0, 1, 0); PG8_SCHED; PG8_LDA(At, 1, 0); PG8_STAGE(PG8_SA(0, 1), a2 + hstep, voffA);
            PG8_WAIT_L(8); PG8_BAR; PG8_WAIT_L(0); PG8_MMA(0, 0, At, B0); PG8_BAR; PG8_SCHED;
            PG8_LDB(B1, 1, 1); PG8_STAGE(PG8_SB(1, 0), b3, voffB);
            PG8_BAR; PG8_WAIT_L(0); PG8_MMA(0, 1, At, B1); PG8_BAR;
            PG8_LDA(At, 1, 1); PG8_STAGE(PG8_SA(1, 0), a3, voffA);
            PG8_BAR; PG8_WAIT_L(0); PG8_MMA(1, 0, At, B0); PG8_BAR; PG8_SCHED;
            PG8_STAGE(PG8_SB(1, 1), b3 + hstep, voffB);
            PG8_WAIT_V(6); PG8_BAR; PG8_MMA(1, 1, At, B1); PG8_BAR;
            }
        }
        if constexpr (ALIGN_EPI) { if (wr == 0) PG8_BAR; }
        if constexpr (!Epi::AFTER_DRAIN) { E(acc, cur, wr, wc, fr, fq); S.done(cur); }
        if (!has_next) break;
#pragma unroll
        for (int a = 0; a < 2; ++a)
#pragma unroll
            for (int b = 0; b < 2; ++b)
#pragma unroll
                for (int m = 0; m < 4; ++m)
#pragma unroll
                    for (int n = 0; n < 2; ++n) acc[a][b][m][n] = (f32x4){0.f, 0.f, 0.f, 0.f};
        cur = nxt; cA = nA; cB = nB; ++ui;
        if constexpr (ALIGN_EPI) { if (wr == 1) PG8_BAR; }
    }
    PG8_WAIT_V(0);
    if constexpr (!ALIGN_EPI) { if (wr == 0) PG8_BAR; }
    PG8_BAR;
    if constexpr (Epi::AFTER_DRAIN) { E.fused(acc, cur, wr, wc, fr, fq, lds, wid, lane); S.done(cur); }
#undef PG8_SA
#undef PG8_SB
#undef PG8_STAGE
#undef PG8_LDA
#undef PG8_LDB
#undef PG8_MMA
#undef PG8_WAIT_V
#undef PG8_WAIT_L
#undef PG8_BAR
#undef PG8_SCHED
}
}
#define LASX __attribute__((address_space(3)))
#define XB_TMO      128
#define XB_XCNT(j)  (256  + 64 * (j))
#define XB_XSUB(j)  (1280 + 64 * (j))
#define XB_XGEN(j)  (2304 + 64 * (j))
#define XB_TOP      3328
#define XB_TOPGEN   3392
#define XCD_BAR_WORDS 3456
#define XB_SPIN_CAP (1u << 18)

__device__ __forceinline__ unsigned xb_ld(unsigned* p)              { return __hip_atomic_load(p, __ATOMIC_RELAXED, __HIP_MEMORY_SCOPE_AGENT); }
__device__ __forceinline__ unsigned xb_add(unsigned* p, unsigned v) { return __hip_atomic_fetch_add(p, v, __ATOMIC_RELAXED, __HIP_MEMORY_SCOPE_AGENT); }
__device__ __forceinline__ unsigned xb_xcc_id() { return (unsigned)__builtin_amdgcn_s_getreg((3 << 11) | 20) & 0xFu; }
#define XB_SPIN(cond, bar) do { unsigned _sp = 0; while (cond) { __builtin_amdgcn_s_sleep(1); \
    if ((++_sp & 255u) == 0u) { if (xb_ld(&(bar)[XB_TMO])) break; if (_sp > XB_SPIN_CAP) { atomicAdd(&(bar)[XB_TMO], 1u); break; } } } } while (0)

struct XcdBarrier {
    unsigned* bar; unsigned x;
    volatile LASX unsigned* st;
};

__device__ __forceinline__ XcdBarrier xcd_barrier_post(unsigned* bar, volatile LASX unsigned* st) {
    XcdBarrier b; b.bar = bar; b.x = xb_xcc_id(); b.st = st;
    if (threadIdx.x == 0) (void)xb_add(&bar[XB_XCNT(b.x)], 1u);
    return b;
}
__device__ __forceinline__ void xcd_barrier_complete(unsigned* bar, unsigned x, unsigned& nloc, unsigned& nx) {
    const unsigned G = gridDim.x * gridDim.y * gridDim.z;
    unsigned sum, cnt, mine, sp = 0u;
    for (;;) {
        sum = 0u; cnt = 0u; mine = 0u;
#pragma unroll
        for (unsigned j = 0; j < 16; ++j) { const unsigned c = xb_ld(&bar[XB_XCNT(j)]); sum += c; cnt += (c > 0u) ? 1u : 0u; mine = (j == x) ? c : mine; }
        if (sum == G) break;
        __builtin_amdgcn_s_sleep(1);
        if ((++sp & 255u) == 0u) { if (xb_ld(&bar[XB_TMO])) break; if (sp > XB_SPIN_CAP) { atomicAdd(&bar[XB_TMO], 1u); break; } }
    }
    nloc = mine > 0u ? mine : 1u; nx = cnt > 0u ? cnt : 1u;
}

__device__ __forceinline__ void xcd_barrier(const XcdBarrier& b) {
    asm volatile("s_waitcnt vmcnt(0)" ::: "memory");
    __syncthreads();
    if (threadIdx.x == 0) {
        unsigned* bar = b.bar;
        __builtin_amdgcn_s_waitcnt(0);
        unsigned nloc = b.st[0], nx = b.st[1];
        if (nloc == 0u) { xcd_barrier_complete(bar, b.x, nloc, nx); b.st[0] = nloc; b.st[1] = nx; }
        const unsigned old = xb_add(&bar[XB_XSUB(b.x)], 1u);
        const unsigned gen = old / nloc;
        if (old + 1u == (gen + 1u) * nloc) {
            __builtin_amdgcn_fence(__ATOMIC_RELEASE, "agent");
            asm volatile("s_waitcnt vmcnt(0)" ::: "memory");
            const unsigned og = xb_add(&bar[XB_TOP], 1u);
            const unsigned tg = og / nx;
            if (og + 1u == (tg + 1u) * nx) xb_add(&bar[XB_TOPGEN], 1u);
            else XB_SPIN(xb_ld(&bar[XB_TOPGEN]) == tg, bar);
            __builtin_amdgcn_fence(__ATOMIC_ACQUIRE, "agent");
            xb_add(&bar[XB_XGEN(b.x)], 1u);
            asm volatile("s_waitcnt vmcnt(0)" ::: "memory");
        } else {
            XB_SPIN(xb_ld(&bar[XB_XGEN(b.x)]) == gen, bar);
            __builtin_amdgcn_fence(__ATOMIC_ACQUIRE, "agent");
            asm volatile("s_waitcnt vmcnt(0)" ::: "memory");
        }
    }
    __syncthreads();
}

#ifndef PROBE_OD
#define PROBE_OD 0
#endif
#ifndef PROBE_GC
#define PROBE_GC 0
#endif
#ifndef PROBE_AA
#define PROBE_AA 0
#endif
#ifndef XEXP
#define XEXP 0
#endif
typedef unsigned short bf16_t;
typedef short bf16x8 __attribute__((ext_vector_type(8)));
typedef float f32x4 __attribute__((ext_vector_type(4)));
typedef unsigned u32x4 __attribute__((ext_vector_type(4)));
typedef unsigned u32x2 __attribute__((ext_vector_type(2)));
#define LAS __attribute__((address_space(3)))

constexpr int NB = 2, SEQ = 8192, LC = 256, TB = SEQ + LC, MT = NB * TB, DM = 1024, NL = 4;
constexpr int IN_DIM = 5824, NPIN = 5888, FF = 2816, FF2 = 5632;
constexpr float EPS = 1e-6f, LOG2E = 1.4426950408889634f;
constexpr int NTHR = 512, NWAVES = 8;
constexpr int LDS_BYTES = 147456;
enum { I_X = 0, I_C, I_CTX, I_CCTX, I_WMOD, I_BMOD, I_NMIX, I_NFFN, I_WIN, I_SINK, I_QNORM, I_KVNORM, I_WUQ, I_WUKV, I_WGATE, I_BGATE, I_HNORM,
       I_WBRA, I_WBRB, I_WBRC, I_WOUT, I_WUP, I_CONVW, I_CONVB, I_WDOWN, I_FNORM, N_IN };

constexpr size_t O_MOD = 0;
constexpr size_t O_BAR = 384 * 1024;
constexpr size_t O_ROPEA = 512 * 1024;
constexpr size_t O_ROPEB = O_ROPEA + 2 * 1024 * 1024;
constexpr size_t O_SSQ = O_ROPEB + 1024 * 1024;
constexpr size_t O_GD = O_SSQ + 256 * 1024;
constexpr size_t O_X = O_GD + 1024 * 1024;
constexpr size_t SZ_X = (size_t)MT * DM * 4;
constexpr size_t O_WIN = O_X + SZ_X;
constexpr size_t O_WUQ = O_WIN + (size_t)NPIN * 1024 * 2;
constexpr size_t O_WUKV = O_WUQ + (size_t)768 * 256 * 2;
constexpr size_t O_WBR = O_WUKV + (size_t)1024 * 256 * 2;
constexpr size_t O_WOUT = O_WBR + (size_t)3 * 1024 * 512 * 2;
constexpr size_t O_WUP = O_WOUT + (size_t)1024 * 1024 * 2;
constexpr size_t O_WDOWN = O_WUP + (size_t)FF2 * 1024 * 2;
constexpr size_t O_HM = O_WDOWN + (size_t)1024 * FF * 2;
constexpr size_t O_MIX = O_HM + (size_t)MT * 1024 * 2;
constexpr size_t O_QA = O_MIX;
constexpr size_t O_KA = O_QA + (size_t)MT * 512 * 2;
constexpr size_t O_VAT = O_KA + (size_t)MT * 128 * 2;
constexpr size_t O_CQB = O_VAT + (size_t)2 * 2 * 64 * TB * 2;
constexpr size_t O_CKVB = O_CQB + (size_t)MT * 256 * 2;
constexpr size_t O_QB = O_CKVB + (size_t)MT * 256 * 2;
constexpr size_t O_KB = O_QB + (size_t)MT * 768 * 2;
constexpr size_t O_VBT = O_KB + (size_t)MT * 768 * 2;
constexpr size_t O_CQ = O_VBT + (size_t)2 * 8 * 64 * TB * 2;
constexpr size_t O_CK = O_CQ + (size_t)MT * 256 * 2;
constexpr size_t O_CV = O_CK + (size_t)MT * 256 * 2;
constexpr size_t O_CR = O_CV + (size_t)MT * 512 * 2;
constexpr size_t O_GLOW = O_CR + (size_t)MT * 512 * 2;
constexpr size_t O_GATES = O_GLOW + (size_t)MT * 32 * 4;
constexpr size_t O_YB = O_GATES + (size_t)MT * 3072 * 2;
constexpr size_t O_END = O_YB + (size_t)MT * 512 * 2;
constexpr size_t O_MACC = O_QB;
static_assert(O_CQ - O_QB == (size_t)MT * 1024 * 4, "MACC overlay");
constexpr size_t O_U = O_MIX;
constexpr size_t O_ACT = O_U + (size_t)MT * FF2 * 2;
static_assert(O_ACT + (size_t)MT * FF * 2 <= O_END, "U|ACT overlay");
constexpr size_t O_ST = O_HM;
static_assert((size_t)2112 * 8192 * 2 <= (size_t)MT * 1024 * 2, "ST overlay");
static_assert(O_END <= (size_t)448 * 1024 * 1024, "workspace budget");

__device__ __forceinline__ unsigned f2bf(float f) { unsigned u = __float_as_uint(f); return (u + 0x7fffu + ((u >> 16) & 1u)) >> 16; }
typedef float f32x2_t __attribute__((ext_vector_type(2))); typedef __bf16 bf16x2_t __attribute__((ext_vector_type(2)));
__device__ __forceinline__ unsigned pk2(float lo, float hi) { f32x2_t v = {lo, hi}; bf16x2_t b = __builtin_convertvector(v, bf16x2_t); return __builtin_bit_cast(unsigned, b); }
__device__ __forceinline__ float bflo(unsigned w) { return __uint_as_float(w << 16); }
__device__ __forceinline__ float bfhi(unsigned w) { return __uint_as_float(w & 0xffff0000u); }
__device__ __forceinline__ float bf2f(bf16_t h) { return __uint_as_float(((unsigned)h) << 16); }
__device__ __forceinline__ u32x4 pack8(const float* v) { u32x4 w; w.x = pk2(v[0], v[1]); w.y = pk2(v[2], v[3]); w.z = pk2(v[4], v[5]); w.w = pk2(v[6], v[7]); return w; }
__device__ __forceinline__ void unpack8(u32x4 w, float* v) { v[0] = bflo(w.x); v[1] = bfhi(w.x); v[2] = bflo(w.y); v[3] = bfhi(w.y); v[4] = bflo(w.z); v[5] = bfhi(w.z); v[6] = bflo(w.w); v[7] = bfhi(w.w); }
__device__ __forceinline__ float wave_sum(float v) {
#pragma unroll
    for (int o = 1; o < 64; o <<= 1) v += __shfl_xor(v, o);
    return v;
}
__device__ __forceinline__ float sigmoidf_(float x) { return 1.f / (1.f + __expf(-x)); }
__device__ __forceinline__ float siluf_(float x) { return x / (1.f + __expf(-x)); }

struct Args { const float* in[N_IN]; float* out; unsigned char* ws; int ph_lo, ph_hi; };

enum { MAT_IN = 0, MAT_UQ, MAT_UKV, MAT_PLAIN };
__device__ __forceinline__ int srcmap(int mat, int p) {
    if (mat == MAT_IN) {
        if (p < 640) { const int w = p & 63; return (p & ~63) + (w >> 1) + 32 * (w & 1); }
        if (p < 1152) return p;
        if (p < 1184) { const int w = p - 1152; return 1152 + (w >> 1) + 16 * (w & 1); }
        if (p < 1216) return 2720 + (p - 1184);
        if (p < 1280) return -1;
        if (p < 2816) return 1184 + (p - 1280);
        return 2752 + (p - 2816);
    }
    if (mat == MAT_UQ) { const int h = p / 96, w = p - h * 96; if (w < 64) return p; const int ww = w - 64; return h * 96 + 64 + (ww >> 1) + 16 * (ww & 1); }
    return p;
}
__device__ __forceinline__ void transpose_item(const float* __restrict__ W, int K, int N, bf16_t* WT, int KD, int item, int mat, const float* __restrict__ ks, float* scr, int lane) {
    const int nkb = KD / 64, pb = item / nkb, kb = item - pb * nkb, p0 = pb * 32, k0 = kb * 64;
    const int src = srcmap(mat, p0 + (lane & 31));
    float tv[32];
#pragma unroll
    for (int i = 0; i < 32; ++i) {
        const int k = k0 + 2 * i + (lane >> 5);
        float v = 0.f;
        if (src >= 0 && k < K) { v = W[(size_t)k * N + src]; if (ks) v *= ks[k]; }
        tv[i] = v;
    }
#pragma unroll
    for (int i = 0; i < 32; ++i) scr[(2 * i + (lane >> 5)) * 33 + (lane & 31)] = tv[i];
    __builtin_amdgcn_fence(__ATOMIC_RELEASE, "workgroup"); __builtin_amdgcn_wave_barrier();
    const int c = lane & 7;
#pragma unroll
    for (int j = 0; j < 4; ++j) {
        const int n = (lane >> 3) + 8 * j; const float* s = scr + (8 * c) * 33 + n;
        u32x4 o; o.x = pk2(s[0 * 33], s[1 * 33]); o.y = pk2(s[2 * 33], s[3 * 33]); o.z = pk2(s[4 * 33], s[5 * 33]); o.w = pk2(s[6 * 33], s[7 * 33]);
        *(u32x4*)(WT + (size_t)(p0 + n) * KD + k0 + 8 * c) = o;
    }
    __builtin_amdgcn_fence(__ATOMIC_RELEASE, "workgroup"); __builtin_amdgcn_wave_barrier();
}

#define EPI_LOOP_BEGIN \
    int fr_l = fr, fq_l = fq; asm volatile("" : "+v"(fr_l), "+v"(fq_l)); \
    _Pragma("unroll") for (int bj = 0; bj < 2; ++bj) { const int c0 = u.pn * 256 + bj * 128 + wc * 32 + 8 * fq_l; \
    _Pragma("unroll") for (int ai = 0; ai < 2; ++ai) _Pragma("unroll") for (int m = 0; m < 4; ++m) { const int t = u.pm * 256 + ai * 128 + wr * 64 + m * 16 + fr_l; \
        float v[8]; { const f32x4 a0 = acc[ai][bj][m][0], a1 = acc[ai][bj][m][1]; v[0] = a0[0]; v[1] = a0[1]; v[2] = a0[2]; v[3] = a0[3]; v[4] = a1[0]; v[5] = a1[1]; v[6] = a1[2]; v[7] = a1[3]; }
#define EPI_LOOP_END asm volatile("" ::: "memory"); } }

struct EpiIn {
    static constexpr bool PERM = true, AFTER_DRAIN = false;
    unsigned char* ws;
    __device__ __forceinline__ void operator()(const f32x4 (&acc)[2][2][4][2], const pg8::Unit& u, int wr, int wc, int fr, int fq) const {
        EPI_LOOP_BEGIN
            const int b = (t >= TB) ? 1 : 0, i = t - b * TB; const bool lat = i >= LC; const int pos = i - LC;
            if (c0 < 640) {
                if (lat) { const float* cs = (const float*)(ws + O_ROPEA) + (size_t)pos * 64 + ((c0 & 63) >> 1);
#pragma unroll
                    for (int p = 0; p < 4; ++p) { const float c = cs[p], s = cs[32 + p], a = v[2 * p], bb = v[2 * p + 1]; v[2 * p] = a * c - bb * s; v[2 * p + 1] = a * s + bb * c; } }
                if (c0 < 512) {
#pragma unroll
                    for (int e = 0; e < 8; ++e) v[e] *= 0.125f * LOG2E;
                    *(u32x4*)((bf16_t*)(ws + O_QA) + (size_t)t * 512 + c0) = pack8(v);
                } else *(u32x4*)((bf16_t*)(ws + O_KA) + (size_t)t * 128 + (c0 - 512)) = pack8(v);
            } else if (c0 < 768) {
                const int cc = c0 - 640, kvh = cc >> 6, d0 = cc & 63;
                bf16_t* dst = (bf16_t*)(ws + O_VAT) + ((size_t)(b * 2 + kvh) * 64 + d0) * TB + i;
#pragma unroll
                for (int e = 0; e < 8; ++e) dst[(size_t)e * TB] = (bf16_t)f2bf(v[e]);
            } else if (c0 < 1152) {
                float s = 0.f;
#pragma unroll
                for (int e = 0; e < 8; ++e) s += v[e] * v[e];
                s += __shfl_xor(s, 16); s += __shfl_xor(s, 32);
                if (c0 < 1024) { *(u32x4*)((bf16_t*)(ws + O_CQB) + (size_t)t * 256 + (c0 - 768)) = pack8(v); if (fq_l == 0) unsafeAtomicAdd((float*)(ws + O_SSQ) + t * 2, s); }
                else { bf16_t* d = (bf16_t*)(ws + O_CKVB) + (size_t)t * 256 + (c0 - 1024); *(u32x4*)d = pack8(v); *(u32x4*)(d + 128) = (u32x4){0u, 0u, 0u, 0u}; if (fq_l == 0) unsafeAtomicAdd((float*)(ws + O_SSQ) + t * 2 + 1, s); }
            } else if (c0 < 1184) {
                if (lat) { const float* cs = (const float*)(ws + O_ROPEB) + (size_t)pos * 32 + ((c0 - 1152) >> 1);
#pragma unroll
                    for (int p = 0; p < 4; ++p) { const float c = cs[p], s = cs[16 + p], a = v[2 * p], bb = v[2 * p + 1]; v[2 * p] = a * c - bb * s; v[2 * p + 1] = a * s + bb * c; } }
                const u32x4 w = pack8(v); bf16_t* d = (bf16_t*)(ws + O_KB) + (size_t)t * 768 + 64 + (c0 - 1152);
#pragma unroll
                for (int h = 0; h < 8; ++h) *(u32x4*)(d + h * 96) = w;
            } else if (c0 < 1216) {
                float* d = (float*)(ws + O_GLOW) + (size_t)t * 32 + (c0 - 1184);
                *(f32x4*)d = (f32x4){v[0], v[1], v[2], v[3]}; *(f32x4*)(d + 4) = (f32x4){v[4], v[5], v[6], v[7]};
            } else if (c0 < 1280) {
            } else if (c0 < 1536) {
#pragma unroll
                for (int e = 0; e < 8; ++e) v[e] *= 0.125f;
                *(u32x4*)((bf16_t*)(ws + O_CQ) + (size_t)t * 256 + (c0 - 1280)) = pack8(v);
            } else if (c0 < 1792) { *(u32x4*)((bf16_t*)(ws + O_CK) + (size_t)t * 256 + (c0 - 1536)) = pack8(v);
            } else if (c0 < 2304) { *(u32x4*)((bf16_t*)(ws + O_CV) + (size_t)t * 512 + (c0 - 1792)) = pack8(v);
            } else if (c0 < 2816) { *(u32x4*)((bf16_t*)(ws + O_CR) + (size_t)t * 512 + (c0 - 2304)) = pack8(v);
            } else {
#pragma unroll
                for (int e = 0; e < 8; ++e) v[e] = sigmoidf_(v[e]);
                *(u32x4*)((bf16_t*)(ws + O_GATES) + (size_t)t * 3072 + (c0 - 2816)) = pack8(v);
            }
        EPI_LOOP_END
    }
};

struct EpiUq {
    static constexpr bool PERM = true, AFTER_DRAIN = false;
    unsigned char* ws;
    __device__ __forceinline__ void operator()(const f32x4 (&acc)[2][2][4][2], const pg8::Unit& u, int wr, int wc, int fr, int fq) const {
        EPI_LOOP_BEGIN
            const int b = (t >= TB) ? 1 : 0, i = t - b * TB; const bool lat = i >= LC; const int pos = i - LC;
            const float rstd = rsqrtf(((const float*)(ws + O_SSQ))[t * 2] * (1.f / 256.f) + EPS) * (0.10206207261596575f * LOG2E);
#pragma unroll
            for (int e = 0; e < 8; ++e) v[e] *= rstd;
            const int h = c0 / 96, w = c0 - h * 96;
            if (w >= 64 && lat) { const float* cs = (const float*)(ws + O_ROPEB) + (size_t)pos * 32 + ((w - 64) >> 1);
#pragma unroll
                for (int p = 0; p < 4; ++p) { const float c = cs[p], s = cs[16 + p], a = v[2 * p], bb = v[2 * p + 1]; v[2 * p] = a * c - bb * s; v[2 * p + 1] = a * s + bb * c; } }
            *(u32x4*)((bf16_t*)(ws + O_QB) + (size_t)t * 768 + c0) = pack8(v);
        EPI_LOOP_END
    }
};
struct EpiUkv {
    static constexpr bool PERM = true, AFTER_DRAIN = false;
    unsigned char* ws;
    __device__ __forceinline__ void operator()(const f32x4 (&acc)[2][2][4][2], const pg8::Unit& u, int wr, int wc, int fr, int fq) const {
        EPI_LOOP_BEGIN
            const int b = (t >= TB) ? 1 : 0, i = t - b * TB;
            const float rstd = rsqrtf(((const float*)(ws + O_SSQ))[t * 2 + 1] * (1.f / 128.f) + EPS);
#pragma unroll
            for (int e = 0; e < 8; ++e) v[e] *= rstd;
            const int h = c0 >> 7, w = c0 & 127;
            if (w < 64) *(u32x4*)((bf16_t*)(ws + O_KB) + (size_t)t * 768 + h * 96 + w) = pack8(v);
            else { bf16_t* dst = (bf16_t*)(ws + O_VBT) + ((size_t)(b * 8 + h) * 64 + (w - 64)) * TB + i;
#pragma unroll
                for (int e = 0; e < 8; ++e) dst[(size_t)e * TB] = (bf16_t)f2bf(v[e]); }
        EPI_LOOP_END
    }
};
template <int PASS> struct EpiMerge {
    static constexpr bool PERM = true, AFTER_DRAIN = false;
    unsigned char* ws;
    __device__ __forceinline__ void operator()(const f32x4 (&acc)[2][2][4][2], const pg8::Unit& u, int wr, int wc, int fr, int fq) const {
        EPI_LOOP_BEGIN
            float g[8]; unpack8(*(const u32x4*)((const bf16_t*)(ws + O_GATES) + (size_t)t * 3072 + PASS * 1024 + c0), g);
            bf16_t* mp = (bf16_t*)(ws + O_HM) + (size_t)t * 1024 + c0;
            if (PASS > 0) { float pv[8]; unpack8(*(const u32x4*)mp, pv);
#pragma unroll
                for (int e = 0; e < 8; ++e) v[e] = pv[e] + g[e] * v[e];
            } else {
#pragma unroll
                for (int e = 0; e < 8; ++e) v[e] *= g[e];
            }
            *(u32x4*)mp = pack8(v);
        EPI_LOOP_END
    }
};
template <int PASS> struct EpiMergePart {
    static constexpr bool PERM = true, AFTER_DRAIN = false;
    unsigned char* ws; int kbstep;
    __device__ __forceinline__ void operator()(const f32x4 (&acc)[2][2][4][2], const pg8::Unit& u, int wr, int wc, int fr, int fq) const {
        const int ks = u.kb / kbstep;
        EPI_LOOP_BEGIN
            float g[8]; unpack8(*(const u32x4*)((const bf16_t*)(ws + O_GATES) + (size_t)t * 3072 + PASS * 1024 + c0), g);
            const int cr = (t >= TB) ? (t - TB + 256) : t;
            float* pp = (float*)(ws + O_CQ) + ((size_t)((PASS * 2 + ks) * 512 + cr)) * 1024 + c0;
            *(f32x4*)pp = (f32x4){g[0] * v[0], g[1] * v[1], g[2] * v[2], g[3] * v[3]}; *(f32x4*)(pp + 4) = (f32x4){g[4] * v[4], g[5] * v[5], g[6] * v[6], g[7] * v[7]};
        EPI_LOOP_END
    }
};
struct EpiResid {
    static constexpr bool PERM = true, AFTER_DRAIN = false;
    unsigned char* ws; const float* modl; int goff;
    __device__ __forceinline__ void operator()(const f32x4 (&acc)[2][2][4][2], const pg8::Unit& u, int wr, int wc, int fr, int fq) const {
        EPI_LOOP_BEGIN
            const int b = (t >= TB) ? 1 : 0, i = t - b * TB; const int r = (i >= LC) ? b : 2;
            const float* gp = modl + r * 6144 + goff + c0;
            const f32x4 g0 = *(const f32x4*)gp, g1 = *(const f32x4*)(gp + 4);
            float* xp = (float*)(ws + O_X) + (size_t)t * 1024 + c0;
            f32x4 x0 = *(const f32x4*)xp, x1 = *(const f32x4*)(xp + 4);
            x0[0] += g0[0] * v[0]; x0[1] += g0[1] * v[1]; x0[2] += g0[2] * v[2]; x0[3] += g0[3] * v[3];
            x1[0] += g1[0] * v[4]; x1[1] += g1[1] * v[5]; x1[2] += g1[2] * v[6]; x1[3] += g1[3] * v[7];
            *(f32x4*)xp = x0; *(f32x4*)(xp + 4) = x1;
        EPI_LOOP_END
    }
};
struct EpiPartial {
    static constexpr bool PERM = true, AFTER_DRAIN = false;
    float* P; int kbstep;
    __device__ __forceinline__ void operator()(const f32x4 (&acc)[2][2][4][2], const pg8::Unit& u, int wr, int wc, int fr, int fq) const {
        const int ks = u.kb / kbstep;
        EPI_LOOP_BEGIN
            const int cr = (t >= TB) ? (t - TB + 256) : t;
            float* pp = P + ((size_t)(ks * 512 + cr)) * 1024 + c0;
            *(f32x4*)pp = (f32x4){v[0], v[1], v[2], v[3]}; *(f32x4*)(pp + 4) = (f32x4){v[4], v[5], v[6], v[7]};
        EPI_LOOP_END
    }
};
struct EpiNull {
    static constexpr bool PERM = true, AFTER_DRAIN = false;
    float* sink;
    __device__ __forceinline__ void operator()(const f32x4 (&acc)[2][2][4][2], const pg8::Unit& u, int wr, int wc, int fr, int fq) const {
        float sacc = 0.f;
        EPI_LOOP_BEGIN
            sacc += v[0] + v[1] + v[2] + v[3] + v[4] + v[5] + v[6] + v[7] + (float)(t + c0) * 1e-30f;
        EPI_LOOP_END
        if (sacc == 1.2345e30f) sink[threadIdx.x] = sacc;
    }
};
struct EpiStore {
    static constexpr bool PERM = true, AFTER_DRAIN = false;
    bf16_t* O; int ldc;
    __device__ __forceinline__ void operator()(const f32x4 (&acc)[2][2][4][2], const pg8::Unit& u, int wr, int wc, int fr, int fq) const {
        EPI_LOOP_BEGIN
            *(u32x4*)(O + (size_t)t * ldc + c0) = pack8(v);
        EPI_LOOP_END
    }
};

template <class Epi> __device__ __forceinline__ void run_gemm(unsigned char* lds, const bf16_t* A, const bf16_t* Bt, int M, int N, int K, const Epi& E) {
    asm volatile("" : "+s"(K), "+s"(M), "+s"(N));
    int gd_ = (int)gridDim.x, bi_ = (int)blockIdx.x; asm volatile("" : "+s"(gd_), "+s"(bi_));
    pg8::Gemm g{A, Bt, M, N, K, K}; pg8::StaticOrder S; S.init(M, N, gd_, bi_);
    pg8::gemm_phase<Epi, pg8::StaticOrder, true, false>((PG8_LAS unsigned char*)lds, g, S, E);
}

struct MainOrder {
    pg8::StaticOrder S;
    __device__ void init(int N, int G_, int c_) { S.init(64 * 256, N, G_, c_); }
    __device__ bool next(int i, pg8::Unit& u) const { if (!S.next(i, u)) return false; u.pm = (u.pm < 32) ? u.pm + 1 : u.pm + 2; return true; }
    __device__ __forceinline__ void a_ready(const pg8::Unit&) const {}
    __device__ __forceinline__ void done(const pg8::Unit&) const {}
};
struct CtxSplitOrder {
    int nN, nsplit, kloop, G, c;
    __device__ bool next(int i, pg8::Unit& u) const {
        const int L = i * G + c; if (L >= 2 * nN * nsplit) return false;
        const int ks = L % nsplit, r = L / nsplit; u.pn = r % nN; u.pm = (r / nN) ? 33 : 0; u.kb = ks * kloop * 2; return true;
    }
    __device__ __forceinline__ void a_ready(const pg8::Unit&) const {}
    __device__ __forceinline__ void done(const pg8::Unit&) const {}
};
template <class Epi> __device__ __forceinline__ void run_gemm_main(unsigned char* lds, const bf16_t* A, const bf16_t* Bt, int N, int K, const Epi& E) {
    asm volatile("" : "+s"(K), "+s"(N));
    int gd_ = (int)gridDim.x, bi_ = (int)blockIdx.x; asm volatile("" : "+s"(gd_), "+s"(bi_));
    pg8::Gemm g{A, Bt, MT, N, K, K}; MainOrder S; S.init(N, gd_, bi_);
    pg8::gemm_phase<Epi, MainOrder, true, true>((PG8_LAS unsigned char*)lds, g, S, E);
}
template <class Epi> __device__ __forceinline__ void run_gemm_ctx(unsigned char* lds, const bf16_t* A, const bf16_t* Bt, int N, int K, int nsplit, const Epi& E, int rot = 0) {
    asm volatile("" : "+s"(K), "+s"(N), "+s"(nsplit));
    int gd_ = (int)gridDim.x, bi_ = (int)blockIdx.x; asm volatile("" : "+s"(gd_), "+s"(bi_));
    bi_ = (bi_ + gd_ - (rot % gd_)) % gd_;
    const int kloop = K / nsplit;
    pg8::Gemm g{A, Bt, MT, N, K, kloop}; CtxSplitOrder S{N / 256, nsplit, kloop, gd_, bi_};
    pg8::gemm_phase<Epi, CtxSplitOrder, true, true>((PG8_LAS unsigned char*)lds, g, S, E);
}

struct NormRow { f32x4 v[4]; float s; };
struct NormPar { const float* src; float* cp; const float* part; const float* gv; const float* sc; const float* sh; bf16_t* orow; int nsl; };
__device__ __forceinline__ void norm_load(NormRow& R, const NormPar& P, int lane) {
    const f32x4* xr = (const f32x4*)P.src + lane; R.s = 0.f;
#pragma unroll
    for (int j = 0; j < 4; ++j) { R.v[j] = xr[64 * j];
        if (P.part) { f32x4 a = (f32x4){0.f, 0.f, 0.f, 0.f};
            for (int q = 0; q < P.nsl; ++q) a = a + ((const f32x4*)(P.part + (size_t)q * 512 * 1024))[64 * j + lane];
            R.v[j] = R.v[j] + ((const f32x4*)P.gv)[64 * j + lane] * a; }
        R.s += (R.v[j][0] * R.v[j][0] + R.v[j][1] * R.v[j][1]) + (R.v[j][2] * R.v[j][2] + R.v[j][3] * R.v[j][3]); }
}
__device__ __forceinline__ void norm_finish(const NormRow& R, const NormPar& P, const float* nw, int lane) {
    if (P.cp) {
#pragma unroll
        for (int j = 0; j < 4; ++j) ((f32x4*)P.cp)[64 * j + lane] = R.v[j];
    }
    const float rstd = rsqrtf(wave_sum(R.s) * (1.f / 1024.f) + EPS);
#pragma unroll
    for (int j = 0; j < 4; ++j) {
        const int idx = 64 * j + lane;
        const f32x4 w = ((const f32x4*)nw)[idx], a = ((const f32x4*)P.sc)[idx], bsh = ((const f32x4*)P.sh)[idx];
        const float y0 = R.v[j][0] * rstd * w[0] * (1.f + a[0]) + bsh[0], y1 = R.v[j][1] * rstd * w[1] * (1.f + a[1]) + bsh[1];
        const float y2 = R.v[j][2] * rstd * w[2] * (1.f + a[2]) + bsh[2], y3 = R.v[j][3] * rstd * w[3] * (1.f + a[3]) + bsh[3];
        u32x2 o; o.x = pk2(y0, y1); o.y = pk2(y2, y3);
        ((u32x2*)P.orow)[idx] = o;
    }
}

#define ATT_THR 4.0f
template <int DQK, bool MASK, int NQ>
__device__ __forceinline__ void attn_unit(unsigned char* lds, const bf16_t* Qg, int ldq, const bf16_t* Kg, int ldk, const bf16_t* Vtg, bf16_t* Og, int ldo,
                                          int qi0, int a0, int n1, int b0, int n2, float m0, bool sink) {
    constexpr int KP = DQK + 8, KBYTES = 64 * KP * 2, VP = 72, VBYTES = 64 * VP * 2, NC = DQK / 32, KCH = DQK / 8, WR = 16 * NQ;
    constexpr int KOFF = 0, VOFF = 2 * KBYTES;
    int tid_ = threadIdx.x; asm volatile("" : "+v"(tid_));
    const int tid = tid_, lane = tid & 63, wid = tid >> 6, ql = lane & 15, g = lane >> 4;
    const int qw0 = qi0 + wid * WR;
    bf16x8 qf[NQ][NC];
#pragma unroll
    for (int qb = 0; qb < NQ; ++qb)
#pragma unroll
        for (int c = 0; c < NC; ++c) qf[qb][c] = *(const bf16x8*)(Qg + (size_t)(qw0 + qb * 16 + ql) * ldq + c * 32 + g * 8);
    f32x4 o[4][NQ];
#pragma unroll
    for (int eb = 0; eb < 4; ++eb)
#pragma unroll
        for (int qb = 0; qb < NQ; ++qb) o[eb][qb] = (f32x4){0.f, 0.f, 0.f, 0.f};
    float mrow[NQ]; f32x4 negm[NQ], ol[NQ];
#pragma unroll
    for (int qb = 0; qb < NQ; ++qb) { mrow[qb] = sink ? m0 : 0.f; const float l0 = sink ? 1.f : 0.f; ol[qb] = (f32x4){l0, l0, l0, l0}; negm[qb] = (f32x4){-mrow[qb], -mrow[qb], -mrow[qb], -mrow[qb]}; }
    const bf16x8 ones = (bf16x8){0x3F80, 0x3F80, 0x3F80, 0x3F80, 0x3F80, 0x3F80, 0x3F80, 0x3F80};
    bool first = !sink;
    int nt = n1 + n2; asm volatile("" : "+s"(nt));
    const int kr0 = tid / KCH, kc0 = tid - kr0 * KCH;
    const int ci1 = tid + 512, kr1 = ci1 / KCH, kc1 = ci1 - kr1 * KCH;
    const bool has1 = (KCH * 64 > 512) && (ci1 < KCH * 64);
    const int ve = tid >> 3, vc = tid & 7;
    u32x4 kreg0, kreg1 = (u32x4){0u, 0u, 0u, 0u}, vreg;
#define ATT_TILE(tt) (((tt) < n1) ? (a0 + (tt)) : (b0 + (tt) - n1))
#define ATT_SKIP(kt) (MASK && ((kt) >= 4) && (((kt) * 64 > qw0 + (WR - 1) + 128) || ((kt) * 64 + 63 < qw0 - 128)))
#define ATT_ISSUE(kt) do { kreg0 = *(const u32x4*)(Kg + (size_t)((kt) * 64 + kr0) * ldk + kc0 * 8); \
        if (has1) kreg1 = *(const u32x4*)(Kg + (size_t)((kt) * 64 + kr1) * ldk + kc1 * 8); \
        vreg = *(const u32x4*)(Vtg + (size_t)ve * TB + (kt) * 64 + vc * 8); } while (0)
#define ATT_COMMIT(buf) do { unsigned char* kb_ = lds + KOFF + (buf) * KBYTES; *(u32x4*)(kb_ + kr0 * (KP * 2) + kc0 * 16) = kreg0; \
        if (has1) *(u32x4*)(kb_ + kr1 * (KP * 2) + kc1 * 16) = kreg1; \
        *(u32x4*)(lds + VOFF + (buf) * VBYTES + ve * (VP * 2) + vc * 16) = vreg; } while (0)
    { const int kt0 = ATT_TILE(0); ATT_ISSUE(kt0); ATT_COMMIT(0); }
    __syncthreads();
#pragma unroll 1
    for (int tt = 0; tt < nt; ++tt) {
        const int kt = ATT_TILE(tt);
        if (tt + 1 < nt) { const int ktn = ATT_TILE(tt + 1); ATT_ISSUE(ktn); }
        if (!ATT_SKIP(kt)) {
#pragma unroll 1
          for (int hb = 0; hb < 2; ++hb) {
            f32x4 sc[2][NQ];
            { const unsigned char* kb_ = lds + KOFF + (tt & 1) * KBYTES + hb * (32 * KP * 2);
              __builtin_amdgcn_s_setprio(1);
#pragma unroll
              for (int k2 = 0; k2 < 2; ++k2) {
#pragma unroll
                  for (int c = 0; c < NC; ++c) {
                      const bf16x8 kf = *(const bf16x8*)(kb_ + (k2 * 16 + ql) * (KP * 2) + (c * 32 + g * 8) * 2);
#pragma unroll
                      for (int qb = 0; qb < NQ; ++qb) sc[k2][qb] = __builtin_amdgcn_mfma_f32_16x16x32_bf16(kf, qf[qb][c], c == 0 ? negm[qb] : sc[k2][qb], 0, 0, 0);
                  } }
              __builtin_amdgcn_s_setprio(0); }
            if (MASK) { if (kt >= 4) { int dl = kt * 64 + hb * 32 + g * 4 - qw0 - ql; asm volatile("" : "+v"(dl));
#pragma unroll
                for (int k2 = 0; k2 < 2; ++k2)
#pragma unroll
                    for (int qb = 0; qb < NQ; ++qb)
#pragma unroll
                        for (int j = 0; j < 4; ++j) { const int d = dl + (k2 * 16 + j - qb * 16); if (d > 128 || d < -128) sc[k2][qb][j] = -1e30f; } } }
            float am = fmaxf(fmaxf(sc[0][0][0], sc[0][0][1]), sc[0][0][2]); am = fmaxf(fmaxf(am, sc[0][0][3]), sc[1][0][0]); am = fmaxf(fmaxf(am, sc[1][0][1]), sc[1][0][2]); am = fmaxf(am, sc[1][0][3]);
#pragma unroll
            for (int qb = 1; qb < NQ; ++qb) { am = fmaxf(fmaxf(am, sc[0][qb][0]), sc[0][qb][1]); am = fmaxf(fmaxf(am, sc[0][qb][2]), sc[0][qb][3]);
                am = fmaxf(fmaxf(am, sc[1][qb][0]), sc[1][qb][1]); am = fmaxf(fmaxf(am, sc[1][qb][2]), sc[1][qb][3]); }
            if (__any(first || (am > ATT_THR))) {
#pragma unroll
                for (int qb = 0; qb < NQ; ++qb) {
                    float a = fmaxf(fmaxf(sc[0][qb][0], sc[0][qb][1]), sc[0][qb][2]);
                    a = fmaxf(fmaxf(a, sc[0][qb][3]), sc[1][qb][0]); a = fmaxf(fmaxf(a, sc[1][qb][1]), sc[1][qb][2]); a = fmaxf(a, sc[1][qb][3]);
                    { auto r16 = __builtin_amdgcn_permlane16_swap(__float_as_uint(a), __float_as_uint(a), false, false); a = fmaxf(__uint_as_float(r16[0]), __uint_as_float(r16[1])); }
                    { auto r32 = __builtin_amdgcn_permlane32_swap(__float_as_uint(a), __float_as_uint(a), false, false); a = fmaxf(__uint_as_float(r32[0]), __uint_as_float(r32[1])); }
                    const float dlt = first ? a : fmaxf(a, 0.f);
                    mrow[qb] += dlt; negm[qb] = (f32x4){-mrow[qb], -mrow[qb], -mrow[qb], -mrow[qb]};
                    sc[0][qb] = sc[0][qb] - dlt; sc[1][qb] = sc[1][qb] - dlt;
                    if (!first) { const float alpha = __builtin_amdgcn_exp2f(-dlt); ol[qb] = ol[qb] * alpha;
#pragma unroll
                        for (int eb = 0; eb < 4; ++eb) o[eb][qb] = o[eb][qb] * alpha; } }
                first = false; }
            bf16x8 pf[NQ];
#pragma unroll
            for (int qb = 0; qb < NQ; ++qb) {
#pragma unroll
                for (int k2 = 0; k2 < 2; ++k2)
#pragma unroll
                    for (int j = 0; j < 4; ++j) sc[k2][qb][j] = __builtin_amdgcn_exp2f(sc[k2][qb][j]);
                u32x4 w; w.x = pk2(sc[0][qb][0], sc[0][qb][1]); w.y = pk2(sc[0][qb][2], sc[0][qb][3]); w.z = pk2(sc[1][qb][0], sc[1][qb][1]); w.w = pk2(sc[1][qb][2], sc[1][qb][3]);
                pf[qb] = __builtin_bit_cast(bf16x8, w); }
            { const unsigned char* vb_ = lds + VOFF + (tt & 1) * VBYTES + hb * 64;
#pragma unroll
              for (int eb = 0; eb < 4; ++eb) {
                  const unsigned char* vp = vb_ + (eb * 16 + ql) * (VP * 2) + (g * 4) * 2;
                  const u32x2 lo = *(const u32x2*)vp, hi = *(const u32x2*)(vp + 32); const u32x4 w = (u32x4){lo.x, lo.y, hi.x, hi.y};
                  const bf16x8 vf = __builtin_bit_cast(bf16x8, w);
#pragma unroll
                  for (int qb = 0; qb < NQ; ++qb) o[eb][qb] = __builtin_amdgcn_mfma_f32_16x16x32_bf16(vf, pf[qb], o[eb][qb], 0, 0, 0);
              }
#pragma unroll
              for (int qb = 0; qb < NQ; ++qb) ol[qb] = __builtin_amdgcn_mfma_f32_16x16x32_bf16(ones, pf[qb], ol[qb], 0, 0, 0); }
          }
        }
        if (tt + 1 < nt) ATT_COMMIT((tt + 1) & 1);
        __syncthreads();
    }
#undef ATT_TILE
#undef ATT_SKIP
#undef ATT_ISSUE
#undef ATT_COMMIT
#pragma unroll
    for (int qb = 0; qb < NQ; ++qb) {
        const float inv = 1.f / ol[qb][0];
        bf16_t* op = Og + (size_t)(qw0 + qb * 16 + ql) * ldo + g * 4;
        if (Og)
#pragma unroll
        for (int eb = 0; eb < 4; ++eb) { u32x2 w; w.x = pk2(o[eb][qb][0] * inv, o[eb][qb][1] * inv); w.y = pk2(o[eb][qb][2] * inv, o[eb][qb][3] * inv); *(u32x2*)(op + eb * 16) = w; }
    }
}

constexpr int GL_BS = 0;
constexpr int GL_TOT = GL_BS + 64 * 65 * 4;
constexpr int GL_QE = GL_TOT + 8 * 64 * 4;
constexpr int GL_KE = GL_QE + 64 * 72 * 2;
constexpr int GL_ATT = GL_KE + 64 * 72 * 2;
constexpr int GL_VT = GL_ATT + 64 * 72 * 2;
constexpr int GL_O = GL_VT + 128 * 72 * 2;
constexpr int GL_END = GL_O + 64 * 132 * 4;
static_assert(GL_END <= 131072 && (GL_QE % 16) == 0 && (GL_VT % 16) == 0 && (GL_O % 16) == 0, "GLA LDS map");

__device__ __forceinline__ void gla_decay(unsigned char* lds, const float* glow_t0, const float* Wg  , const float* bg  , int dir) {
    float* Bs = (float*)(lds + GL_BS); float* Tot = (float*)(lds + GL_TOT); float* GLs = (float*)(lds + GL_O);
    int tid_ = threadIdx.x; asm volatile("" : "+v"(tid_)); const int tid = tid_;
    { const int s = tid >> 3, q = tid & 7;
      const float* gp = glow_t0 + (size_t)s * 32 + dir * 16 + q * 2;
      GLs[s * 16 + q * 2] = gp[0]; GLs[s * 16 + q * 2 + 1] = gp[1]; }
    const int d = tid & 63, seg = tid >> 6;
    float w[16];
#pragma unroll
    for (int r = 0; r < 16; ++r) w[r] = Wg[r * 256 + d];
    const float bias = bg[d];
    __syncthreads();
    float loc[8];
#pragma unroll
    for (int k = 0; k < 8; ++k) { const float* gl = GLs + (seg * 8 + k) * 16; float a = bias;
#pragma unroll
        for (int r = 0; r < 16; ++r) a += gl[r] * w[r];
        loc[k] = (fminf(a, 0.f) - __logf(1.f + __expf(-fabsf(a)))) * (1.f / 16.f); }
    float run = 0.f;
    if (dir == 0) {
#pragma unroll
        for (int k = 0; k < 8; ++k) { run += loc[k]; loc[k] = run; }
    } else {
#pragma unroll
        for (int k = 7; k >= 0; --k) { run += loc[k]; loc[k] = run; }
    }
    Tot[seg * 64 + d] = run;
    __syncthreads();
    float off = 0.f;
#pragma unroll
    for (int sg = 0; sg < 8; ++sg) { const float tv = Tot[sg * 64 + d]; if (dir == 0 ? (sg < seg) : (sg > seg)) off += tv; }
#pragma unroll
    for (int k = 0; k < 8; ++k) Bs[(seg * 8 + k) * 65 + d] = loc[k] + off;
    __syncthreads();
}
__device__ __forceinline__ void gla_load_vt(unsigned char* lds, const bf16_t* cv_t0  ) {
    bf16_t* Vt = (bf16_t*)(lds + GL_VT);
    int tid_ = threadIdx.x; asm volatile("" : "+v"(tid_)); const int tid = tid_;
#pragma unroll
    for (int r = 0; r < 2; ++r) { const int ci = tid + 512 * r, s = ci >> 4, eg = ci & 15;
        const u32x4 w = *(const u32x4*)(cv_t0 + (size_t)s * 512 + eg * 8);
        bf16_t* dst = Vt + (eg * 8) * 72 + s;
        dst[0 * 72] = (bf16_t)(w.x & 0xffffu); dst[1 * 72] = (bf16_t)(w.x >> 16); dst[2 * 72] = (bf16_t)(w.y & 0xffffu); dst[3 * 72] = (bf16_t)(w.y >> 16);
        dst[4 * 72] = (bf16_t)(w.z & 0xffffu); dst[5 * 72] = (bf16_t)(w.z >> 16); dst[6 * 72] = (bf16_t)(w.w & 0xffffu); dst[7 * 72] = (bf16_t)(w.w >> 16); }
}
__device__ __forceinline__ int gla_ord(int dir, int k) { return dir == 0 ? k : (k < 4 ? 3 - k : 135 - k); }

__device__ __forceinline__ void gla_state_item(unsigned char* lds, unsigned char* ws, const float* wgate, const float* bgate, int l, int item) {
    const int c = item % 132, dir = (item / 132) & 1, h = (item / 264) & 3, b = item / 1056;
    const int t0 = b * TB + c * 64;
    int tid_ = threadIdx.x; asm volatile("" : "+v"(tid_));
    const int tid = tid_, lane = tid & 63, wid = tid >> 6, ql = lane & 15, g = lane >> 4;
    const u32x4 kraw = *(const u32x4*)((const bf16_t*)(ws + O_CK) + (size_t)(t0 + (tid >> 3)) * 256 + h * 64 + (tid & 7) * 8);
    gla_load_vt(lds, (const bf16_t*)(ws + O_CV) + (size_t)t0 * 512 + h * 128);
    gla_decay(lds, (const float*)(ws + O_GLOW) + (size_t)t0 * 32, wgate + (size_t)((l * 2 + dir) * 16) * 256 + h * 64, bgate + (l * 2 + dir) * 256 + h * 64, dir);
    const float* Bs = (const float*)(lds + GL_BS); bf16_t* KDt = (bf16_t*)(lds + GL_KE);
    const int iend = dir == 0 ? 63 : 0;
    { const int s = tid >> 3, dg = tid & 7;
      float kv[8]; unpack8(kraw, kv);
#pragma unroll
      for (int e = 0; e < 8; ++e) { const int d = dg * 8 + e; KDt[d * 72 + s] = (bf16_t)f2bf(kv[e] * __expf(Bs[iend * 65 + d] - Bs[s * 65 + d])); } }
    if (tid < 64) ((float*)(ws + O_GD))[(size_t)item * 64 + tid] = __expf(Bs[iend * 65 + tid]);
    __syncthreads();
    const bf16_t* Vt = (const bf16_t*)(lds + GL_VT);
    f32x4 acc[4];
#pragma unroll
    for (int cb = 0; cb < 4; ++cb) acc[cb] = (f32x4){0.f, 0.f, 0.f, 0.f};
#pragma unroll
    for (int kk = 0; kk < 2; ++kk) {
        const bf16x8 a = *(const bf16x8*)(Vt + (wid * 16 + ql) * 72 + kk * 32 + g * 8);
#pragma unroll
        for (int cb = 0; cb < 4; ++cb) { const bf16x8 bb = *(const bf16x8*)(KDt + (cb * 16 + ql) * 72 + kk * 32 + g * 8); acc[cb] = __builtin_amdgcn_mfma_f32_16x16x32_bf16(a, bb, acc[cb], 0, 0, 0); }
    }
    bf16_t* st = (bf16_t*)(ws + O_ST) + (size_t)item * 8192;
#pragma unroll
    for (int cb = 0; cb < 4; ++cb)
#pragma unroll
        for (int j = 0; j < 4; ++j) st[(wid * 16 + g * 4 + j) * 64 + cb * 16 + ql] = (bf16_t)f2bf(acc[cb][j]);
    __syncthreads();
}

__device__ __forceinline__ void gla_scan(unsigned char* ws, int bid, int tid, int G) {
    bf16_t* ST = (bf16_t*)(ws + O_ST); const float* GD = (const float*)(ws + O_GD);
    for (int gidx = bid * NTHR + tid; gidx < 16 * 8192; gidx += G * NTHR) {
        const int seq = gidx >> 13, idx = gidx & 8191, d = idx & 63, dir = seq & 1;
        float s = 0.f;
        for (int k0 = 0; k0 < 132; k0 += 33) {
            float uv[33], dv[33];
#pragma unroll
            for (int u = 0; u < 33; ++u) { const int c = gla_ord(dir, k0 + u); uv[u] = bf2f(ST[(size_t)(seq * 132 + c) * 8192 + idx]); dv[u] = GD[(size_t)(seq * 132 + c) * 64 + d]; }
#pragma unroll
            for (int u = 0; u < 33; ++u) { const int c = gla_ord(dir, k0 + u); ST[(size_t)(seq * 132 + c) * 8192 + idx] = (bf16_t)f2bf(s); s = dv[u] * s + uv[u]; }
        }
    }
}

__device__ __forceinline__ void gla_out_item(unsigned char* lds, unsigned char* ws, const float* wgate, const float* bgate, const float* hnorm, int l, int item, bool dowrite = true) {
    const int c = item % 132, h = (item / 132) & 3, b = item / 528;
    const int t0 = b * TB + c * 64;
    int tid_ = threadIdx.x; asm volatile("" : "+v"(tid_));
    const int tid = tid_, lane = tid & 63, wid = tid >> 6, ql = lane & 15, g = lane >> 4;
    const float* Bs = (const float*)(lds + GL_BS);
    bf16_t* QE = (bf16_t*)(lds + GL_QE); bf16_t* KE = (bf16_t*)(lds + GL_KE); bf16_t* ATT = (bf16_t*)(lds + GL_ATT); const bf16_t* Vt = (const bf16_t*)(lds + GL_VT);
    const u32x4 qraw = *(const u32x4*)((const bf16_t*)(ws + O_CQ) + (size_t)(t0 + (tid >> 3)) * 256 + h * 64 + (tid & 7) * 8);
    const u32x4 kraw = *(const u32x4*)((const bf16_t*)(ws + O_CK) + (size_t)(t0 + (tid >> 3)) * 256 + h * 64 + (tid & 7) * 8);
    bf16x8 sfr[2][2];
#pragma unroll
    for (int dd = 0; dd < 2; ++dd)
#pragma unroll
        for (int kk = 0; kk < 2; ++kk) sfr[dd][kk] = *(const bf16x8*)((const bf16_t*)(ws + O_ST) + (size_t)(((b * 4 + h) * 2 + dd) * 132 + c) * 8192 + (wid * 16 + ql) * 64 + kk * 32 + g * 8);
    const u32x4 rraw0 = *(const u32x4*)((const bf16_t*)(ws + O_CR) + (size_t)(t0 + (tid >> 3)) * 512 + h * 128 + (tid & 7) * 16);
    const u32x4 rraw1 = *(const u32x4*)((const bf16_t*)(ws + O_CR) + (size_t)(t0 + (tid >> 3)) * 512 + h * 128 + (tid & 7) * 16 + 8);
    gla_load_vt(lds, (const bf16_t*)(ws + O_CV) + (size_t)t0 * 512 + h * 128);
    f32x4 oacc[4];
#pragma unroll
    for (int rb = 0; rb < 4; ++rb) oacc[rb] = (f32x4){0.f, 0.f, 0.f, 0.f};
    for (int dir = 0; dir < 2; ++dir) {
        gla_decay(lds, (const float*)(ws + O_GLOW) + (size_t)t0 * 32, wgate + (size_t)((l * 2 + dir) * 16) * 256 + h * 64, bgate + (l * 2 + dir) * 256 + h * 64, dir);
        { const int s = tid >> 3, dg = tid & 7;
          float qv[8], kv[8];
          unpack8(qraw, qv);
          unpack8(kraw, kv);
#pragma unroll
          for (int e = 0; e < 8; ++e) { const float bv = Bs[s * 65 + dg * 8 + e]; qv[e] *= __expf(bv); kv[e] *= __expf(-bv); }
          *(u32x4*)(QE + s * 72 + dg * 8) = pack8(qv); *(u32x4*)(KE + s * 72 + dg * 8) = pack8(kv); }
        __syncthreads();
        { const int rb = wid >> 1;
#pragma unroll
          for (int cc = 0; cc < 2; ++cc) { const int cb = (wid & 1) * 2 + cc; f32x4 a4 = (f32x4){0.f, 0.f, 0.f, 0.f};
#pragma unroll
              for (int kk = 0; kk < 2; ++kk) { const bf16x8 a = *(const bf16x8*)(QE + (rb * 16 + ql) * 72 + kk * 32 + g * 8); const bf16x8 bb = *(const bf16x8*)(KE + (cb * 16 + ql) * 72 + kk * 32 + g * 8);
                  a4 = __builtin_amdgcn_mfma_f32_16x16x32_bf16(a, bb, a4, 0, 0, 0); }
#pragma unroll
              for (int j = 0; j < 4; ++j) { const int i = rb * 16 + g * 4 + j, ip = cb * 16 + ql; const bool keep = dir == 0 ? (ip <= i) : (ip >= i); ATT[i * 72 + ip] = (bf16_t)f2bf(keep ? a4[j] : 0.f); } } }
        __syncthreads();
        { const int sidx = ((b * 4 + h) * 2 + dir) * 132 + c;
          const bf16_t* st = (const bf16_t*)(ws + O_ST) + (size_t)sidx * 8192;
#pragma unroll
          for (int kk = 0; kk < 2; ++kk) {
              const bf16x8 bv = *(const bf16x8*)(Vt + (wid * 16 + ql) * 72 + kk * 32 + g * 8);
              const bf16x8 bs = dir == 0 ? sfr[0][kk] : sfr[1][kk];
#pragma unroll
              for (int rb = 0; rb < 4; ++rb) {
                  const bf16x8 a1 = *(const bf16x8*)(ATT + (rb * 16 + ql) * 72 + kk * 32 + g * 8);
                  const bf16x8 a2 = *(const bf16x8*)(QE + (rb * 16 + ql) * 72 + kk * 32 + g * 8);
                  oacc[rb] = __builtin_amdgcn_mfma_f32_16x16x32_bf16(a1, bv, oacc[rb], 0, 0, 0);
                  oacc[rb] = __builtin_amdgcn_mfma_f32_16x16x32_bf16(a2, bs, oacc[rb], 0, 0, 0);
              } } }
        __syncthreads();
    }
    float* Os = (float*)(lds + GL_O);
#pragma unroll
    for (int rb = 0; rb < 4; ++rb)
#pragma unroll
        for (int j = 0; j < 4; ++j) Os[(rb * 16 + g * 4 + j) * 132 + wid * 16 + ql] = oacc[rb][j];
    __syncthreads();
    { const int i = tid >> 3, eg = tid & 7;
      float ov[16]; float ss = 0.f;
#pragma unroll
      for (int e = 0; e < 16; ++e) { ov[e] = Os[i * 132 + eg * 16 + e]; ss += ov[e] * ov[e]; }
      ss += __shfl_xor(ss, 1); ss += __shfl_xor(ss, 2); ss += __shfl_xor(ss, 4);
      const float rstd = rsqrtf(ss * (1.f / 128.f) + EPS);
      const float* gn = hnorm + l * 512 + h * 128 + eg * 16;
      bf16_t* rp = (bf16_t*)(ws + O_CR) + (size_t)(t0 + i) * 512 + h * 128 + eg * 16;
#pragma unroll
      for (int hh = 0; hh < 2; ++hh) { float rv[8]; unpack8(hh == 0 ? rraw0 : rraw1, rv);
#pragma unroll
          for (int e = 0; e < 8; ++e) rv[e] = ov[hh * 8 + e] * rstd * gn[hh * 8 + e] * siluf_(rv[e]);
          if (dowrite) *(u32x4*)(rp + hh * 8) = pack8(rv); } }
    __syncthreads();
}

#ifndef REPK
#define REPK 0
#endif
#ifndef REP_SYNC
#define REP_SYNC 0
#endif
#ifndef ASEL
#define ASEL 31
#endif
#ifndef PM
#define PM 0xffff
#endif
#define ON(k) (((PM) >> (k)) & 1)
typedef const __attribute__((address_space(4))) Args* CArgsP;
__global__ void __launch_bounds__(NTHR, 2) mk_fwd(Args args) {
    extern __shared__ __attribute__((aligned(16))) unsigned char lds[];
    cg::grid_group grid = cg::this_grid();
    volatile LASX unsigned* misc = (volatile LASX unsigned*)((LASX unsigned char*)lds + 131072 + 512);
    if (threadIdx.x < 16) misc[threadIdx.x] = 0u;
    __syncthreads();
    XcdBarrier xbar = xcd_barrier_post((unsigned*)(args.ws + O_BAR), misc + 8);
    if (args.ph_hi < 0) grid.sync();
    int rep = 0;
    for (int ph = args.ph_lo; ph < args.ph_hi; ) {
        int tid_k = threadIdx.x; asm volatile("" : "+v"(tid_k));
        const int tid = tid_k, lane = tid & 63, wid = __builtin_amdgcn_readfirstlane(tid >> 6);
        int G_k = gridDim.x, bid_k = blockIdx.x; asm volatile("" : "+s"(G_k), "+s"(bid_k));
        const int G = G_k, bid = bid_k, gw = bid * NWAVES + wid, NGW = G * NWAVES;
        CArgsP ap = (CArgsP)__builtin_amdgcn_kernarg_segment_ptr(); asm volatile("" : "+s"(ap));
        unsigned char* ws = ap->ws;
        float* MOD = (float*)(ws + O_MOD); float* X = (float*)(ws + O_X); bf16_t* HM = (bf16_t*)(ws + O_HM);
        if (ON(11) && ph == 0) {
            float* sv = (float*)lds; float* red = sv + 3072;
            for (int item = bid; item < 4 * 48; item += G) {
                const int l = item / 48, n0 = (item % 48) * 128;
                for (int idx = tid; idx < 3072; idx += NTHR) { const int r = idx >> 10, k = idx & 1023; const float cv = (r < 2) ? ap->in[I_C][r * 1024 + k] : ap->in[I_CCTX][k]; sv[idx] = siluf_(cv); }
                __syncthreads();
                const int kq = tid >> 7, nn = tid & 127; float a0 = 0.f, a1 = 0.f, a2 = 0.f;
                const float* wp = ap->in[I_WMOD] + ((size_t)l * 1024 + kq * 256) * 6144 + n0 + nn;
#pragma unroll 32
                for (int k = 0; k < 256; ++k) { const float w = wp[(size_t)k * 6144]; a0 += sv[kq * 256 + k] * w; a1 += sv[1024 + kq * 256 + k] * w; a2 += sv[2048 + kq * 256 + k] * w; }
                red[(kq * 3 + 0) * 128 + nn] = a0; red[(kq * 3 + 1) * 128 + nn] = a1; red[(kq * 3 + 2) * 128 + nn] = a2;
                __syncthreads();
                if (tid < 384) { const int r = tid >> 7, n2 = tid & 127; float a = ap->in[I_BMOD][l * 6144 + n0 + n2];
                    for (int q = 0; q < 4; ++q) a += red[(q * 3 + r) * 128 + n2];
                    MOD[(l * 3 + r) * 6144 + n0 + n2] = a; }
                __syncthreads();
            }
            float* RA = (float*)(ws + O_ROPEA); float* RB = (float*)(ws + O_ROPEB);
            for (int idx = bid * NTHR + tid; idx < 8192 * 32; idx += G * NTHR) { const int pos = idx >> 5, j = idx & 31;
                const float inv = exp2f(-(float)(j & 15) * (13.287712379549449f / 16.f)); const float p = (j < 16) ? (float)(pos >> 6) : (float)(pos & 63); const float ang = p * inv;
                RA[pos * 64 + j] = __cosf(ang); RA[pos * 64 + 32 + j] = __sinf(ang); }
            for (int idx = bid * NTHR + tid; idx < 8192 * 16; idx += G * NTHR) { const int pos = idx >> 4, j = idx & 15;
                const float inv = exp2f(-(float)(j & 7) * (13.287712379549449f / 8.f)); const float p = (j < 8) ? (float)(pos >> 6) : (float)(pos & 63); const float ang = p * inv;
                RB[pos * 32 + j] = __cosf(ang); RB[pos * 32 + 16 + j] = __sinf(ang); }
        } else if (ON(12) && ph == 45) {
            for (int r = gw; r < NB * SEQ; r += NGW) { const int b = r >> 13, s = r & 8191;
                const f32x4* xr = (const f32x4*)(X + (size_t)(b * TB + LC + s) * 1024) + lane; f32x4 v[4]; float ss = 0.f;
#pragma unroll
                for (int j = 0; j < 4; ++j) { v[j] = xr[64 * j]; ss += (v[j][0] * v[j][0] + v[j][1] * v[j][1]) + (v[j][2] * v[j][2] + v[j][3] * v[j][3]); }
                const float rstd = rsqrtf(wave_sum(ss) * (1.f / 1024.f) + EPS);
#pragma unroll
                for (int j = 0; j < 4; ++j) { const f32x4 w = ((const f32x4*)ap->in[I_FNORM])[64 * j + lane]; f32x4 o; o[0] = v[j][0] * rstd * w[0]; o[1] = v[j][1] * rstd * w[1]; o[2] = v[j][2] * rstd * w[2]; o[3] = v[j][3] * rstd * w[3];
                    ((f32x4*)(ap->out + (size_t)r * 1024))[64 * j + lane] = o; } }
        } else {
            const int l = (ph - 1) / 11, k = (ph - 1) % 11;
            const float* modl = MOD + l * 3 * 6144;
            if (ON(0) && k == 0) {
                float* scr = (float*)lds + wid * (64 * 33);
                constexpr int I0 = 184 * 16, I1 = I0 + 24 * 4, I2 = I1 + 32 * 4, I3 = I2 + 3 * 32 * 8, I4 = I3 + 32 * 16, I5 = I4 + 176 * 16, I6 = I5 + 32 * 44;
                for (int it = gw; it < I6; it += NGW) {
                    if (it < I0) transpose_item(ap->in[I_WIN] + (size_t)l * 1024 * IN_DIM, 1024, IN_DIM, (bf16_t*)(ws + O_WIN), 1024, it, MAT_IN, nullptr, scr, lane);
                    else if (it < I1) transpose_item(ap->in[I_WUQ] + (size_t)l * 256 * 768, 256, 768, (bf16_t*)(ws + O_WUQ), 256, it - I0, MAT_UQ, ap->in[I_QNORM] + l * 256, scr, lane);
                    else if (it < I2) transpose_item(ap->in[I_WUKV] + (size_t)l * 128 * 1024, 128, 1024, (bf16_t*)(ws + O_WUKV), 256, it - I1, MAT_PLAIN, ap->in[I_KVNORM] + l * 128, scr, lane);
                    else if (it < I3) { const int r = it - I2, br = r / 256; const float* src = (br == 0 ? ap->in[I_WBRA] : (br == 1 ? ap->in[I_WBRB] : ap->in[I_WBRC])) + (size_t)l * 512 * 1024;
                        transpose_item(src, 512, 1024, (bf16_t*)(ws + O_WBR) + (size_t)br * 1024 * 512, 512, r - br * 256, MAT_PLAIN, nullptr, scr, lane); }
                    else if (it < I4) transpose_item(ap->in[I_WOUT] + (size_t)l * 1024 * 1024, 1024, 1024, (bf16_t*)(ws + O_WOUT), 1024, it - I3, MAT_PLAIN, nullptr, scr, lane);
                    else if (it < I5) transpose_item(ap->in[I_WUP] + (size_t)l * 1024 * FF2, 1024, FF2, (bf16_t*)(ws + O_WUP), 1024, it - I4, MAT_PLAIN, nullptr, scr, lane);
                    else transpose_item(ap->in[I_WDOWN] + (size_t)l * FF * 1024, FF, 1024, (bf16_t*)(ws + O_WDOWN), FF, it - I5, MAT_PLAIN, nullptr, scr, lane);
                }
                for (int idx = bid * NTHR + tid; idx < MT * 2; idx += G * NTHR) ((float*)(ws + O_SSQ))[idx] = 0.f;
#define NORM1_PAR(P, t) do { const int b = ((t) >= TB) ? 1 : 0, i = (t) - b * TB, r = (i >= LC) ? b : 2; \
                    P.src = X + (size_t)(t) * 1024; P.cp = nullptr; P.part = nullptr; P.gv = nullptr; P.nsl = 11; \
                    if (l == 0) { P.src = (i >= LC) ? ap->in[I_X] + ((size_t)b * SEQ + (i - LC)) * 1024 : ap->in[I_CTX] + ((size_t)b * LC + i) * 1024; P.cp = X + (size_t)(t) * 1024; } \
                    if (l > 0 && i < LC) { P.part = (const float*)(ws + O_U) + (size_t)(b * 256 + i) * 1024; P.gv = MOD + ((l - 1) * 3 + 2) * 6144 + 5120; P.cp = X + (size_t)(t) * 1024; } \
                    P.sc = modl + r * 6144 + 1024; P.sh = modl + r * 6144; P.orow = HM + (size_t)(t) * 1024; } while (0)
                for (int t = gw; t < MT; t += 2 * NGW) {
                    const int tB = t + NGW; const bool hb = tB < MT;
                    const int tBc = hb ? tB : t;
                    NormPar PA, PB; NormRow RA, RB; NORM1_PAR(PA, t); NORM1_PAR(PB, tBc);
                    norm_load(RA, PA, lane); norm_load(RB, PB, lane);
                    norm_finish(RA, PA, ap->in[I_NMIX] + l * 1024, lane); if (hb) norm_finish(RB, PB, ap->in[I_NMIX] + l * 1024, lane);
                }
#undef NORM1_PAR
            } else if (ON(1) && k == 1) {
                EpiIn E{ws}; run_gemm(lds, HM, (const bf16_t*)(ws + O_WIN), MT, NPIN, 1024, E);
            } else if (ON(2) && k == 2) {
                if (ON(13)) { EpiUq E{ws}; run_gemm(lds, (const bf16_t*)(ws + O_CQB), (const bf16_t*)(ws + O_WUQ), MT, 768, 256, E); }
                if (ON(14)) { EpiUkv E{ws}; run_gemm(lds, (const bf16_t*)(ws + O_CKVB), (const bf16_t*)(ws + O_WUKV), MT, 1024, 256, E); }
                if (ON(15)) for (int item = bid; item < 2112; item += G) gla_state_item(lds, ws, ap->in[I_WGATE], ap->in[I_BGATE], l, item);
            } else if (ON(3) && k == 3) {
                if ((ASEL & 16) && rep == 0) gla_scan(ws, bid, tid, G);
                for (int L = bid; L < (rep == 0 ? 544 : 256); L += G) {
                    const int npass = (PROBE_AA && L >= 256 && L < 768) ? 2 : 1;
                    for (int pass = 0; pass < npass; ++pass) {
                    if ((ASEL & 1) && L < 256) { const int bh_ = (L & 7) + 8 * ((L >> 3) & 1), b = bh_ >> 3, h = bh_ & 7, qs = L >> 4;
                        attn_unit<96, false, 4>(lds, (const bf16_t*)(ws + O_QB) + (size_t)b * TB * 768 + h * 96, 768, (const bf16_t*)(ws + O_KB) + (size_t)b * TB * 768 + h * 96, 768,
                                             (const bf16_t*)(ws + O_VBT) + (size_t)(b * 8 + h) * 64 * TB, (bf16_t*)(ws + O_YB) + (size_t)b * TB * 512 + h * 64, 512, LC + qs * 512, 0, 132, 0, 0, 0.f, false);
                    } else if ((ASEL & 2) && L >= 256 && L < 512) { const int L2 = L - 256, bh_ = (L2 & 7) + 8 * ((L2 >> 3) & 1), b = bh_ >> 3, h = bh_ & 7, qs = L2 >> 4, kvh = h >> 2;
                        const int p0 = qs * 512, lo = (p0 - 128 < 0) ? 0 : p0 - 128, hi = (p0 + 640 > SEQ) ? SEQ : p0 + 640;
                        bf16_t* qo = (bf16_t*)(ws + O_QA) + (size_t)b * TB * 512 + h * 64;
                        attn_unit<64, true, 4>(lds, qo, 512, (const bf16_t*)(ws + O_KA) + (size_t)b * TB * 128 + kvh * 64, 128, (const bf16_t*)(ws + O_VAT) + (size_t)(b * 2 + kvh) * 64 * TB,
                                            qo, 512, LC + p0, 0, 4, (lo + LC) / 64, (hi - lo) / 64, ap->in[I_SINK][l * 8 + h] * LOG2E, true);
                    } else if ((ASEL & 4) && L >= 512 && L < 528) { const int L2 = L - 512, b = L2 >> 3, h = L2 & 7;
                        attn_unit<96, false, 2>(lds, (const bf16_t*)(ws + O_QB) + (size_t)b * TB * 768 + h * 96, 768, (const bf16_t*)(ws + O_KB) + (size_t)b * TB * 768 + h * 96, 768,
                                             (const bf16_t*)(ws + O_VBT) + (size_t)(b * 8 + h) * 64 * TB, (bf16_t*)(ws + O_YB) + (size_t)b * TB * 512 + h * 64, 512, 0, 0, 4, 0, 0, 0.f, false);
                    } else if ((ASEL & 8) && L >= 528) { const int L2 = L - 528, b = L2 >> 3, h = L2 & 7, kvh = h >> 2;
                        bf16_t* qo = (bf16_t*)(ws + O_QA) + (size_t)b * TB * 512 + h * 64;
                        attn_unit<64, false, 2>(lds, qo, 512, (const bf16_t*)(ws + O_KA) + (size_t)b * TB * 128 + kvh * 64, 128, (const bf16_t*)(ws + O_VAT) + (size_t)(b * 2 + kvh) * 64 * TB,
                                             qo, 512, 0, 0, 4, 0, 0, ap->in[I_SINK][l * 8 + h] * LOG2E, true);
                    }
                    }
                }
            } else if (ON(4) && k == 4) {
                if (PROBE_GC) for (int item = bid; item < 1056; item += G) gla_out_item(lds, ws, ap->in[I_WGATE], ap->in[I_BGATE], ap->in[I_HNORM], l, item, false);
                for (int item = bid; item < 1056; item += G) gla_out_item(lds, ws, ap->in[I_WGATE], ap->in[I_BGATE], ap->in[I_HNORM], l, item);
            } else if (ON(5) && k == 5) {
                { EpiMerge<0> E{ws}; run_gemm_main(lds, (const bf16_t*)(ws + O_QA), (const bf16_t*)(ws + O_WBR), 1024, 512, E); }
                { EpiMerge<1> E{ws}; run_gemm_main(lds, (const bf16_t*)(ws + O_YB), (const bf16_t*)(ws + O_WBR) + (size_t)1024 * 512, 1024, 512, E); }
                { EpiMerge<2> E{ws}; run_gemm_main(lds, (const bf16_t*)(ws + O_CR), (const bf16_t*)(ws + O_WBR) + (size_t)2 * 1024 * 512, 1024, 512, E); }
                { EpiMergePart<0> E{ws, 256 * 2}; run_gemm_ctx(lds, (const bf16_t*)(ws + O_QA), (const bf16_t*)(ws + O_WBR), 1024, 512, 2, E, 64); }
                { EpiMergePart<1> E{ws, 256 * 2}; run_gemm_ctx(lds, (const bf16_t*)(ws + O_YB), (const bf16_t*)(ws + O_WBR) + (size_t)1024 * 512, 1024, 512, 2, E, 96); }
                { EpiMergePart<2> E{ws, 256 * 2}; run_gemm_ctx(lds, (const bf16_t*)(ws + O_CR), (const bf16_t*)(ws + O_WBR) + (size_t)2 * 1024 * 512, 1024, 512, 2, E, 128); }
            } else if (ON(6) && k == 6) {
                for (int r = gw; r < 512; r += NGW) { const int t = (r < 256) ? r : (TB + r - 256);
                    const f32x4* sp = (const f32x4*)((const float*)(ws + O_CQ) + (size_t)r * 1024);
#pragma unroll
                    for (int j = 0; j < 4; ++j) { f32x4 a = sp[64 * j + lane];
#pragma unroll
                        for (int q = 1; q < 6; ++q) a = a + sp[(size_t)q * 512 * 256 + 64 * j + lane];
                        u32x2 o; o.x = pk2(a[0], a[1]); o.y = pk2(a[2], a[3]); ((u32x2*)(HM + (size_t)t * 1024))[64 * j + lane] = o; } }
                xcd_barrier(xbar);
                if (PROBE_OD) { EpiNull E{(float*)(ws + O_SSQ)}; run_gemm_main(lds, HM, (const bf16_t*)(ws + O_WOUT), 1024, 1024, E); run_gemm_ctx(lds, HM, (const bf16_t*)(ws + O_WOUT), 1024, 1024, 4, E); }
                { EpiResid E{ws, modl, 2048}; run_gemm_main(lds, HM, (const bf16_t*)(ws + O_WOUT), 1024, 1024, E); }
                { EpiPartial E{(float*)(ws + O_GATES), 256 * 2}; run_gemm_ctx(lds, HM, (const bf16_t*)(ws + O_WOUT), 1024, 1024, 4, E); }
            } else if (ON(7) && k == 7) {
#define NORM2_PAR(P, t) do { const int b = ((t) >= TB) ? 1 : 0, i = (t) - b * TB, r = (i >= LC) ? b : 2; \
                    P.src = X + (size_t)(t) * 1024; P.cp = nullptr; P.part = nullptr; P.gv = nullptr; P.nsl = 4; \
                    if (i < LC) { P.part = (const float*)(ws + O_GATES) + (size_t)(b * 256 + i) * 1024; P.gv = modl + 2 * 6144 + 2048; P.cp = X + (size_t)(t) * 1024; } \
                    P.sc = modl + r * 6144 + 4096; P.sh = modl + r * 6144 + 3072; P.orow = HM + (size_t)(t) * 1024; } while (0)
                for (int t = gw; t < MT; t += 2 * NGW) {
                    const int tB = t + NGW; const bool hb = tB < MT;
                    const int tBc = hb ? tB : t;
                    NormPar PA, PB; NormRow RA, RB; NORM2_PAR(PA, t); NORM2_PAR(PB, tBc);
                    norm_load(RA, PA, lane); norm_load(RB, PB, lane);
                    norm_finish(RA, PA, ap->in[I_NFFN] + l * 1024, lane); if (hb) norm_finish(RB, PB, ap->in[I_NFFN] + l * 1024, lane);
                }
#undef NORM2_PAR
            } else if (ON(8) && k == 8) {
                EpiStore E{(bf16_t*)(ws + O_U), FF2}; run_gemm(lds, HM, (const bf16_t*)(ws + O_WUP), MT, FF2, 1024, E);
            } else if (ON(9) && k == 9) {
                const bf16_t* U = (const bf16_t*)(ws + O_U); bf16_t* ACT = (bf16_t*)(ws + O_ACT);
                const float* cw = ap->in[I_CONVW] + (size_t)l * 3 * FF2; const float* cb = ap->in[I_CONVB] + (size_t)l * FF2;
#pragma unroll 1
                for (int idx = bid * NTHR + tid; idx < (MT / 16) * 352; idx += G * NTHR) {
                    const int tb = idx / 352, j0 = (idx - tb * 352) * 8; const int t0 = tb * 16; const int b = (t0 >= TB) ? 1 : 0, i0 = t0 - b * TB;
                    float wg0[8], wg1[8], wg2[8], bg[8], wv0[8], wv1[8], wv2[8], bv[8];
#pragma unroll
                    for (int e = 0; e < 8; ++e) { wg0[e] = cw[j0 + e]; wg1[e] = cw[FF2 + j0 + e]; wg2[e] = cw[2 * FF2 + j0 + e]; bg[e] = cb[j0 + e];
                        wv0[e] = cw[FF + j0 + e]; wv1[e] = cw[FF2 + FF + j0 + e]; wv2[e] = cw[2 * FF2 + FF + j0 + e]; bv[e] = cb[FF + j0 + e]; }
                    const bf16_t* up = U + (size_t)t0 * FF2 + j0;
                    u32x4 gp_ = (u32x4){0u, 0u, 0u, 0u}, vp_ = (u32x4){0u, 0u, 0u, 0u};
                    if (i0 != 0 && i0 != LC) { gp_ = *(const u32x4*)(up - FF2); vp_ = *(const u32x4*)(up - FF2 + FF); }
                    u32x4 gc_ = *(const u32x4*)up, vc_ = *(const u32x4*)(up + FF);
#pragma unroll 4
                    for (int r = 0; r < 16; ++r) {
                        u32x4 gn_ = (u32x4){0u, 0u, 0u, 0u}, vn_ = (u32x4){0u, 0u, 0u, 0u};
                        const int ii = i0 + r;
                        if (ii != LC - 1 && ii != TB - 1) { gn_ = *(const u32x4*)(up + (size_t)(r + 1) * FF2); vn_ = *(const u32x4*)(up + (size_t)(r + 1) * FF2 + FF); }
                        float gm[8], gc[8], gn[8], vm[8], vc[8], vn[8], o[8];
                        unpack8(gp_, gm); unpack8(gc_, gc); unpack8(gn_, gn); unpack8(vp_, vm); unpack8(vc_, vc); unpack8(vn_, vn);
#pragma unroll
                        for (int e = 0; e < 8; ++e) {
                            const float a = wg0[e] * gm[e] + wg1[e] * gc[e] + wg2[e] * gn[e] + bg[e];
                            const float v = wv0[e] * vm[e] + wv1[e] * vc[e] + wv2[e] * vn[e] + bv[e];
                            o[e] = siluf_(a) * v;
                        }
                        *(u32x4*)(ACT + (size_t)(t0 + r) * FF + j0) = pack8(o);
                        gp_ = gc_; vp_ = vc_; gc_ = gn_; vc_ = vn_;
                    }
                }
            } else if (ON(10) && k == 10) {
                if (PROBE_OD) { EpiNull E{(float*)(ws + O_SSQ)}; run_gemm_main(lds, (const bf16_t*)(ws + O_ACT), (const bf16_t*)(ws + O_WDOWN), 1024, FF, E); run_gemm_ctx(lds, (const bf16_t*)(ws + O_ACT), (const bf16_t*)(ws + O_WDOWN), 1024, FF, 11, E); }
                { EpiResid E{ws, modl, 5120}; run_gemm_main(lds, (const bf16_t*)(ws + O_ACT), (const bf16_t*)(ws + O_WDOWN), 1024, FF, E); }
                { EpiPartial E{(float*)(ws + O_U), 256 * 2}; run_gemm_ctx(lds, (const bf16_t*)(ws + O_ACT), (const bf16_t*)(ws + O_WDOWN), 1024, FF, 11, E); }
            }
        }
        { const int kk_ = (ph >= 1 && ph <= 44) ? (ph - 1) % 11 : 15;
          const bool again = (rep == 0) && (((REPK) >> kk_) & 1);
          if (again) rep = 1; else { rep = 0; ++ph; }
          if (again || ph < args.ph_hi) { xcd_barrier(xbar); if (REP_SYNC) xcd_barrier(xbar); } }
    }
}

constexpr int N_PHASES = 46;
extern "C" void kernel_launch(void* const* d_in, const int* in_sizes, int n_in, void* d_out, int out_size, void* d_ws, size_t ws_size, hipStream_t stream) {
    static int grid = 0;
    if (grid == 0) {
        if (n_in != N_IN || ws_size < O_END) { fprintf(stderr, "kernel_launch: bad shapes: n_in %d ws %zu (need %zu)\n", n_in, ws_size, (size_t)O_END); grid = -1; return; }
        int dev = 0, cus = 0, per_cu = 0;
        hipGetDevice(&dev); hipDeviceGetAttribute(&cus, hipDeviceAttributeMultiprocessorCount, dev);
        if (hipFuncSetAttribute((const void*)mk_fwd, hipFuncAttributeMaxDynamicSharedMemorySize, LDS_BYTES) != hipSuccess) { fprintf(stderr, "kernel_launch: hipFuncSetAttribute failed\n"); grid = -1; return; }
        hipOccupancyMaxActiveBlocksPerMultiprocessor(&per_cu, (const void*)mk_fwd, NTHR, LDS_BYTES);
        (void)hipGetLastError();
        if (per_cu < 1) per_cu = 1;
        grid = cus * 1;
        fprintf(stderr, "kernel_launch: cus %d per_cu %d grid %d\n", cus, per_cu, grid);
    }
    if (grid < 0) return;
    if (hipMemsetAsync((char*)d_ws + O_BAR, 0, 16384, stream) != hipSuccess) { fprintf(stderr, "kernel_launch: memset failed\n"); return; }
    Args a{};
    for (int i = 0; i < N_IN; ++i) a.in[i] = (const float*)d_in[i];
    a.out = (float*)d_out; a.ws = (unsigned char*)d_ws;
#if ONE_LAUNCH
    a.ph_lo = 0; a.ph_hi = N_PHASES;
    void* kargs[] = {&a};
    hipError_t e = hipLaunchCooperativeKernel((const void*)mk_fwd, dim3(grid), dim3(NTHR), kargs, LDS_BYTES, stream);
    if (e != hipSuccess) fprintf(stderr, "cooperative launch failed: %s (grid %d)\n", hipGetErrorString(e), grid);
#else
    for (int ph = 0; ph < N_PHASES; ++ph) { a.ph_lo = ph; a.ph_hi = ph + 1; hipLaunchKernelGGL(mk_fwd, dim3(grid), dim3(NTHR), LDS_BYTES, stream, a); }
#endif
}
```

```cpp
#include <hip/hip_runtime.h>
#include <hip/hip_cooperative_groups.h>
#include <cstdio>
#include <cstdint>
namespace cg = cooperative_groups;
#ifndef ONE_LAUNCH
#define ONE_LAUNCH 1
#endif
namespace pg8 {
#define PG8_LAS __attribute__((address_space(3)))
typedef unsigned short bf16_t;
typedef short bf16x8 __attribute__((ext_vector_type(8)));
typedef float f32x4 __attribute__((ext_vector_type(4)));
typedef unsigned u32x4 __attribute__((ext_vector_type(4)));
constexpr int BM = 256, BK = 64, HALF = 128, HTB = HALF * BK * 2  , STAGE_BYTES = 8 * HTB, NXCD = 8, WGM = 8;

__host__ __device__ __forceinline__ int lds_byte(int r, int c) { const int st = (r >> 4) * 2 + (c >> 5), rr = r & 15, cc = c & 31, ob = rr * 64 + cc * 2; return st * 1024 + (ob ^ (((ob >> 9) & 1) << 5)); }
__host__ __device__ __forceinline__ void stage_rc(int b, int& R, int& C) { const int st = b / 1024, sb = b % 1024, swz = sb ^ (((sb >> 9) & 1) << 5); R = (st >> 1) * 16 + swz / 64; C = (st & 1) * 32 + (swz % 64) / 2; }
__host__ __device__ __forceinline__ int perm32(int rho) { const int n = rho >> 4, i = rho & 15; return 8 * (i >> 2) + 4 * n + (i & 3); }

struct Unit { int pm, pn, kb; };
struct Gemm { const bf16_t* A; const bf16_t* Bt; int M, N, K, Kloop; };

struct StaticOrder {
    int nM, nN, nwg, G, c;
    __host__ __device__ void init(int M, int N, int G_, int c_) { nM = M / BM; nN = N / BM; nwg = nM * nN; G = G_; c = c_; }
    __host__ __device__ bool next(int i, Unit& u) const {
        const long L = (long)i * G + c; if (L >= nwg) return false;
        int wgid = (int)L; { const int q = nwg / NXCD, r = nwg % NXCD, xcd = wgid % NXCD, off = wgid / NXCD; wgid = (xcd < r ? xcd * (q + 1) : r * (q + 1) + (xcd - r) * q) + off; }
        const int nig = WGM * nN, gid = wgid / nig, fm = gid * WGM, gsz = (nM - fm) < WGM ? (nM - fm) : WGM;
        u.pm = fm + ((wgid % nig) % gsz); u.pn = (wgid % nig) / gsz; u.kb = 0; return true;
    }
    __device__ __forceinline__ void a_ready(const Unit&) const {}
    __device__ __forceinline__ void done(const Unit&) const {}
};

__device__ __forceinline__ unsigned cvt_pk_bf16(float lo, float hi) { unsigned r; asm volatile("v_cvt_pk_bf16_f32 %0, %1, %2" : "=v"(r) : "v"(lo), "v"(hi)); return r; }
template <class Epi, class Sched, bool ALIGN_EPI = false, bool SP2 = false>
__device__ __forceinline__ void gemm_phase(PG8_LAS unsigned char* lds, const Gemm g, const Sched& S, const Epi& E) {
    int tid_ = threadIdx.x; asm volatile("" : "+v"(tid_));
    const int tid = tid_, wid = __builtin_amdgcn_readfirstlane(tid >> 6), lane = tid & 63, wr = wid >> 2, wc = wid & 3, fr = lane & 15, fq = lane >> 4;
    const int K = g.K, nt = g.Kloop / BK;
    unsigned voffA[2], voffB[2];
#pragma unroll
    for (int i = 0; i < 2; ++i) { int R, C; stage_rc(tid * 16 + i * 8192, R, C); const int Rb = Epi::PERM ? ((R & ~31) + perm32(R & 31)) : R;
        voffA[i] = (unsigned)(R * K + C) * 2u; voffB[i] = (unsigned)(Rb * K + C) * 2u; }
    const size_t kstep = (size_t)(BK * 2);
    const size_t hstep = (size_t)HALF * K * 2;
    const size_t tstep = 2 * hstep;
    const unsigned ldsw = (unsigned)wid * 1024u;
    const int aoff = lds_byte(wr * 64 + fr, fq * 8), boff = lds_byte(wc * 32 + fr, fq * 8);
#define PG8_SA(b, h) (((b) * 2 + (h)) * HTB)
#define PG8_SB(b, h) ((4 + (b) * 2 + (h)) * HTB)
#define PG8_STAGE(bufoff, gbase, voff) do { _Pragma("unroll") for (int _i = 0; _i < 2; ++_i) \
        __builtin_amdgcn_global_load_lds((const unsigned*)((const char*)(gbase) + (voff)[_i]), (PG8_LAS unsigned*)(lds + (bufoff) + ldsw + _i * 8192), 16, 0, 0); } while (0)
#define PG8_LDA(dst, b, h) do { _Pragma("unroll") for (int m = 0; m < 4; ++m) _Pragma("unroll") for (int k = 0; k < 2; ++k) dst[m][k] = *(const PG8_LAS bf16x8*)(lds + PG8_SA(b, h) + aoff + m * 2048 + k * 1024); } while (0)
#define PG8_LDB(dst, b, h) do { _Pragma("unroll") for (int n = 0; n < 2; ++n) _Pragma("unroll") for (int k = 0; k < 2; ++k) dst[n][k] = *(const PG8_LAS bf16x8*)(lds + PG8_SB(b, h) + boff + n * 2048 + k * 1024); } while (0)
#define PG8_MMA(ai, bj, At, Bt) do { __builtin_amdgcn_s_setprio(1); _Pragma("unroll") for (int m = 0; m < 4; ++m) _Pragma("unroll") for (int n = 0; n < 2; ++n) _Pragma("unroll") for (int k = 0; k < 2; ++k) \
        acc[ai][bj][m][n] = __builtin_amdgcn_mfma_f32_16x16x32_bf16(Bt[n][k], At[m][k], acc[ai][bj][m][n], 0, 0, 0); __builtin_amdgcn_s_setprio(0); } while (0)
#define PG8_WAIT_V(n) asm volatile("s_waitcnt vmcnt(" #n ")" ::: "memory")
#define PG8_WAIT_L(n) asm volatile("s_waitcnt lgkmcnt(" #n ")" ::: "memory")
#define PG8_BAR __builtin_amdgcn_s_barrier()
#define PG8_SCHED __builtin_amdgcn_sched_barrier(0)
    Unit cur, nxt; int ui = 0;
    if (!S.next(0, cur)) return;
    f32x4 acc[2][2][4][2];
#pragma unroll
    for (int a = 0; a < 2; ++a)
#pragma unroll
        for (int b = 0; b < 2; ++b)
#pragma unroll
            for (int m = 0; m < 4; ++m)
#pragma unroll
                for (int n = 0; n < 2; ++n) acc[a][b][m][n] = (f32x4){0.f, 0.f, 0.f, 0.f};
    bf16x8 At[4][2], B0[2][2], B1[2][2];
    const char* cA = (const char*)g.A + (size_t)cur.pm * tstep + cur.kb; const char* cB = (const char*)g.Bt + (size_t)cur.pn * tstep + cur.kb;
    S.a_ready(cur);
    if constexpr (SP2) {
        PG8_STAGE(PG8_SB(0, 0), cB, voffB); PG8_STAGE(PG8_SB(0, 1), cB + hstep, voffB); PG8_STAGE(PG8_SA(0, 0), cA, voffA); PG8_STAGE(PG8_SA(0, 1), cA + hstep, voffA);
        if (wr == 1) PG8_BAR;
        PG8_WAIT_V(2); PG8_BAR;
        PG8_STAGE(PG8_SB(1, 0), cB + kstep, voffB); PG8_STAGE(PG8_SA(1, 0), cA + kstep, voffA); PG8_STAGE(PG8_SB(1, 1), cB + hstep + kstep, voffB);
        PG8_WAIT_V(6); PG8_BAR;
    } else {
        PG8_STAGE(PG8_SB(0, 0), cB, voffB); PG8_STAGE(PG8_SA(0, 0), cA, voffA); PG8_STAGE(PG8_SB(0, 1), cB + hstep, voffB); PG8_STAGE(PG8_SA(0, 1), cA + hstep, voffA);
        if (wr == 1) PG8_BAR;
        PG8_WAIT_V(4); PG8_BAR;
        PG8_STAGE(PG8_SB(1, 0), cB + kstep, voffB); PG8_STAGE(PG8_SA(1, 0), cA + kstep, voffA); PG8_STAGE(PG8_SB(1, 1), cB + hstep + kstep, voffB);
        PG8_WAIT_V(6); PG8_BAR;
    }
    for (;;) {
        const bool has_next = S.next(ui + 1, nxt);
        const char* nA = has_next ? (const char*)g.A + (size_t)nxt.pm * tstep + nxt.kb : cA; const char* nB = has_next ? (const char*)g.Bt + (size_t)nxt.pn * tstep + nxt.kb : cB;
        for (int t = 0; t < nt; t += 2) {
            const bool last = (t == nt - 2);
            const char* a1 = cA + (size_t)(t + 1) * kstep;
            const char* a2 = last ? nA : cA + (size_t)(t + 2) * kstep; const char* b2 = last ? nB : cB + (size_t)(t + 2) * kstep;
            const char* a3 = a2 + kstep; const char* b3 = b2 + kstep;
            if (last && has_next) S.a_ready(nxt);
            if constexpr (SP2) {
            PG8_LDB(B0, 0, 0); PG8_LDB(B1, 0, 1); PG8_SCHED; PG8_LDA(At, 0, 0); PG8_STAGE(PG8_SA(1, 1), a1 + hstep, voffA);
            PG8_WAIT_V(8); PG8_WAIT_L(0); PG8_BAR; PG8_MMA(0, 0, At, B0); PG8_MMA(0, 1, At, B1); PG8_BAR; PG8_SCHED;
            PG8_LDA(At, 0, 1); PG8_STAGE(PG8_SB(0, 0), b2, voffB); PG8_STAGE(PG8_SB(0, 1), b2 + hstep, voffB); PG8_STAGE(PG8_SA(0, 0), a2, voffA);
            PG8_WAIT_V(8); PG8_WAIT_L(0); PG8_BAR; PG8_MMA(1, 0, At, B0); PG8_MMA(1, 1, At, B1); PG8_BAR; PG8_SCHED;
            PG8_LDB(B0, 1, 0); PG8_LDB(B1, 1, 1); PG8_SCHED; PG8_LDA(At, 1, 0); PG8_STAGE(PG8_SA(0, 1), a2 + hstep, voffA);
            PG8_WAIT_V(8); PG8_WAIT_L(0); PG8_BAR; PG8_MMA(0, 0, At, B0); PG8_MMA(0, 1, At, B1); PG8_BAR; PG8_SCHED;
            PG8_LDA(At, 1, 1); PG8_STAGE(PG8_SB(1, 0), b3, voffB); PG8_STAGE(PG8_SB(1, 1), b3 + hstep, voffB); PG8_STAGE(PG8_SA(1, 0), a3, voffA);
            PG8_WAIT_V(8); PG8_WAIT_L(0); PG8_BAR; PG8_MMA(1, 0, At, B0); PG8_MMA(1, 1, At, B1); PG8_BAR; PG8_SCHED;
            } else {
            PG8_LDB(B0, 0, 0); PG8_SCHED; PG8_LDA(At, 0, 0); PG8_STAGE(PG8_SA(1, 1), a1 + hstep, voffA);
            PG8_WAIT_L(8); PG8_BAR; PG8_WAIT_L(0); PG8_MMA(0, 0, At, B0); PG8_BAR; PG8_SCHED;
            PG8_LDB(B1, 0, 1); PG8_STAGE(PG8_SB(0, 0), b2, voffB);
            PG8_BAR; PG8_WAIT_L(0); PG8_MMA(0, 1, At, B1); PG8_BAR;
            PG8_LDA(At, 0, 1); PG8_STAGE(PG8_SA(0, 0), a2, voffA);
            PG8_BAR; PG8_WAIT_L(0); PG8_MMA(1, 0, At, B0); PG8_BAR; PG8_SCHED;
            PG8_STAGE(PG8_SB(0, 1), b2 + hstep, voffB);
            PG8_WAIT_V(6); PG8_BAR; PG8_MMA(1, 1, At, B1); PG8_BAR;
            PG8_LDB(B0, 1, 0); PG8_SCHED; PG8_LDA(At, 1, 0); PG8_STAGE(PG8_SA(0, 1), a2 + hstep, voffA);
            PG8_WAIT_L(8); PG8_BAR; PG8_WAIT_L(0); PG8_MMA(0, 0, At, B0); PG8_BAR; PG8_SCHED;
            PG8_LDB(B1, 1, 1); PG8_STAGE(PG8_SB(1, 0), b3, voffB);
            PG8_BAR; PG8_WAIT_L(0); PG8_MMA(0, 1, At, B1); PG8_BAR;
            PG8_LDA(At, 1, 1); PG8_STAGE(PG8_SA(1, 0), a3, voffA);
            PG8_BAR; PG8_WAIT_L(0); PG8_MMA(1, 0, At, B0); PG8_BAR; PG8_SCHED;
            PG8_STAGE(PG8_SB(1, 1), b3 + hstep, voffB);
            PG8_WAIT_V(6); PG8_BAR; PG8_MMA(1, 1, At, B1); PG8_BAR;
            }
        }
        if constexpr (ALIGN_EPI) { if (wr == 0) PG8_BAR; }
        if constexpr (!Epi::AFTER_DRAIN) { E(acc, cur, wr, wc, fr, fq); S.done(cur); }
        if (!has_next) break;
#pragma unroll
        for (int a = 0; a < 2; ++a)
#pragma unroll
            for (int b = 0; b < 2; ++b)
#pragma unroll
                for (int m = 0; m < 4; ++m)
#pragma unroll
                    for (int n = 0; n < 2; ++n) acc[a][b][m][n] = (f32x4){0.f, 0.f, 0.f, 0.f};
        cur = nxt; cA = nA; cB = nB; ++ui;
        if constexpr (ALIGN_EPI) { if (wr == 1) PG8_BAR; }
    }
    PG8_WAIT_V(0);
    if constexpr (!ALIGN_EPI) { if (wr == 0) PG8_BAR; }
    PG8_BAR;
    if constexpr (Epi::AFTER_DRAIN) { E.fused(acc, cur, wr, wc, fr, fq, lds, wid, lane); S.done(cur); }
#undef PG8_SA
#undef PG8_SB
#undef PG8_STAGE
#undef PG8_LDA
#undef PG8_LDB
#undef PG8_MMA
#undef PG8_WAIT_V
#undef PG8_WAIT_L
#undef PG8_BAR
#undef PG8_SCHED
}
}
#define LASX __attribute__((address_space(3)))
#define XB_TMO      128
#define XB_XCNT(j)  (256  + 64 * (j))
#define XB_XSUB(j)  (1280 + 64 * (j))
#define XB_XGEN(j)  (2304 + 64 * (j))
#define XB_TOP      3328
#define XB_TOPGEN   3392
#define XCD_BAR_WORDS 3456
#define XB_SPIN_CAP (1u << 18)

__device__ __forceinline__ unsigned xb_ld(unsigned* p)              { return __hip_atomic_load(p, __ATOMIC_RELAXED, __HIP_MEMORY_SCOPE_AGENT); }
__device__ __forceinline__ unsigned xb_add(unsigned* p, unsigned v) { return __hip_atomic_fetch_add(p, v, __ATOMIC_RELAXED, __HIP_MEMORY_SCOPE_AGENT); }
__device__ __forceinline__ unsigned xb_xcc_id() { return (unsigned)__builtin_amdgcn_s_getreg((3 << 11) | 20) & 0xFu; }
#define XB_SPIN(cond, bar) do { unsigned _sp = 0; while (cond) { __builtin_amdgcn_s_sleep(1); \
    if ((++_sp & 255u) == 0u) { if (xb_ld(&(bar)[XB_TMO])) break; if (_sp > XB_SPIN_CAP) { atomicAdd(&(bar)[XB_TMO], 1u); break; } } } } while (0)

struct XcdBarrier {
    unsigned* bar; unsigned x;
    volatile LASX unsigned* st;
};

__device__ __forceinline__ XcdBarrier xcd_barrier_post(unsigned* bar, volatile LASX unsigned* st) {
    XcdBarrier b; b.bar = bar; b.x = xb_xcc_id(); b.st = st;
    if (threadIdx.x == 0) (void)xb_add(&bar[XB_XCNT(b.x)], 1u);
    return b;
}
__device__ __forceinline__ void xcd_barrier_complete(unsigned* bar, unsigned x, unsigned& nloc, unsigned& nx) {
    const unsigned G = gridDim.x * gridDim.y * gridDim.z;
    unsigned sum, cnt, mine, sp = 0u;
    for (;;) {
        sum = 0u; cnt = 0u; mine = 0u;
#pragma unroll
        for (unsigned j = 0; j < 16; ++j) { const unsigned c = xb_ld(&bar[XB_XCNT(j)]); sum += c; cnt += (c > 0u) ? 1u : 0u; mine = (j == x) ? c : mine; }
        if (sum == G) break;
        __builtin_amdgcn_s_sleep(1);
        if ((++sp & 255u) == 0u) { if (xb_ld(&bar[XB_TMO])) break; if (sp > XB_SPIN_CAP) { atomicAdd(&bar[XB_TMO], 1u); break; } }
    }
    nloc = mine > 0u ? mine : 1u; nx = cnt > 0u ? cnt : 1u;
}

__device__ __forceinline__ void xcd_barrier(const XcdBarrier& b) {
    asm volatile("s_waitcnt vmcnt(0)" ::: "memory");
    __syncthreads();
    if (threadIdx.x == 0) {
        unsigned* bar = b.bar;
        __builtin_amdgcn_s_waitcnt(0);
        unsigned nloc = b.st[0], nx = b.st[1];
        if (nloc == 0u) { xcd_barrier_complete(bar, b.x, nloc, nx); b.st[0] = nloc; b.st[1] = nx; }
        const unsigned old = xb_add(&bar[XB_XSUB(b.x)], 1u);
        const unsigned gen = old / nloc;
        if (old + 1u == (gen + 1u) * nloc) {
            __builtin_amdgcn_fence(__ATOMIC_RELEASE, "agent");
            asm volatile("s_waitcnt vmcnt(0)" ::: "memory");
            const unsigned og = xb_add(&bar[XB_TOP], 1u);
            const unsigned tg = og / nx;
            if (og + 1u == (tg + 1u) * nx) xb_add(&bar[XB_TOPGEN], 1u);
            else XB_SPIN(xb_ld(&bar[XB_TOPGEN]) == tg, bar);
            __builtin_amdgcn_fence(__ATOMIC_ACQUIRE, "agent");
            xb_add(&bar[XB_XGEN(b.x)], 1u);
            asm volatile("s_waitcnt vmcnt(0)" ::: "memory");
        } else {
            XB_SPIN(xb_ld(&bar[XB_XGEN(b.x)]) == gen, bar);
            __builtin_amdgcn_fence(__ATOMIC_ACQUIRE, "agent");
            asm volatile("s_waitcnt vmcnt(0)" ::: "memory");
        }
    }
    __syncthreads();
}

#ifndef PROBE_OD
#define PROBE_OD 0
#endif
#ifndef PROBE_GC
#define PROBE_GC 0
#endif
#ifndef PROBE_AA
#define PROBE_AA 0
#endif
#ifndef XEXP
#define XEXP 0
#endif
typedef unsigned short bf16_t;
typedef short bf16x8 __attribute__((ext_vector_type(8)));
typedef float f32x4 __attribute__((ext_vector_type(4)));
typedef unsigned u32x4 __attribute__((ext_vector_type(4)));
typedef unsigned u32x2 __attribute__((ext_vector_type(2)));
#define LAS __attribute__((address_space(3)))

constexpr int NB = 2, SEQ = 8192, LC = 256, TB = SEQ + LC, MT = NB * TB, DM = 1024, NL = 4;
constexpr int IN_DIM = 5824, NPIN = 5888, FF = 2816, FF2 = 5632;
constexpr float EPS = 1e-6f, LOG2E = 1.4426950408889634f;
constexpr int NTHR = 512, NWAVES = 8;
constexpr int LDS_BYTES = 147456;
enum { I_X = 0, I_C, I_CTX, I_CCTX, I_WMOD, I_BMOD, I_NMIX, I_NFFN, I_WIN, I_SINK, I_QNORM, I_KVNORM, I_WUQ, I_WUKV, I_WGATE, I_BGATE, I_HNORM,
       I_WBRA, I_WBRB, I_WBRC, I_WOUT, I_WUP, I_CONVW, I_CONVB, I_WDOWN, I_FNORM, N_IN };

constexpr size_t O_MOD = 0;
constexpr size_t O_BAR = 384 * 1024;
constexpr size_t O_ROPEA = 512 * 1024;
constexpr size_t O_ROPEB = O_ROPEA + 2 * 1024 * 1024;
constexpr size_t O_SSQ = O_ROPEB + 1024 * 1024;
constexpr size_t O_GD = O_SSQ + 256 * 1024;
constexpr size_t O_X = O_GD + 1024 * 1024;
constexpr size_t SZ_X = (size_t)MT * DM * 4;
constexpr size_t O_WIN = O_X + SZ_X;
constexpr size_t O_WUQ = O_WIN + (size_t)NPIN * 1024 * 2;
constexpr size_t O_WUKV = O_WUQ + (size_t)768 * 256 * 2;
constexpr size_t O_WBR = O_WUKV + (size_t)1024 * 256 * 2;
constexpr size_t O_WOUT = O_WBR + (size_t)3 * 1024 * 512 * 2;
constexpr size_t O_WUP = O_WOUT + (size_t)1024 * 1024 * 2;
constexpr size_t O_WDOWN = O_WUP + (size_t)FF2 * 1024 * 2;
constexpr size_t O_HM = O_WDOWN + (size_t)1024 * FF * 2;
constexpr size_t O_MIX = O_HM + (size_t)MT * 1024 * 2;
constexpr size_t O_QA = O_MIX;
constexpr size_t O_KA = O_QA + (size_t)MT * 512 * 2;
constexpr size_t O_VAT = O_KA + (size_t)MT * 128 * 2;
constexpr size_t O_CQB = O_VAT + (size_t)2 * 2 * 64 * TB * 2;
constexpr size_t O_CKVB = O_CQB + (size_t)MT * 256 * 2;
constexpr size_t O_QB = O_CKVB + (size_t)MT * 256 * 2;
constexpr size_t O_KB = O_QB + (size_t)MT * 768 * 2;
constexpr size_t O_VBT = O_KB + (size_t)MT * 768 * 2;
constexpr size_t O_CQ = O_VBT + (size_t)2 * 8 * 64 * TB * 2;
constexpr size_t O_CK = O_CQ + (size_t)MT * 256 * 2;
constexpr size_t O_CV = O_CK + (size_t)MT * 256 * 2;
constexpr size_t O_CR = O_CV + (size_t)MT * 512 * 2;
constexpr size_t O_GLOW = O_CR + (size_t)MT * 512 * 2;
constexpr size_t O_GATES = O_GLOW + (size_t)MT * 32 * 4;
constexpr size_t O_YB = O_GATES + (size_t)MT * 3072 * 2;
constexpr size_t O_END = O_YB + (size_t)MT * 512 * 2;
constexpr size_t O_MACC = O_QB;
static_assert(O_CQ - O_QB == (size_t)MT * 1024 * 4, "MACC overlay");
constexpr size_t O_U = O_MIX;
constexpr size_t O_ACT = O_U + (size_t)MT * FF2 * 2;
static_assert(O_ACT + (size_t)MT * FF * 2 <= O_END, "U|ACT overlay");
constexpr size_t O_ST = O_HM;
static_assert((size_t)2112 * 8192 * 2 <= (size_t)MT * 1024 * 2, "ST overlay");
static_assert(O_END <= (size_t)448 * 1024 * 1024, "workspace budget");

__device__ __forceinline__ unsigned f2bf(float f) { unsigned u = __float_as_uint(f); return (u + 0x7fffu + ((u >> 16) & 1u)) >> 16; }
typedef float f32x2_t __attribute__((ext_vector_type(2))); typedef __bf16 bf16x2_t __attribute__((ext_vector_type(2)));
__device__ __forceinline__ unsigned pk2(float lo, float hi) { f32x2_t v = {lo, hi}; bf16x2_t b = __builtin_convertvector(v, bf16x2_t); return __builtin_bit_cast(unsigned, b); }
__device__ __forceinline__ float bflo(unsigned w) { return __uint_as_float(w << 16); }
__device__ __forceinline__ float bfhi(unsigned w) { return __uint_as_float(w & 0xffff0000u); }
__device__ __forceinline__ float bf2f(bf16_t h) { return __uint_as_float(((unsigned)h) << 16); }
__device__ __forceinline__ u32x4 pack8(const float* v) { u32x4 w; w.x = pk2(v[0], v[1]); w.y = pk2(v[2], v[3]); w.z = pk2(v[4], v[5]); w.w = pk2(v[6], v[7]); return w; }
__device__ __forceinline__ void unpack8(u32x4 w, float* v) { v[0] = bflo(w.x); v[1] = bfhi(w.x); v[2] = bflo(w.y); v[3] = bfhi(w.y); v[4] = bflo(w.z); v[5] = bfhi(w.z); v[6] = bflo(w.w); v[7] = bfhi(w.w); }
__device__ __forceinline__ float wave_sum(float v) {
#pragma unroll
    for (int o = 1; o < 64; o <<= 1) v += __shfl_xor(v, o);
    return v;
}
__device__ __forceinline__ float sigmoidf_(float x) { return 1.f / (1.f + __expf(-x)); }
__device__ __forceinline__ float siluf_(float x) { return x / (1.f + __expf(-x)); }

struct Args { const float* in[N_IN]; float* out; unsigned char* ws; int ph_lo, ph_hi; };

enum { MAT_IN = 0, MAT_UQ, MAT_UKV, MAT_PLAIN };
__device__ __forceinline__ int srcmap(int mat, int p) {
    if (mat == MAT_IN) {
        if (p < 640) { const int w = p & 63; return (p & ~63) + (w >> 1) + 32 * (w & 1); }
        if (p < 1152) return p;
        if (p < 1184) { const int w = p - 1152; return 1152 + (w >> 1) + 16 * (w & 1); }
        if (p < 1216) return 2720 + (p - 1184);
        if (p < 1280) return -1;
        if (p < 2816) return 1184 + (p - 1280);
        return 2752 + (p - 2816);
    }
    if (mat == MAT_UQ) { const int h = p / 96, w = p - h * 96; if (w < 64) return p; const int ww = w - 64; return h * 96 + 64 + (ww >> 1) + 16 * (ww & 1); }
    return p;
}
__device__ __forceinline__ void transpose_item(const float* __restrict__ W, int K, int N, bf16_t* WT, int KD, int item, int mat, const float* __restrict__ ks, float* scr, int lane) {
    const int nkb = KD / 64, pb = item / nkb, kb = item - pb * nkb, p0 = pb * 32, k0 = kb * 64;
    const int src = srcmap(mat, p0 + (lane & 31));
    float tv[32];
#pragma unroll
    for (int i = 0; i < 32; ++i) {
        const int k = k0 + 2 * i + (lane >> 5);
        float v = 0.f;
        if (src >= 0 && k < K) { v = W[(size_t)k * N + src]; if (ks) v *= ks[k]; }
        tv[i] = v;
    }
#pragma unroll
    for (int i = 0; i < 32; ++i) scr[(2 * i + (lane >> 5)) * 33 + (lane & 31)] = tv[i];
    __builtin_amdgcn_fence(__ATOMIC_RELEASE, "workgroup"); __builtin_amdgcn_wave_barrier();
    const int c = lane & 7;
#pragma unroll
    for (int j = 0; j < 4; ++j) {
        const int n = (lane >> 3) + 8 * j; const float* s = scr + (8 * c) * 33 + n;
        u32x4 o; o.x = pk2(s[0 * 33], s[1 * 33]); o.y = pk2(s[2 * 33], s[3 * 33]); o.z = pk2(s[4 * 33], s[5 * 33]); o.w = pk2(s[6 * 33], s[7 * 33]);
        *(u32x4*)(WT + (size_t)(p0 + n) * KD + k0 + 8 * c) = o;
    }
    __builtin_amdgcn_fence(__ATOMIC_RELEASE, "workgroup"); __builtin_amdgcn_wave_barrier();
}

#define EPI_LOOP_BEGIN \
    int fr_l = fr, fq_l = fq; asm volatile("" : "+v"(fr_l), "+v"(fq_l)); \
    _Pragma("unroll") for (int bj = 0; bj < 2; ++bj) { const int c0 = u.pn * 256 + bj * 128 + wc * 32 + 8 * fq_l; \
    _Pragma("unroll") for (int ai = 0; ai < 2; ++ai) _Pragma("unroll") for (int m = 0; m < 4; ++m) { const int t = u.pm * 256 + ai * 128 + wr * 64 + m * 16 + fr_l; \
        float v[8]; { const f32x4 a0 = acc[ai][bj][m][0], a1 = acc[ai][bj][m][1]; v[0] = a0[0]; v[1] = a0[1]; v[2] = a0[2]; v[3] = a0[3]; v[4] = a1[0]; v[5] = a1[1]; v[6] = a1[2]; v[7] = a1[3]; }
#define EPI_LOOP_END asm volatile("" ::: "memory"); } }

struct EpiIn {
    static constexpr bool PERM = true, AFTER_DRAIN = false;
    unsigned char* ws;
    __device__ __forceinline__ void operator()(const f32x4 (&acc)[2][2][4][2], const pg8::Unit& u, int wr, int wc, int fr, int fq) const {
        EPI_LOOP_BEGIN
            const int b = (t >= TB) ? 1 : 0, i = t - b * TB; const bool lat = i >= LC; const int pos = i - LC;
            if (c0 < 640) {
                if (lat) { const float* cs = (const float*)(ws + O_ROPEA) + (size_t)pos * 64 + ((c0 & 63) >> 1);
#pragma unroll
                    for (int p = 0; p < 4; ++p) { const float c = cs[p], s = cs[32 + p], a = v[2 * p], bb = v[2 * p + 1]; v[2 * p] = a * c - bb * s; v[2 * p + 1] = a * s + bb * c; } }
                if (c0 < 512) {
#pragma unroll
                    for (int e = 0; e < 8; ++e) v[e] *= 0.125f * LOG2E;
                    *(u32x4*)((bf16_t*)(ws + O_QA) + (size_t)t * 512 + c0) = pack8(v);
                } else *(u32x4*)((bf16_t*)(ws + O_KA) + (size_t)t * 128 + (c0 - 512)) = pack8(v);
            } else if (c0 < 768) {
                const int cc = c0 - 640, kvh = cc >> 6, d0 = cc & 63;
                bf16_t* dst = (bf16_t*)(ws + O_VAT) + ((size_t)(b * 2 + kvh) * 64 + d0) * TB + i;
#pragma unroll
                for (int e = 0; e < 8; ++e) dst[(size_t)e * TB] = (bf16_t)f2bf(v[e]);
            } else if (c0 < 1152) {
                float s = 0.f;
#pragma unroll
                for (int e = 0; e < 8; ++e) s += v[e] * v[e];
                s += __shfl_xor(s, 16); s += __shfl_xor(s, 32);
                if (c0 < 1024) { *(u32x4*)((bf16_t*)(ws + O_CQB) + (size_t)t * 256 + (c0 - 768)) = pack8(v); if (fq_l == 0) unsafeAtomicAdd((float*)(ws + O_SSQ) + t * 2, s); }
                else { bf16_t* d = (bf16_t*)(ws + O_CKVB) + (size_t)t * 256 + (c0 - 1024); *(u32x4*)d = pack8(v); *(u32x4*)(d + 128) = (u32x4){0u, 0u, 0u, 0u}; if (fq_l == 0) unsafeAtomicAdd((float*)(ws + O_SSQ) + t * 2 + 1, s); }
            } else if (c0 < 1184) {
                if (lat) { const float* cs = (const float*)(ws + O_ROPEB) + (size_t)pos * 32 + ((c0 - 1152) >> 1);
#pragma unroll
                    for (int p = 0; p < 4; ++p) { const float c = cs[p], s = cs[16 + p], a = v[2 * p], bb = v[2 * p + 1]; v[2 * p] = a * c - bb * s; v[2 * p + 1] = a * s + bb * c; } }
                const u32x4 w = pack8(v); bf16_t* d = (bf16_t*)(ws + O_KB) + (size_t)t * 768 + 64 + (c0 - 1152);
#pragma unroll
                for (int h = 0; h < 8; ++h) *(u32x4*)(d + h * 96) = w;
            } else if (c0 < 1216) {
                float* d = (float*)(ws + O_GLOW) + (size_t)t * 32 + (c0 - 1184);
                *(f32x4*)d = (f32x4){v[0], v[1], v[2], v[3]}; *(f32x4*)(d + 4) = (f32x4){v[4], v[5], v[6], v[7]};
            } else if (c0 < 1280) {
            } else if (c0 < 1536) {
#pragma unroll
                for (int e = 0; e < 8; ++e) v[e] *= 0.125f;
                *(u32x4*)((bf16_t*)(ws + O_CQ) + (size_t)t * 256 + (c0 - 1280)) = pack8(v);
            } else if (c0 < 1792) { *(u32x4*)((bf16_t*)(ws + O_CK) + (size_t)t * 256 + (c0 - 1536)) = pack8(v);
            } else if (c0 < 2304) { *(u32x4*)((bf16_t*)(ws + O_CV) + (size_t)t * 512 + (c0 - 1792)) = pack8(v);
            } else if (c0 < 2816) { *(u32x4*)((bf16_t*)(ws + O_CR) + (size_t)t * 512 + (c0 - 2304)) = pack8(v);
            } else {
#pragma unroll
                for (int e = 0; e < 8; ++e) v[e] = sigmoidf_(v[e]);
                *(u32x4*)((bf16_t*)(ws + O_GATES) + (size_t)t * 3072 + (c0 - 2816)) = pack8(v);
            }
        EPI_LOOP_END
    }
};

struct EpiUq {
    static constexpr bool PERM = true, AFTER_DRAIN = false;
    unsigned char* ws;
    __device__ __forceinline__ void operator()(const f32x4 (&acc)[2][2][4][2], const pg8::Unit& u, int wr, int wc, int fr, int fq) const {
        EPI_LOOP_BEGIN
            const int b = (t >= TB) ? 1 : 0, i = t - b * TB; const bool lat = i >= LC; const int pos = i - LC;
            const float rstd = rsqrtf(((const float*)(ws + O_SSQ))[t * 2] * (1.f / 256.f) + EPS) * (0.10206207261596575f * LOG2E);
#pragma unroll
            for (int e = 0; e < 8; ++e) v[e] *= rstd;
            const int h = c0 / 96, w = c0 - h * 96;
            if (w >= 64 && lat) { const float* cs = (const float*)(ws + O_ROPEB) + (size_t)pos * 32 + ((w - 64) >> 1);
#pragma unroll
                for (int p = 0; p < 4; ++p) { const float c = cs[p], s = cs[16 + p], a = v[2 * p], bb = v[2 * p + 1]; v[2 * p] = a * c - bb * s; v[2 * p + 1] = a * s + bb * c; } }
            *(u32x4*)((bf16_t*)(ws + O_QB) + (size_t)t * 768 + c0) = pack8(v);
        EPI_LOOP_END
    }
};
struct EpiUkv {
    static constexpr bool PERM = true, AFTER_DRAIN = false;
    unsigned char* ws;
    __device__ __forceinline__ void operator()(const f32x4 (&acc)[2][2][4][2], const pg8::Unit& u, int wr, int wc, int fr, int fq) const {
        EPI_LOOP_BEGIN
            const int b = (t >= TB) ? 1 : 0, i = t - b * TB;
            const float rstd = rsqrtf(((const float*)(ws + O_SSQ))[t * 2 + 1] * (1.f / 128.f) + EPS);
#pragma unroll
            for (int e = 0; e < 8; ++e) v[e] *= rstd;
            const int h = c0 >> 7, w = c0 & 127;
            if (w < 64) *(u32x4*)((bf16_t*)(ws + O_KB) + (size_t)t * 768 + h * 96 + w) = pack8(v);
            else { bf16_t* dst = (bf16_t*)(ws + O_VBT) + ((size_t)(b * 8 + h) * 64 + (w - 64)) * TB + i;
#pragma unroll
                for (int e = 0; e < 8; ++e) dst[(size_t)e * TB] = (bf16_t)f2bf(v[e]); }
        EPI_LOOP_END
    }
};
template <int PASS> struct EpiMerge {
    static constexpr bool PERM = true, AFTER_DRAIN = false;
    unsigned char* ws;
    __device__ __forceinline__ void operator()(const f32x4 (&acc)[2][2][4][2], const pg8::Unit& u, int wr, int wc, int fr, int fq) const {
        EPI_LOOP_BEGIN
            float g[8]; unpack8(*(const u32x4*)((const bf16_t*)(ws + O_GATES) + (size_t)t * 3072 + PASS * 1024 + c0), g);
            bf16_t* mp = (bf16_t*)(ws + O_HM) + (size_t)t * 1024 + c0;
            if (PASS > 0) { float pv[8]; unpack8(*(const u32x4*)mp, pv);
#pragma unroll
                for (int e = 0; e < 8; ++e) v[e] = pv[e] + g[e] * v[e];
            } else {
#pragma unroll
                for (int e = 0; e < 8; ++e) v[e] *= g[e];
            }
            *(u32x4*)mp = pack8(v);
        EPI_LOOP_END
    }
};
template <int PASS> struct EpiMergePart {
    static constexpr bool PERM = true, AFTER_DRAIN = false;
    unsigned char* ws; int kbstep;
    __device__ __forceinline__ void operator()(const f32x4 (&acc)[2][2][4][2], const pg8::Unit& u, int wr, int wc, int fr, int fq) const {
        const int ks = u.kb / kbstep;
        EPI_LOOP_BEGIN
            float g[8]; unpack8(*(const u32x4*)((const bf16_t*)(ws + O_GATES) + (size_t)t * 3072 + PASS * 1024 + c0), g);
            const int cr = (t >= TB) ? (t - TB + 256) : t;
            float* pp = (float*)(ws + O_CQ) + ((size_t)((PASS * 2 + ks) * 512 + cr)) * 1024 + c0;
            *(f32x4*)pp = (f32x4){g[0] * v[0], g[1] * v[1], g[2] * v[2], g[3] * v[3]}; *(f32x4*)(pp + 4) = (f32x4){g[4] * v[4], g[5] * v[5], g[6] * v[6], g[7] * v[7]};
        EPI_LOOP_END
    }
};
struct EpiResid {
    static constexpr bool PERM = true, AFTER_DRAIN = false;
    unsigned char* ws; const float* modl; int goff;
    __device__ __forceinline__ void operator()(const f32x4 (&acc)[2][2][4][2], const pg8::Unit& u, int wr, int wc, int fr, int fq) const {
        EPI_LOOP_BEGIN
            const int b = (t >= TB) ? 1 : 0, i = t - b * TB; const int r = (i >= LC) ? b : 2;
            const float* gp = modl + r * 6144 + goff + c0;
            const f32x4 g0 = *(const f32x4*)gp, g1 = *(const f32x4*)(gp + 4);
            float* xp = (float*)(ws + O_X) + (size_t)t * 1024 + c0;
            f32x4 x0 = *(const f32x4*)xp, x1 = *(const f32x4*)(xp + 4);
            x0[0] += g0[0] * v[0]; x0[1] += g0[1] * v[1]; x0[2] += g0[2] * v[2]; x0[3] += g0[3] * v[3];
            x1[0] += g1[0] * v[4]; x1[1] += g1[1] * v[5]; x1[2] += g1[2] * v[6]; x1[3] += g1[3] * v[7];
            *(f32x4*)xp = x0; *(f32x4*)(xp + 4) = x1;
        EPI_LOOP_END
    }
};
struct EpiPartial {
    static constexpr bool PERM = true, AFTER_DRAIN = false;
    float* P; int kbstep;
    __device__ __forceinline__ void operator()(const f32x4 (&acc)[2][2][4][2], const pg8::Unit& u, int wr, int wc, int fr, int fq) const {
        const int ks = u.kb / kbstep;
        EPI_LOOP_BEGIN
            const int cr = (t >= TB) ? (t - TB + 256) : t;
            float* pp = P + ((size_t)(ks * 512 + cr)) * 1024 + c0;
            *(f32x4*)pp = (f32x4){v[0], v[1], v[2], v[3]}; *(f32x4*)(pp + 4) = (f32x4){v[4], v[5], v[6], v[7]};
        EPI_LOOP_END
    }
};
struct EpiNull {
    static constexpr bool PERM = true, AFTER_DRAIN = false;
    float* sink;
    __device__ __forceinline__ void operator()(const f32x4 (&acc)[2][2][4][2], const pg8::Unit& u, int wr, int wc, int fr, int fq) const {
        float sacc = 0.f;
        EPI_LOOP_BEGIN
            sacc += v[0] + v[1] + v[2] + v[3] + v[4] + v[5] + v[6] + v[7] + (float)(t + c0) * 1e-30f;
        EPI_LOOP_END
        if (sacc == 1.2345e30f) sink[threadIdx.x] = sacc;
    }
};
struct EpiStore {
    static constexpr bool PERM = true, AFTER_DRAIN = false;
    bf16_t* O; int ldc;
    __device__ __forceinline__ void operator()(const f32x4 (&acc)[2][2][4][2], const pg8::Unit& u, int wr, int wc, int fr, int fq) const {
        EPI_LOOP_BEGIN
            *(u32x4*)(O + (size_t)t * ldc + c0) = pack8(v);
        EPI_LOOP_END
    }
};

template <class Epi> __device__ __forceinline__ void run_gemm(unsigned char* lds, const bf16_t* A, const bf16_t* Bt, int M, int N, int K, const Epi& E) {
    asm volatile("" : "+s"(K), "+s"(M), "+s"(N));
    int gd_ = (int)gridDim.x, bi_ = (int)blockIdx.x; asm volatile("" : "+s"(gd_), "+s"(bi_));
    pg8::Gemm g{A, Bt, M, N, K, K}; pg8::StaticOrder S; S.init(M, N, gd_, bi_);
    pg8::gemm_phase<Epi, pg8::StaticOrder, true, true>((PG8_LAS unsigned char*)lds, g, S, E);
}

struct MainOrder {
    pg8::StaticOrder S;
    __device__ void init(int N, int G_, int c_) { S.init(64 * 256, N, G_, c_); }
    __device__ bool next(int i, pg8::Unit& u) const { if (!S.next(i, u)) return false; u.pm = (u.pm < 32) ? u.pm + 1 : u.pm + 2; return true; }
    __device__ __forceinline__ void a_ready(const pg8::Unit&) const {}
    __device__ __forceinline__ void done(const pg8::Unit&) const {}
};
struct CtxSplitOrder {
    int nN, nsplit, kloop, G, c;
    __device__ bool next(int i, pg8::Unit& u) const {
        const int L = i * G + c; if (L >= 2 * nN * nsplit) return false;
        const int ks = L % nsplit, r = L / nsplit; u.pn = r % nN; u.pm = (r / nN) ? 33 : 0; u.kb = ks * kloop * 2; return true;
    }
    __device__ __forceinline__ void a_ready(const pg8::Unit&) const {}
    __device__ __forceinline__ void done(const pg8::Unit&) const {}
};
template <class Epi> __device__ __forceinline__ void run_gemm_main(unsigned char* lds, const bf16_t* A, const bf16_t* Bt, int N, int K, const Epi& E) {
    asm volatile("" : "+s"(K), "+s"(N));
    int gd_ = (int)gridDim.x, bi_ = (int)blockIdx.x; asm volatile("" : "+s"(gd_), "+s"(bi_));
    pg8::Gemm g{A, Bt, MT, N, K, K}; MainOrder S; S.init(N, gd_, bi_);
    pg8::gemm_phase<Epi, MainOrder, true, true>((PG8_LAS unsigned char*)lds, g, S, E);
}
template <class Epi> __device__ __forceinline__ void run_gemm_ctx(unsigned char* lds, const bf16_t* A, const bf16_t* Bt, int N, int K, int nsplit, const Epi& E, int rot = 0) {
    asm volatile("" : "+s"(K), "+s"(N), "+s"(nsplit));
    int gd_ = (int)gridDim.x, bi_ = (int)blockIdx.x; asm volatile("" : "+s"(gd_), "+s"(bi_));
    bi_ = (bi_ + gd_ - (rot % gd_)) % gd_;
    const int kloop = K / nsplit;
    pg8::Gemm g{A, Bt, MT, N, K, kloop}; CtxSplitOrder S{N / 256, nsplit, kloop, gd_, bi_};
    pg8::gemm_phase<Epi, CtxSplitOrder, true, true>((PG8_LAS unsigned char*)lds, g, S, E);
}

struct NormRow { f32x4 v[4]; float s; };
struct NormPar { const float* src; float* cp; const float* part; const float* gv; const float* sc; const float* sh; bf16_t* orow; int nsl; };
__device__ __forceinline__ void norm_load(NormRow& R, const NormPar& P, int lane) {
    const f32x4* xr = (const f32x4*)P.src + lane; R.s = 0.f;
#pragma unroll
    for (int j = 0; j < 4; ++j) { R.v[j] = xr[64 * j];
        if (P.part) { f32x4 a = (f32x4){0.f, 0.f, 0.f, 0.f};
            for (int q = 0; q < P.nsl; ++q) a = a + ((const f32x4*)(P.part + (size_t)q * 512 * 1024))[64 * j + lane];
            R.v[j] = R.v[j] + ((const f32x4*)P.gv)[64 * j + lane] * a; }
        R.s += (R.v[j][0] * R.v[j][0] + R.v[j][1] * R.v[j][1]) + (R.v[j][2] * R.v[j][2] + R.v[j][3] * R.v[j][3]); }
}
__device__ __forceinline__ void norm_finish(const NormRow& R, const NormPar& P, const float* nw, int lane) {
    if (P.cp) {
#pragma unroll
        for (int j = 0; j < 4; ++j) ((f32x4*)P.cp)[64 * j + lane] = R.v[j];
    }
    const float rstd = rsqrtf(wave_sum(R.s) * (1.f / 1024.f) + EPS);
#pragma unroll
    for (int j = 0; j < 4; ++j) {
        const int idx = 64 * j + lane;
        const f32x4 w = ((const f32x4*)nw)[idx], a = ((const f32x4*)P.sc)[idx], bsh = ((const f32x4*)P.sh)[idx];
        const float y0 = R.v[j][0] * rstd * w[0] * (1.f + a[0]) + bsh[0], y1 = R.v[j][1] * rstd * w[1] * (1.f + a[1]) + bsh[1];
        const float y2 = R.v[j][2] * rstd * w[2] * (1.f + a[2]) + bsh[2], y3 = R.v[j][3] * rstd * w[3] * (1.f + a[3]) + bsh[3];
        u32x2 o; o.x = pk2(y0, y1); o.y = pk2(y2, y3);
        ((u32x2*)P.orow)[idx] = o;
    }
}

#define ATT_THR 4.0f
template <int DQK, bool MASK, int NQ>
__device__ __forceinline__ void attn_unit(unsigned char* lds, const bf16_t* Qg, int ldq, const bf16_t* Kg, int ldk, const bf16_t* Vtg, bf16_t* Og, int ldo,
                                          int qi0, int a0, int n1, int b0, int n2, float m0, bool sink) {
    constexpr int KP = DQK + 8, KBYTES = 64 * KP * 2, VP = 72, VBYTES = 64 * VP * 2, NC = DQK / 32, KCH = DQK / 8, WR = 16 * NQ;
    constexpr int KOFF = 0, VOFF = 2 * KBYTES;
    int tid_ = threadIdx.x; asm volatile("" : "+v"(tid_));
    const int tid = tid_, lane = tid & 63, wid = tid >> 6, ql = lane & 15, g = lane >> 4;
    const int qw0 = qi0 + wid * WR;
    bf16x8 qf[NQ][NC];
#pragma unroll
    for (int qb = 0; qb < NQ; ++qb)
#pragma unroll
        for (int c = 0; c < NC; ++c) qf[qb][c] = *(const bf16x8*)(Qg + (size_t)(qw0 + qb * 16 + ql) * ldq + c * 32 + g * 8);
    f32x4 o[4][NQ];
#pragma unroll
    for (int eb = 0; eb < 4; ++eb)
#pragma unroll
        for (int qb = 0; qb < NQ; ++qb) o[eb][qb] = (f32x4){0.f, 0.f, 0.f, 0.f};
    float mrow[NQ]; f32x4 negm[NQ], ol[NQ];
#pragma unroll
    for (int qb = 0; qb < NQ; ++qb) { mrow[qb] = sink ? m0 : 0.f; const float l0 = sink ? 1.f : 0.f; ol[qb] = (f32x4){l0, l0, l0, l0}; negm[qb] = (f32x4){-mrow[qb], -mrow[qb], -mrow[qb], -mrow[qb]}; }
    const bf16x8 ones = (bf16x8){0x3F80, 0x3F80, 0x3F80, 0x3F80, 0x3F80, 0x3F80, 0x3F80, 0x3F80};
    bool first = !sink;
    int nt = n1 + n2; asm volatile("" : "+s"(nt));
    const int kr0 = tid / KCH, kc0 = tid - kr0 * KCH;
    const int ci1 = tid + 512, kr1 = ci1 / KCH, kc1 = ci1 - kr1 * KCH;
    const bool has1 = (KCH * 64 > 512) && (ci1 < KCH * 64);
    const int ve = tid >> 3, vc = tid & 7;
    u32x4 kreg0, kreg1 = (u32x4){0u, 0u, 0u, 0u}, vreg;
#define ATT_TILE(tt) (((tt) < n1) ? (a0 + (tt)) : (b0 + (tt) - n1))
#define ATT_SKIP(kt) (MASK && ((kt) >= 4) && (((kt) * 64 > qw0 + (WR - 1) + 128) || ((kt) * 64 + 63 < qw0 - 128)))
#define ATT_ISSUE(kt) do { kreg0 = *(const u32x4*)(Kg + (size_t)((kt) * 64 + kr0) * ldk + kc0 * 8); \
        if (has1) kreg1 = *(const u32x4*)(Kg + (size_t)((kt) * 64 + kr1) * ldk + kc1 * 8); \
        vreg = *(const u32x4*)(Vtg + (size_t)ve * TB + (kt) * 64 + vc * 8); } while (0)
#define ATT_COMMIT(buf) do { unsigned char* kb_ = lds + KOFF + (buf) * KBYTES; *(u32x4*)(kb_ + kr0 * (KP * 2) + kc0 * 16) = kreg0; \
        if (has1) *(u32x4*)(kb_ + kr1 * (KP * 2) + kc1 * 16) = kreg1; \
        *(u32x4*)(lds + VOFF + (buf) * VBYTES + ve * (VP * 2) + vc * 16) = vreg; } while (0)
    { const int kt0 = ATT_TILE(0); ATT_ISSUE(kt0); ATT_COMMIT(0); }
    __syncthreads();
#pragma unroll 1
    for (int tt = 0; tt < nt; ++tt) {
        const int kt = ATT_TILE(tt);
        if (tt + 1 < nt) { const int ktn = ATT_TILE(tt + 1); ATT_ISSUE(ktn); }
        if (!ATT_SKIP(kt)) {
#pragma unroll 1
          for (int hb = 0; hb < 2; ++hb) {
            f32x4 sc[2][NQ];
            { const unsigned char* kb_ = lds + KOFF + (tt & 1) * KBYTES + hb * (32 * KP * 2);
              __builtin_amdgcn_s_setprio(1);
#pragma unroll
              for (int k2 = 0; k2 < 2; ++k2) {
#pragma unroll
                  for (int c = 0; c < NC; ++c) {
                      const bf16x8 kf = *(const bf16x8*)(kb_ + (k2 * 16 + ql) * (KP * 2) + (c * 32 + g * 8) * 2);
#pragma unroll
                      for (int qb = 0; qb < NQ; ++qb) sc[k2][qb] = __builtin_amdgcn_mfma_f32_16x16x32_bf16(kf, qf[qb][c], c == 0 ? negm[qb] : sc[k2][qb], 0, 0, 0);
                  } }
              __builtin_amdgcn_s_setprio(0); }
            if (MASK) { if (kt >= 4) { int dl = kt * 64 + hb * 32 + g * 4 - qw0 - ql; asm volatile("" : "+v"(dl));
#pragma unroll
                for (int k2 = 0; k2 < 2; ++k2)
#pragma unroll
                    for (int qb = 0; qb < NQ; ++qb)
#pragma unroll
                        for (int j = 0; j < 4; ++j) { const int d = dl + (k2 * 16 + j - qb * 16); if (d > 128 || d < -128) sc[k2][qb][j] = -1e30f; } } }
            float am = fmaxf(fmaxf(sc[0][0][0], sc[0][0][1]), sc[0][0][2]); am = fmaxf(fmaxf(am, sc[0][0][3]), sc[1][0][0]); am = fmaxf(fmaxf(am, sc[1][0][1]), sc[1][0][2]); am = fmaxf(am, sc[1][0][3]);
#pragma unroll
            for (int qb = 1; qb < NQ; ++qb) { am = fmaxf(fmaxf(am, sc[0][qb][0]), sc[0][qb][1]); am = fmaxf(fmaxf(am, sc[0][qb][2]), sc[0][qb][3]);
                am = fmaxf(fmaxf(am, sc[1][qb][0]), sc[1][qb][1]); am = fmaxf(fmaxf(am, sc[1][qb][2]), sc[1][qb][3]); }
            if (__any(first || (am > ATT_THR))) {
#pragma unroll
                for (int qb = 0; qb < NQ; ++qb) {
                    float a = fmaxf(fmaxf(sc[0][qb][0], sc[0][qb][1]), sc[0][qb][2]);
                    a = fmaxf(fmaxf(a, sc[0][qb][3]), sc[1][qb][0]); a = fmaxf(fmaxf(a, sc[1][qb][1]), sc[1][qb][2]); a = fmaxf(a, sc[1][qb][3]);
                    { auto r16 = __builtin_amdgcn_permlane16_swap(__float_as_uint(a), __float_as_uint(a), false, false); a = fmaxf(__uint_as_float(r16[0]), __uint_as_float(r16[1])); }
                    { auto r32 = __builtin_amdgcn_permlane32_swap(__float_as_uint(a), __float_as_uint(a), false, false); a = fmaxf(__uint_as_float(r32[0]), __uint_as_float(r32[1])); }
                    const float dlt = first ? a : fmaxf(a, 0.f);
                    mrow[qb] += dlt; negm[qb] = (f32x4){-mrow[qb], -mrow[qb], -mrow[qb], -mrow[qb]};
                    sc[0][qb] = sc[0][qb] - dlt; sc[1][qb] = sc[1][qb] - dlt;
                    if (!first) { const float alpha = __builtin_amdgcn_exp2f(-dlt); ol[qb] = ol[qb] * alpha;
#pragma unroll
                        for (int eb = 0; eb < 4; ++eb) o[eb][qb] = o[eb][qb] * alpha; } }
                first = false; }
            bf16x8 pf[NQ];
#pragma unroll
            for (int qb = 0; qb < NQ; ++qb) {
#pragma unroll
                for (int k2 = 0; k2 < 2; ++k2)
#pragma unroll
                    for (int j = 0; j < 4; ++j) sc[k2][qb][j] = __builtin_amdgcn_exp2f(sc[k2][qb][j]);
                u32x4 w; w.x = pk2(sc[0][qb][0], sc[0][qb][1]); w.y = pk2(sc[0][qb][2], sc[0][qb][3]); w.z = pk2(sc[1][qb][0], sc[1][qb][1]); w.w = pk2(sc[1][qb][2], sc[1][qb][3]);
                pf[qb] = __builtin_bit_cast(bf16x8, w); }
            { const unsigned char* vb_ = lds + VOFF + (tt & 1) * VBYTES + hb * 64;
#pragma unroll
              for (int eb = 0; eb < 4; ++eb) {
                  const unsigned char* vp = vb_ + (eb * 16 + ql) * (VP * 2) + (g * 4) * 2;
                  const u32x2 lo = *(const u32x2*)vp, hi = *(const u32x2*)(vp + 32); const u32x4 w = (u32x4){lo.x, lo.y, hi.x, hi.y};
                  const bf16x8 vf = __builtin_bit_cast(bf16x8, w);
#pragma unroll
                  for (int qb = 0; qb < NQ; ++qb) o[eb][qb] = __builtin_amdgcn_mfma_f32_16x16x32_bf16(vf, pf[qb], o[eb][qb], 0, 0, 0);
              }
#pragma unroll
              for (int qb = 0; qb < NQ; ++qb) ol[qb] = __builtin_amdgcn_mfma_f32_16x16x32_bf16(ones, pf[qb], ol[qb], 0, 0, 0); }
          }
        }
        if (tt + 1 < nt) ATT_COMMIT((tt + 1) & 1);
        __syncthreads();
    }
#undef ATT_TILE
#undef ATT_SKIP
#undef ATT_ISSUE
#undef ATT_COMMIT
#pragma unroll
    for (int qb = 0; qb < NQ; ++qb) {
        const float inv = 1.f / ol[qb][0];
        bf16_t* op = Og + (size_t)(qw0 + qb * 16 + ql) * ldo + g * 4;
        if (Og)
#pragma unroll
        for (int eb = 0; eb < 4; ++eb) { u32x2 w; w.x = pk2(o[eb][qb][0] * inv, o[eb][qb][1] * inv); w.y = pk2(o[eb][qb][2] * inv, o[eb][qb][3] * inv); *(u32x2*)(op + eb * 16) = w; }
    }
}

constexpr int GL_BS = 0;
constexpr int GL_TOT = GL_BS + 64 * 65 * 4;
constexpr int GL_QE = GL_TOT + 8 * 64 * 4;
constexpr int GL_KE = GL_QE + 64 * 72 * 2;
constexpr int GL_ATT = GL_KE + 64 * 72 * 2;
constexpr int GL_VT = GL_ATT + 64 * 72 * 2;
constexpr int GL_O = GL_VT + 128 * 72 * 2;
constexpr int GL_END = GL_O + 64 * 132 * 4;
static_assert(GL_END <= 131072 && (GL_QE % 16) == 0 && (GL_VT % 16) == 0 && (GL_O % 16) == 0, "GLA LDS map");

__device__ __forceinline__ void gla_decay(unsigned char* lds, const float* glow_t0, const float* Wg  , const float* bg  , int dir) {
    float* Bs = (float*)(lds + GL_BS); float* Tot = (float*)(lds + GL_TOT); float* GLs = (float*)(lds + GL_O);
    int tid_ = threadIdx.x; asm volatile("" : "+v"(tid_)); const int tid = tid_;
    { const int s = tid >> 3, q = tid & 7;
      const float* gp = glow_t0 + (size_t)s * 32 + dir * 16 + q * 2;
      GLs[s * 16 + q * 2] = gp[0]; GLs[s * 16 + q * 2 + 1] = gp[1]; }
    const int d = tid & 63, seg = tid >> 6;
    float w[16];
#pragma unroll
    for (int r = 0; r < 16; ++r) w[r] = Wg[r * 256 + d];
    const float bias = bg[d];
    __syncthreads();
    float loc[8];
#pragma unroll
    for (int k = 0; k < 8; ++k) { const float* gl = GLs + (seg * 8 + k) * 16; float a = bias;
#pragma unroll
        for (int r = 0; r < 16; ++r) a += gl[r] * w[r];
        loc[k] = (fminf(a, 0.f) - __logf(1.f + __expf(-fabsf(a)))) * (1.f / 16.f); }
    float run = 0.f;
    if (dir == 0) {
#pragma unroll
        for (int k = 0; k < 8; ++k) { run += loc[k]; loc[k] = run; }
    } else {
#pragma unroll
        for (int k = 7; k >= 0; --k) { run += loc[k]; loc[k] = run; }
    }
    Tot[seg * 64 + d] = run;
    __syncthreads();
    float off = 0.f;
#pragma unroll
    for (int sg = 0; sg < 8; ++sg) { const float tv = Tot[sg * 64 + d]; if (dir == 0 ? (sg < seg) : (sg > seg)) off += tv; }
#pragma unroll
    for (int k = 0; k < 8; ++k) Bs[(seg * 8 + k) * 65 + d] = loc[k] + off;
    __syncthreads();
}
__device__ __forceinline__ void gla_load_vt(unsigned char* lds, const bf16_t* cv_t0  ) {
    bf16_t* Vt = (bf16_t*)(lds + GL_VT);
    int tid_ = threadIdx.x; asm volatile("" : "+v"(tid_)); const int tid = tid_;
#pragma unroll
    for (int r = 0; r < 2; ++r) { const int ci = tid + 512 * r, s = ci & 63, eg = ci >> 6;
        const u32x4 w = *(const u32x4*)(cv_t0 + (size_t)s * 512 + eg * 8);
        bf16_t* dst = Vt + (eg * 8) * 72 + s;
        dst[0 * 72] = (bf16_t)(w.x & 0xffffu); dst[1 * 72] = (bf16_t)(w.x >> 16); dst[2 * 72] = (bf16_t)(w.y & 0xffffu); dst[3 * 72] = (bf16_t)(w.y >> 16);
        dst[4 * 72] = (bf16_t)(w.z & 0xffffu); dst[5 * 72] = (bf16_t)(w.z >> 16); dst[6 * 72] = (bf16_t)(w.w & 0xffffu); dst[7 * 72] = (bf16_t)(w.w >> 16); }
}
__device__ __forceinline__ int gla_ord(int dir, int k) { return dir == 0 ? k : (k < 4 ? 3 - k : 135 - k); }

__device__ __forceinline__ void gla_state_item(unsigned char* lds, unsigned char* ws, const float* wgate, const float* bgate, int l, int item) {
    const int c = item % 132, dir = (item / 132) & 1, h = (item / 264) & 3, b = item / 1056;
    const int t0 = b * TB + c * 64;
    int tid_ = threadIdx.x; asm volatile("" : "+v"(tid_));
    const int tid = tid_, lane = tid & 63, wid = tid >> 6, ql = lane & 15, g = lane >> 4;
    const u32x4 kraw = *(const u32x4*)((const bf16_t*)(ws + O_CK) + (size_t)(t0 + (tid & 63)) * 256 + h * 64 + (tid >> 6) * 8);
    gla_load_vt(lds, (const bf16_t*)(ws + O_CV) + (size_t)t0 * 512 + h * 128);
    gla_decay(lds, (const float*)(ws + O_GLOW) + (size_t)t0 * 32, wgate + (size_t)((l * 2 + dir) * 16) * 256 + h * 64, bgate + (l * 2 + dir) * 256 + h * 64, dir);
    const float* Bs = (const float*)(lds + GL_BS); bf16_t* KDt = (bf16_t*)(lds + GL_KE);
    const int iend = dir == 0 ? 63 : 0;
    { const int s = tid & 63, dg = tid >> 6;
      float kv[8]; unpack8(kraw, kv);
#pragma unroll
      for (int e = 0; e < 8; ++e) { const int d = dg * 8 + e; KDt[d * 72 + s] = (bf16_t)f2bf(kv[e] * __expf(Bs[iend * 65 + d] - Bs[s * 65 + d])); } }
    if (tid < 64) ((float*)(ws + O_GD))[(size_t)item * 64 + tid] = __expf(Bs[iend * 65 + tid]);
    __syncthreads();
    const bf16_t* Vt = (const bf16_t*)(lds + GL_VT);
    f32x4 acc[4];
#pragma unroll
    for (int cb = 0; cb < 4; ++cb) acc[cb] = (f32x4){0.f, 0.f, 0.f, 0.f};
#pragma unroll
    for (int kk = 0; kk < 2; ++kk) {
        const bf16x8 a = *(const bf16x8*)(Vt + (wid * 16 + ql) * 72 + kk * 32 + g * 8);
#pragma unroll
        for (int cb = 0; cb < 4; ++cb) { const bf16x8 bb = *(const bf16x8*)(KDt + (cb * 16 + ql) * 72 + kk * 32 + g * 8); acc[cb] = __builtin_amdgcn_mfma_f32_16x16x32_bf16(a, bb, acc[cb], 0, 0, 0); }
    }
    bf16_t* st = (bf16_t*)(ws + O_ST) + (size_t)item * 8192;
#pragma unroll
    for (int cb = 0; cb < 4; ++cb)
#pragma unroll
        for (int j = 0; j < 4; ++j) st[(wid * 16 + g * 4 + j) * 64 + cb * 16 + ql] = (bf16_t)f2bf(acc[cb][j]);
    __syncthreads();
}

__device__ __forceinline__ void gla_scan(unsigned char* ws, int bid, int tid, int G) {
    bf16_t* ST = (bf16_t*)(ws + O_ST); const float* GD = (const float*)(ws + O_GD);
    for (int gidx = bid * NTHR + tid; gidx < 16 * 8192; gidx += G * NTHR) {
        const int seq = gidx >> 13, idx = gidx & 8191, d = idx & 63, dir = seq & 1;
        float s = 0.f;
        for (int k0 = 0; k0 < 132; k0 += 33) {
            float uv[33], dv[33];
#pragma unroll
            for (int u = 0; u < 33; ++u) { const int c = gla_ord(dir, k0 + u); uv[u] = bf2f(ST[(size_t)(seq * 132 + c) * 8192 + idx]); dv[u] = GD[(size_t)(seq * 132 + c) * 64 + d]; }
#pragma unroll
            for (int u = 0; u < 33; ++u) { const int c = gla_ord(dir, k0 + u); ST[(size_t)(seq * 132 + c) * 8192 + idx] = (bf16_t)f2bf(s); s = dv[u] * s + uv[u]; }
        }
    }
}

__device__ __forceinline__ void gla_out_item(unsigned char* lds, unsigned char* ws, const float* wgate, const float* bgate, const float* hnorm, int l, int item, bool dowrite = true) {
    const int c = item % 132, h = (item / 132) & 3, b = item / 528;
    const int t0 = b * TB + c * 64;
    int tid_ = threadIdx.x; asm volatile("" : "+v"(tid_));
    const int tid = tid_, lane = tid & 63, wid = tid >> 6, ql = lane & 15, g = lane >> 4;
    const float* Bs = (const float*)(lds + GL_BS);
    bf16_t* QE = (bf16_t*)(lds + GL_QE); bf16_t* KE = (bf16_t*)(lds + GL_KE); bf16_t* ATT = (bf16_t*)(lds + GL_ATT); const bf16_t* Vt = (const bf16_t*)(lds + GL_VT);
    const u32x4 qraw = *(const u32x4*)((const bf16_t*)(ws + O_CQ) + (size_t)(t0 + (tid >> 3)) * 256 + h * 64 + (tid & 7) * 8);
    const u32x4 kraw = *(const u32x4*)((const bf16_t*)(ws + O_CK) + (size_t)(t0 + (tid >> 3)) * 256 + h * 64 + (tid & 7) * 8);
    bf16x8 sfr[2][2];
#pragma unroll
    for (int dd = 0; dd < 2; ++dd)
#pragma unroll
        for (int kk = 0; kk < 2; ++kk) sfr[dd][kk] = *(const bf16x8*)((const bf16_t*)(ws + O_ST) + (size_t)(((b * 4 + h) * 2 + dd) * 132 + c) * 8192 + (wid * 16 + ql) * 64 + kk * 32 + g * 8);
    const u32x4 rraw0 = *(const u32x4*)((const bf16_t*)(ws + O_CR) + (size_t)(t0 + (tid >> 3)) * 512 + h * 128 + (tid & 7) * 16);
    const u32x4 rraw1 = *(const u32x4*)((const bf16_t*)(ws + O_CR) + (size_t)(t0 + (tid >> 3)) * 512 + h * 128 + (tid & 7) * 16 + 8);
    gla_load_vt(lds, (const bf16_t*)(ws + O_CV) + (size_t)t0 * 512 + h * 128);
    f32x4 oacc[4];
#pragma unroll
    for (int rb = 0; rb < 4; ++rb) oacc[rb] = (f32x4){0.f, 0.f, 0.f, 0.f};
    for (int dir = 0; dir < 2; ++dir) {
        gla_decay(lds, (const float*)(ws + O_GLOW) + (size_t)t0 * 32, wgate + (size_t)((l * 2 + dir) * 16) * 256 + h * 64, bgate + (l * 2 + dir) * 256 + h * 64, dir);
        { const int s = tid >> 3, dg = tid & 7;
          float qv[8], kv[8];
          unpack8(qraw, qv);
          unpack8(kraw, kv);
#pragma unroll
          for (int e = 0; e < 8; ++e) { const float bv = Bs[s * 65 + dg * 8 + e]; qv[e] *= __expf(bv); kv[e] *= __expf(-bv); }
          *(u32x4*)(QE + s * 72 + dg * 8) = pack8(qv); *(u32x4*)(KE + s * 72 + dg * 8) = pack8(kv); }
        __syncthreads();
        { const int rb = wid >> 1;
#pragma unroll
          for (int cc = 0; cc < 2; ++cc) { const int cb = (wid & 1) * 2 + cc; f32x4 a4 = (f32x4){0.f, 0.f, 0.f, 0.f};
#pragma unroll
              for (int kk = 0; kk < 2; ++kk) { const bf16x8 a = *(const bf16x8*)(QE + (rb * 16 + ql) * 72 + kk * 32 + g * 8); const bf16x8 bb = *(const bf16x8*)(KE + (cb * 16 + ql) * 72 + kk * 32 + g * 8);
                  a4 = __builtin_amdgcn_mfma_f32_16x16x32_bf16(a, bb, a4, 0, 0, 0); }
#pragma unroll
              for (int j = 0; j < 4; ++j) { const int i = rb * 16 + g * 4 + j, ip = cb * 16 + ql; const bool keep = dir == 0 ? (ip <= i) : (ip >= i); ATT[i * 72 + ip] = (bf16_t)f2bf(keep ? a4[j] : 0.f); } } }
        __syncthreads();
        { const int sidx = ((b * 4 + h) * 2 + dir) * 132 + c;
          const bf16_t* st = (const bf16_t*)(ws + O_ST) + (size_t)sidx * 8192;
#pragma unroll
          for (int kk = 0; kk < 2; ++kk) {
              const bf16x8 bv = *(const bf16x8*)(Vt + (wid * 16 + ql) * 72 + kk * 32 + g * 8);
              const bf16x8 bs = dir == 0 ? sfr[0][kk] : sfr[1][kk];
#pragma unroll
              for (int rb = 0; rb < 4; ++rb) {
                  const bf16x8 a1 = *(const bf16x8*)(ATT + (rb * 16 + ql) * 72 + kk * 32 + g * 8);
                  const bf16x8 a2 = *(const bf16x8*)(QE + (rb * 16 + ql) * 72 + kk * 32 + g * 8);
                  oacc[rb] = __builtin_amdgcn_mfma_f32_16x16x32_bf16(a1, bv, oacc[rb], 0, 0, 0);
                  oacc[rb] = __builtin_amdgcn_mfma_f32_16x16x32_bf16(a2, bs, oacc[rb], 0, 0, 0);
              } } }
        __syncthreads();
    }
    float* Os = (float*)(lds + GL_O);
#pragma unroll
    for (int rb = 0; rb < 4; ++rb)
#pragma unroll
        for (int j = 0; j < 4; ++j) Os[(rb * 16 + g * 4 + j) * 132 + wid * 16 + ql] = oacc[rb][j];
    __syncthreads();
    { const int i = tid >> 3, eg = tid & 7;
      float ov[16]; float ss = 0.f;
#pragma unroll
      for (int e = 0; e < 16; ++e) { ov[e] = Os[i * 132 + eg * 16 + e]; ss += ov[e] * ov[e]; }
      ss += __shfl_xor(ss, 1); ss += __shfl_xor(ss, 2); ss += __shfl_xor(ss, 4);
      const float rstd = rsqrtf(ss * (1.f / 128.f) + EPS);
      const float* gn = hnorm + l * 512 + h * 128 + eg * 16;
      bf16_t* rp = (bf16_t*)(ws + O_CR) + (size_t)(t0 + i) * 512 + h * 128 + eg * 16;
#pragma unroll
      for (int hh = 0; hh < 2; ++hh) { float rv[8]; unpack8(hh == 0 ? rraw0 : rraw1, rv);
#pragma unroll
          for (int e = 0; e < 8; ++e) rv[e] = ov[hh * 8 + e] * rstd * gn[hh * 8 + e] * siluf_(rv[e]);
          if (dowrite) *(u32x4*)(rp + hh * 8) = pack8(rv); } }
    __syncthreads();
}

#ifndef REPK
#define REPK 0
#endif
#ifndef REP_SYNC
#define REP_SYNC 0
#endif
#ifndef ASEL
#define ASEL 31
#endif
#ifndef PM
#define PM 0xffff
#endif
#define ON(k) (((PM) >> (k)) & 1)
typedef const __attribute__((address_space(4))) Args* CArgsP;
__global__ void __launch_bounds__(NTHR, 2) mk_fwd(Args args) {
    extern __shared__ __attribute__((aligned(16))) unsigned char lds[];
    cg::grid_group grid = cg::this_grid();
    volatile LASX unsigned* misc = (volatile LASX unsigned*)((LASX unsigned char*)lds + 131072 + 512);
    if (threadIdx.x < 16) misc[threadIdx.x] = 0u;
    __syncthreads();
    XcdBarrier xbar = xcd_barrier_post((unsigned*)(args.ws + O_BAR), misc + 8);
    if (args.ph_hi < 0) grid.sync();
    int rep = 0;
    for (int ph = args.ph_lo; ph < args.ph_hi; ) {
        int tid_k = threadIdx.x; asm volatile("" : "+v"(tid_k));
        const int tid = tid_k, lane = tid & 63, wid = __builtin_amdgcn_readfirstlane(tid >> 6);
        int G_k = gridDim.x, bid_k = blockIdx.x; asm volatile("" : "+s"(G_k), "+s"(bid_k));
        const int G = G_k, bid = bid_k, gw = bid * NWAVES + wid, NGW = G * NWAVES;
        CArgsP ap = (CArgsP)__builtin_amdgcn_kernarg_segment_ptr(); asm volatile("" : "+s"(ap));
        unsigned char* ws = ap->ws;
        float* MOD = (float*)(ws + O_MOD); float* X = (float*)(ws + O_X); bf16_t* HM = (bf16_t*)(ws + O_HM);
        if (ON(11) && ph == 0) {
            float* sv = (float*)lds; float* red = sv + 3072;
            for (int item = bid; item < 4 * 48; item += G) {
                const int l = item / 48, n0 = (item % 48) * 128;
                for (int idx = tid; idx < 3072; idx += NTHR) { const int r = idx >> 10, k = idx & 1023; const float cv = (r < 2) ? ap->in[I_C][r * 1024 + k] : ap->in[I_CCTX][k]; sv[idx] = siluf_(cv); }
                __syncthreads();
                const int kq = tid >> 7, nn = tid & 127; float a0 = 0.f, a1 = 0.f, a2 = 0.f;
                const float* wp = ap->in[I_WMOD] + ((size_t)l * 1024 + kq * 256) * 6144 + n0 + nn;
#pragma unroll 32
                for (int k = 0; k < 256; ++k) { const float w = wp[(size_t)k * 6144]; a0 += sv[kq * 256 + k] * w; a1 += sv[1024 + kq * 256 + k] * w; a2 += sv[2048 + kq * 256 + k] * w; }
                red[(kq * 3 + 0) * 128 + nn] = a0; red[(kq * 3 + 1) * 128 + nn] = a1; red[(kq * 3 + 2) * 128 + nn] = a2;
                __syncthreads();
                if (tid < 384) { const int r = tid >> 7, n2 = tid & 127; float a = ap->in[I_BMOD][l * 6144 + n0 + n2];
                    for (int q = 0; q < 4; ++q) a += red[(q * 3 + r) * 128 + n2];
                    MOD[(l * 3 + r) * 6144 + n0 + n2] = a; }
                __syncthreads();
            }
            float* RA = (float*)(ws + O_ROPEA); float* RB = (float*)(ws + O_ROPEB);
            for (int idx = bid * NTHR + tid; idx < 8192 * 32; idx += G * NTHR) { const int pos = idx >> 5, j = idx & 31;
                const float inv = exp2f(-(float)(j & 15) * (13.287712379549449f / 16.f)); const float p = (j < 16) ? (float)(pos >> 6) : (float)(pos & 63); const float ang = p * inv;
                RA[pos * 64 + j] = __cosf(ang); RA[pos * 64 + 32 + j] = __sinf(ang); }
            for (int idx = bid * NTHR + tid; idx < 8192 * 16; idx += G * NTHR) { const int pos = idx >> 4, j = idx & 15;
                const float inv = exp2f(-(float)(j & 7) * (13.287712379549449f / 8.f)); const float p = (j < 8) ? (float)(pos >> 6) : (float)(pos & 63); const float ang = p * inv;
                RB[pos * 32 + j] = __cosf(ang); RB[pos * 32 + 16 + j] = __sinf(ang); }
        } else if (ON(12) && ph == 45) {
            for (int r = gw; r < NB * SEQ; r += NGW) { const int b = r >> 13, s = r & 8191;
                const f32x4* xr = (const f32x4*)(X + (size_t)(b * TB + LC + s) * 1024) + lane; f32x4 v[4]; float ss = 0.f;
#pragma unroll
                for (int j = 0; j < 4; ++j) { v[j] = xr[64 * j]; ss += (v[j][0] * v[j][0] + v[j][1] * v[j][1]) + (v[j][2] * v[j][2] + v[j][3] * v[j][3]); }
                const float rstd = rsqrtf(wave_sum(ss) * (1.f / 1024.f) + EPS);
#pragma unroll
                for (int j = 0; j < 4; ++j) { const f32x4 w = ((const f32x4*)ap->in[I_FNORM])[64 * j + lane]; f32x4 o; o[0] = v[j][0] * rstd * w[0]; o[1] = v[j][1] * rstd * w[1]; o[2] = v[j][2] * rstd * w[2]; o[3] = v[j][3] * rstd * w[3];
                    ((f32x4*)(ap->out + (size_t)r * 1024))[64 * j + lane] = o; } }
        } else {
            const int l = (ph - 1) / 11, k = (ph - 1) % 11;
            const float* modl = MOD + l * 3 * 6144;
            if (ON(0) && k == 0) {
                float* scr = (float*)lds + wid * (64 * 33);
                constexpr int I0 = 184 * 16, I1 = I0 + 24 * 4, I2 = I1 + 32 * 4, I3 = I2 + 3 * 32 * 8, I4 = I3 + 32 * 16, I5 = I4 + 176 * 16, I6 = I5 + 32 * 44;
                for (int it = gw; it < I6; it += NGW) {
                    if (it < I0) transpose_item(ap->in[I_WIN] + (size_t)l * 1024 * IN_DIM, 1024, IN_DIM, (bf16_t*)(ws + O_WIN), 1024, it, MAT_IN, nullptr, scr, lane);
                    else if (it < I1) transpose_item(ap->in[I_WUQ] + (size_t)l * 256 * 768, 256, 768, (bf16_t*)(ws + O_WUQ), 256, it - I0, MAT_UQ, ap->in[I_QNORM] + l * 256, scr, lane);
                    else if (it < I2) transpose_item(ap->in[I_WUKV] + (size_t)l * 128 * 1024, 128, 1024, (bf16_t*)(ws + O_WUKV), 256, it - I1, MAT_PLAIN, ap->in[I_KVNORM] + l * 128, scr, lane);
                    else if (it < I3) { const int r = it - I2, br = r / 256; const float* src = (br == 0 ? ap->in[I_WBRA] : (br == 1 ? ap->in[I_WBRB] : ap->in[I_WBRC])) + (size_t)l * 512 * 1024;
                        transpose_item(src, 512, 1024, (bf16_t*)(ws + O_WBR) + (size_t)br * 1024 * 512, 512, r - br * 256, MAT_PLAIN, nullptr, scr, lane); }
                    else if (it < I4) transpose_item(ap->in[I_WOUT] + (size_t)l * 1024 * 1024, 1024, 1024, (bf16_t*)(ws + O_WOUT), 1024, it - I3, MAT_PLAIN, nullptr, scr, lane);
                    else if (it < I5) transpose_item(ap->in[I_WUP] + (size_t)l * 1024 * FF2, 1024, FF2, (bf16_t*)(ws + O_WUP), 1024, it - I4, MAT_PLAIN, nullptr, scr, lane);
                    else transpose_item(ap->in[I_WDOWN] + (size_t)l * FF * 1024, FF, 1024, (bf16_t*)(ws + O_WDOWN), FF, it - I5, MAT_PLAIN, nullptr, scr, lane);
                }
                for (int idx = bid * NTHR + tid; idx < MT * 2; idx += G * NTHR) ((float*)(ws + O_SSQ))[idx] = 0.f;
#define NORM1_PAR(P, t) do { const int b = ((t) >= TB) ? 1 : 0, i = (t) - b * TB, r = (i >= LC) ? b : 2; \
                    P.src = X + (size_t)(t) * 1024; P.cp = nullptr; P.part = nullptr; P.gv = nullptr; P.nsl = 11; \
                    if (l == 0) { P.src = (i >= LC) ? ap->in[I_X] + ((size_t)b * SEQ + (i - LC)) * 1024 : ap->in[I_CTX] + ((size_t)b * LC + i) * 1024; P.cp = X + (size_t)(t) * 1024; } \
                    if (l > 0 && i < LC) { P.part = (const float*)(ws + O_U) + (size_t)(b * 256 + i) * 1024; P.gv = MOD + ((l - 1) * 3 + 2) * 6144 + 5120; P.cp = X + (size_t)(t) * 1024; } \
                    P.sc = modl + r * 6144 + 1024; P.sh = modl + r * 6144; P.orow = HM + (size_t)(t) * 1024; } while (0)
                for (int t = gw; t < MT; t += 2 * NGW) {
                    const int tB = t + NGW; const bool hb = tB < MT;
                    const int tBc = hb ? tB : t;
                    NormPar PA, PB; NormRow RA, RB; NORM1_PAR(PA, t); NORM1_PAR(PB, tBc);
                    norm_load(RA, PA, lane); norm_load(RB, PB, lane);
                    norm_finish(RA, PA, ap->in[I_NMIX] + l * 1024, lane); if (hb) norm_finish(RB, PB, ap->in[I_NMIX] + l * 1024, lane);
                }
#undef NORM1_PAR
            } else if (ON(1) && k == 1) {
                EpiIn E{ws}; run_gemm(lds, HM, (const bf16_t*)(ws + O_WIN), MT, NPIN, 1024, E);
            } else if (ON(2) && k == 2) {
                if (ON(13)) { EpiUq E{ws}; run_gemm(lds, (const bf16_t*)(ws + O_CQB), (const bf16_t*)(ws + O_WUQ), MT, 768, 256, E); }
                if (ON(14)) { EpiUkv E{ws}; run_gemm(lds, (const bf16_t*)(ws + O_CKVB), (const bf16_t*)(ws + O_WUKV), MT, 1024, 256, E); }
                if (ON(15)) for (int item = bid; item < 2112; item += G) gla_state_item(lds, ws, ap->in[I_WGATE], ap->in[I_BGATE], l, item);
            } else if (ON(3) && k == 3) {
                if ((ASEL & 16) && rep == 0) gla_scan(ws, bid, tid, G);
                for (int L = bid; L < (rep == 0 ? 544 : 256); L += G) {
                    const int npass = (PROBE_AA && L >= 256 && L < 768) ? 2 : 1;
                    for (int pass = 0; pass < npass; ++pass) {
                    if ((ASEL & 1) && L < 256) { const int bh_ = (L & 7) + 8 * ((L >> 3) & 1), b = bh_ >> 3, h = bh_ & 7, qs = L >> 4;
                        attn_unit<96, false, 4>(lds, (const bf16_t*)(ws + O_QB) + (size_t)b * TB * 768 + h * 96, 768, (const bf16_t*)(ws + O_KB) + (size_t)b * TB * 768 + h * 96, 768,
                                             (const bf16_t*)(ws + O_VBT) + (size_t)(b * 8 + h) * 64 * TB, (bf16_t*)(ws + O_YB) + (size_t)b * TB * 512 + h * 64, 512, LC + qs * 512, 0, 132, 0, 0, 0.f, false);
                    } else if ((ASEL & 2) && L >= 256 && L < 512) { const int L2 = L - 256, bh_ = (L2 & 7) + 8 * ((L2 >> 3) & 1), b = bh_ >> 3, h = bh_ & 7, qs = L2 >> 4, kvh = h >> 2;
                        const int p0 = qs * 512, lo = (p0 - 128 < 0) ? 0 : p0 - 128, hi = (p0 + 640 > SEQ) ? SEQ : p0 + 640;
                        bf16_t* qo = (bf16_t*)(ws + O_QA) + (size_t)b * TB * 512 + h * 64;
                        attn_unit<64, true, 4>(lds, qo, 512, (const bf16_t*)(ws + O_KA) + (size_t)b * TB * 128 + kvh * 64, 128, (const bf16_t*)(ws + O_VAT) + (size_t)(b * 2 + kvh) * 64 * TB,
                                            qo, 512, LC + p0, 0, 4, (lo + LC) / 64, (hi - lo) / 64, ap->in[I_SINK][l * 8 + h] * LOG2E, true);
                    } else if ((ASEL & 4) && L >= 512 && L < 528) { const int L2 = L - 512, b = L2 >> 3, h = L2 & 7;
                        attn_unit<96, false, 2>(lds, (const bf16_t*)(ws + O_QB) + (size_t)b * TB * 768 + h * 96, 768, (const bf16_t*)(ws + O_KB) + (size_t)b * TB * 768 + h * 96, 768,
                                             (const bf16_t*)(ws + O_VBT) + (size_t)(b * 8 + h) * 64 * TB, (bf16_t*)(ws + O_YB) + (size_t)b * TB * 512 + h * 64, 512, 0, 0, 4, 0, 0, 0.f, false);
                    } else if ((ASEL & 8) && L >= 528) { const int L2 = L - 528, b = L2 >> 3, h = L2 & 7, kvh = h >> 2;
                        bf16_t* qo = (bf16_t*)(ws + O_QA) + (size_t)b * TB * 512 + h * 64;
                        attn_unit<64, false, 2>(lds, qo, 512, (const bf16_t*)(ws + O_KA) + (size_t)b * TB * 128 + kvh * 64, 128, (const bf16_t*)(ws + O_VAT) + (size_t)(b * 2 + kvh) * 64 * TB,
                                             qo, 512, 0, 0, 4, 0, 0, ap->in[I_SINK][l * 8 + h] * LOG2E, true);
                    }
                    }
                }
            } else if (ON(4) && k == 4) {
                if (PROBE_GC) for (int item = bid; item < 1056; item += G) gla_out_item(lds, ws, ap->in[I_WGATE], ap->in[I_BGATE], ap->in[I_HNORM], l, item, false);
                for (int item = bid; item < 1056; item += G) gla_out_item(lds, ws, ap->in[I_WGATE], ap->in[I_BGATE], ap->in[I_HNORM], l, item);
            } else if (ON(5) && k == 5) {
                { EpiMerge<0> E{ws}; run_gemm_main(lds, (const bf16_t*)(ws + O_QA), (const bf16_t*)(ws + O_WBR), 1024, 512, E); }
                { EpiMerge<1> E{ws}; run_gemm_main(lds, (const bf16_t*)(ws + O_YB), (const bf16_t*)(ws + O_WBR) + (size_t)1024 * 512, 1024, 512, E); }
                { EpiMerge<2> E{ws}; run_gemm_main(lds, (const bf16_t*)(ws + O_CR), (const bf16_t*)(ws + O_WBR) + (size_t)2 * 1024 * 512, 1024, 512, E); }
                { EpiMergePart<0> E{ws, 256 * 2}; run_gemm_ctx(lds, (const bf16_t*)(ws + O_QA), (const bf16_t*)(ws + O_WBR), 1024, 512, 2, E, 64); }
                { EpiMergePart<1> E{ws, 256 * 2}; run_gemm_ctx(lds, (const bf16_t*)(ws + O_YB), (const bf16_t*)(ws + O_WBR) + (size_t)1024 * 512, 1024, 512, 2, E, 96); }
                { EpiMergePart<2> E{ws, 256 * 2}; run_gemm_ctx(lds, (const bf16_t*)(ws + O_CR), (const bf16_t*)(ws + O_WBR) + (size_t)2 * 1024 * 512, 1024, 512, 2, E, 128); }
            } else if (ON(6) && k == 6) {
                for (int r = gw; r < 512; r += NGW) { const int t = (r < 256) ? r : (TB + r - 256);
                    const f32x4* sp = (const f32x4*)((const float*)(ws + O_CQ) + (size_t)r * 1024);
#pragma unroll
                    for (int j = 0; j < 4; ++j) { f32x4 a = sp[64 * j + lane];
#pragma unroll
                        for (int q = 1; q < 6; ++q) a = a + sp[(size_t)q * 512 * 256 + 64 * j + lane];
                        u32x2 o; o.x = pk2(a[0], a[1]); o.y = pk2(a[2], a[3]); ((u32x2*)(HM + (size_t)t * 1024))[64 * j + lane] = o; } }
                xcd_barrier(xbar);
                if (PROBE_OD) { EpiNull E{(float*)(ws + O_SSQ)}; run_gemm_main(lds, HM, (const bf16_t*)(ws + O_WOUT), 1024, 1024, E); run_gemm_ctx(lds, HM, (const bf16_t*)(ws + O_WOUT), 1024, 1024, 4, E); }
                { EpiResid E{ws, modl, 2048}; run_gemm_main(lds, HM, (const bf16_t*)(ws + O_WOUT), 1024, 1024, E); }
                { EpiPartial E{(float*)(ws + O_GATES), 256 * 2}; run_gemm_ctx(lds, HM, (const bf16_t*)(ws + O_WOUT), 1024, 1024, 4, E); }
            } else if (ON(7) && k == 7) {
#define NORM2_PAR(P, t) do { const int b = ((t) >= TB) ? 1 : 0, i = (t) - b * TB, r = (i >= LC) ? b : 2; \
                    P.src = X + (size_t)(t) * 1024; P.cp = nullptr; P.part = nullptr; P.gv = nullptr; P.nsl = 4; \
                    if (i < LC) { P.part = (const float*)(ws + O_GATES) + (size_t)(b * 256 + i) * 1024; P.gv = modl + 2 * 6144 + 2048; P.cp = X + (size_t)(t) * 1024; } \
                    P.sc = modl + r * 6144 + 4096; P.sh = modl + r * 6144 + 3072; P.orow = HM + (size_t)(t) * 1024; } while (0)
                for (int t = gw; t < MT; t += 2 * NGW) {
                    const int tB = t + NGW; const bool hb = tB < MT;
                    const int tBc = hb ? tB : t;
                    NormPar PA, PB; NormRow RA, RB; NORM2_PAR(PA, t); NORM2_PAR(PB, tBc);
                    norm_load(RA, PA, lane); norm_load(RB, PB, lane);
                    norm_finish(RA, PA, ap->in[I_NFFN] + l * 1024, lane); if (hb) norm_finish(RB, PB, ap->in[I_NFFN] + l * 1024, lane);
                }
#undef NORM2_PAR
            } else if (ON(8) && k == 8) {
                EpiStore E{(bf16_t*)(ws + O_U), FF2}; run_gemm(lds, HM, (const bf16_t*)(ws + O_WUP), MT, FF2, 1024, E);
            } else if (ON(9) && k == 9) {
                const bf16_t* U = (const bf16_t*)(ws + O_U); bf16_t* ACT = (bf16_t*)(ws + O_ACT);
                const float* cw = ap->in[I_CONVW] + (size_t)l * 3 * FF2; const float* cb = ap->in[I_CONVB] + (size_t)l * FF2;
#pragma unroll 1
                for (int idx = bid * NTHR + tid; idx < (MT / 16) * 352; idx += G * NTHR) {
                    const int tb = idx / 352, j0 = (idx - tb * 352) * 8; const int t0 = tb * 16; const int b = (t0 >= TB) ? 1 : 0, i0 = t0 - b * TB;
                    float wg0[8], wg1[8], wg2[8], bg[8], wv0[8], wv1[8], wv2[8], bv[8];
#pragma unroll
                    for (int e = 0; e < 8; ++e) { wg0[e] = cw[j0 + e]; wg1[e] = cw[FF2 + j0 + e]; wg2[e] = cw[2 * FF2 + j0 + e]; bg[e] = cb[j0 + e];
                        wv0[e] = cw[FF + j0 + e]; wv1[e] = cw[FF2 + FF + j0 + e]; wv2[e] = cw[2 * FF2 + FF + j0 + e]; bv[e] = cb[FF + j0 + e]; }
                    const bf16_t* up = U + (size_t)t0 * FF2 + j0;
                    u32x4 gp_ = (u32x4){0u, 0u, 0u, 0u}, vp_ = (u32x4){0u, 0u, 0u, 0u};
                    if (i0 != 0 && i0 != LC) { gp_ = *(const u32x4*)(up - FF2); vp_ = *(const u32x4*)(up - FF2 + FF); }
                    u32x4 gc_ = *(const u32x4*)up, vc_ = *(const u32x4*)(up + FF);
#pragma unroll 4
                    for (int r = 0; r < 16; ++r) {
                        u32x4 gn_ = (u32x4){0u, 0u, 0u, 0u}, vn_ = (u32x4){0u, 0u, 0u, 0u};
                        const int ii = i0 + r;
                        if (ii != LC - 1 && ii != TB - 1) { gn_ = *(const u32x4*)(up + (size_t)(r + 1) * FF2); vn_ = *(const u32x4*)(up + (size_t)(r + 1) * FF2 + FF); }
                        float gm[8], gc[8], gn[8], vm[8], vc[8], vn[8], o[8];
                        unpack8(gp_, gm); unpack8(gc_, gc); unpack8(gn_, gn); unpack8(vp_, vm); unpack8(vc_, vc); unpack8(vn_, vn);
#pragma unroll
                        for (int e = 0; e < 8; ++e) {
                            const float a = wg0[e] * gm[e] + wg1[e] * gc[e] + wg2[e] * gn[e] + bg[e];
                            const float v = wv0[e] * vm[e] + wv1[e] * vc[e] + wv2[e] * vn[e] + bv[e];
                            o[e] = siluf_(a) * v;
                        }
                        *(u32x4*)(ACT + (size_t)(t0 + r) * FF + j0) = pack8(o);
                        gp_ = gc_; vp_ = vc_; gc_ = gn_; vc_ = vn_;
                    }
                }
            } else if (ON(10) && k == 10) {
                if (PROBE_OD) { EpiNull E{(float*)(ws + O_SSQ)}; run_gemm_main(lds, (const bf16_t*)(ws + O_ACT), (const bf16_t*)(ws + O_WDOWN), 1024, FF, E); run_gemm_ctx(lds, (const bf16_t*)(ws + O_ACT), (const bf16_t*)(ws + O_WDOWN), 1024, FF, 11, E); }
                { EpiResid E{ws, modl, 5120}; run_gemm_main(lds, (const bf16_t*)(ws + O_ACT), (const bf16_t*)(ws + O_WDOWN), 1024, FF, E); }
                { EpiPartial E{(float*)(ws + O_U), 256 * 2}; run_gemm_ctx(lds, (const bf16_t*)(ws + O_ACT), (const bf16_t*)(ws + O_WDOWN), 1024, FF, 11, E); }
            }
        }
        { const int kk_ = (ph >= 1 && ph <= 44) ? (ph - 1) % 11 : 15;
          const bool again = (rep == 0) && (((REPK) >> kk_) & 1);
          if (again) rep = 1; else { rep = 0; ++ph; }
          if (again || ph < args.ph_hi) { xcd_barrier(xbar); if (REP_SYNC) xcd_barrier(xbar); } }
    }
}

constexpr int N_PHASES = 46;
extern "C" void kernel_launch(void* const* d_in, const int* in_sizes, int n_in, void* d_out, int out_size, void* d_ws, size_t ws_size, hipStream_t stream) {
    static int grid = 0;
    if (grid == 0) {
        if (n_in != N_IN || ws_size < O_END) { fprintf(stderr, "kernel_launch: bad shapes: n_in %d ws %zu (need %zu)\n", n_in, ws_size, (size_t)O_END); grid = -1; return; }
        int dev = 0, cus = 0, per_cu = 0;
        hipGetDevice(&dev); hipDeviceGetAttribute(&cus, hipDeviceAttributeMultiprocessorCount, dev);
        if (hipFuncSetAttribute((const void*)mk_fwd, hipFuncAttributeMaxDynamicSharedMemorySize, LDS_BYTES) != hipSuccess) { fprintf(stderr, "kernel_launch: hipFuncSetAttribute failed\n"); grid = -1; return; }
        hipOccupancyMaxActiveBlocksPerMultiprocessor(&per_cu, (const void*)mk_fwd, NTHR, LDS_BYTES);
        (void)hipGetLastError();
        if (per_cu < 1) per_cu = 1;
        grid = cus * 1;
        fprintf(stderr, "kernel_launch: cus %d per_cu %d grid %d\n", cus, per_cu, grid);
    }
    if (grid < 0) return;
    if (hipMemsetAsync((char*)d_ws + O_BAR, 0, 16384, stream) != hipSuccess) { fprintf(stderr, "kernel_launch: memset failed\n"); return; }
    Args a{};
    for (int i = 0; i < N_IN; ++i) a.in[i] = (const float*)d_in[i];
    a.out = (float*)d_out; a.ws = (unsigned char*)d_ws;
#if ONE_LAUNCH
    a.ph_lo = 0; a.ph_hi = N_PHASES;
    void* kargs[] = {&a};
    hipError_t e = hipLaunchCooperativeKernel((const void*)mk_fwd, dim3(grid), dim3(NTHR), kargs, LDS_BYTES, stream);
    if (e != hipSuccess) fprintf(stderr, "cooperative launch failed: %s (grid %d)\n", hipGetErrorString(e), grid);
#else
    for (int ph = 0; ph < N_PHASES; ++ph) { a.ph_lo = ph; a.ph_hi = ph + 1; hipLaunchKernelGGL(mk_fwd, dim3(grid), dim3(NTHR), LDS_BYTES, stream, a); }
#endif
}
```

```cpp
#include <hip/hip_runtime.h>
#include <hip/hip_cooperative_groups.h>
#include <cstdio>
#include <cstdint>
namespace cg = cooperative_groups;
#ifndef ONE_LAUNCH
#define ONE_LAUNCH 1
#endif
namespace pg8 {
#define PG8_LAS __attribute__((address_space(3)))
typedef unsigned short bf16_t;
typedef short bf16x8 __attribute__((ext_vector_type(8)));
typedef float f32x4 __attribute__((ext_vector_type(4)));
typedef unsigned u32x4 __attribute__((ext_vector_type(4)));
constexpr int BM = 256, BK = 64, HALF = 128, HTB = HALF * BK * 2  , STAGE_BYTES = 8 * HTB, NXCD = 8, WGM = 8;

__host__ __device__ __forceinline__ int lds_byte(int r, int c) { const int st = (r >> 4) * 2 + (c >> 5), rr = r & 15, cc = c & 31, ob = rr * 64 + cc * 2; return st * 1024 + (ob ^ (((ob >> 9) & 1) << 5)); }
__host__ __device__ __forceinline__ void stage_rc(int b, int& R, int& C) { const int st = b / 1024, sb = b % 1024, swz = sb ^ (((sb >> 9) & 1) << 5); R = (st >> 1) * 16 + swz / 64; C = (st & 1) * 32 + (swz % 64) / 2; }
__host__ __device__ __forceinline__ int perm32(int rho) { const int n = rho >> 4, i = rho & 15; return 8 * (i >> 2) + 4 * n + (i & 3); }

struct Unit { int pm, pn, kb; };
struct Gemm { const bf16_t* A; const bf16_t* Bt; int M, N, K, Kloop; };

struct StaticOrder {
    int nM, nN, nwg, G, c;
    __host__ __device__ void init(int M, int N, int G_, int c_) { nM = M / BM; nN = N / BM; nwg = nM * nN; G = G_; c = c_; }
    __host__ __device__ bool next(int i, Unit& u) const {
        const long L = (long)i * G + c; if (L >= nwg) return false;
        int wgid = (int)L; { const int q = nwg / NXCD, r = nwg % NXCD, xcd = wgid % NXCD, off = wgid / NXCD; wgid = (xcd < r ? xcd * (q + 1) : r * (q + 1) + (xcd - r) * q) + off; }
        const int nig = WGM * nN, gid = wgid / nig, fm = gid * WGM, gsz = (nM - fm) < WGM ? (nM - fm) : WGM;
        u.pm = fm + ((wgid % nig) % gsz); u.pn = (wgid % nig) / gsz; u.kb = 0; return true;
    }
    __device__ __forceinline__ void a_ready(const Unit&) const {}
    __device__ __forceinline__ void done(const Unit&) const {}
};

__device__ __forceinline__ unsigned cvt_pk_bf16(float lo, float hi) { unsigned r; asm volatile("v_cvt_pk_bf16_f32 %0, %1, %2" : "=v"(r) : "v"(lo), "v"(hi)); return r; }
template <class Epi, class Sched, bool ALIGN_EPI = false, bool SP2 = false>
__device__ __forceinline__ void gemm_phase(PG8_LAS unsigned char* lds, const Gemm g, const Sched& S, const Epi& E) {
    int tid_ = threadIdx.x; asm volatile("" : "+v"(tid_));
    const int tid = tid_, wid = __builtin_amdgcn_readfirstlane(tid >> 6), lane = tid & 63, wr = wid >> 2, wc = wid & 3, fr = lane & 15, fq = lane >> 4;
    const int K = g.K, nt = g.Kloop / BK;
    unsigned voffA[2], voffB[2];
#pragma unroll
    for (int i = 0; i < 2; ++i) { int R, C; stage_rc(tid * 16 + i * 8192, R, C); const int Rb = Epi::PERM ? ((R & ~31) + perm32(R & 31)) : R;
        voffA[i] = (unsigned)(R * K + C) * 2u; voffB[i] = (unsigned)(Rb * K + C) * 2u; }
    const size_t kstep = (size_t)(BK * 2);
    const size_t hstep = (size_t)HALF * K * 2;
    const size_t tstep = 2 * hstep;
    const unsigned ldsw = (unsigned)wid * 1024u;
    const int aoff = lds_byte(wr * 64 + fr, fq * 8), boff = lds_byte(wc * 32 + fr, fq * 8);
#define PG8_SA(b, h) (((b) * 2 + (h)) * HTB)
#define PG8_SB(b, h) ((4 + (b) * 2 + (h)) * HTB)
#define PG8_STAGE(bufoff, gbase, voff) do { _Pragma("unroll") for (int _i = 0; _i < 2; ++_i) \
        __builtin_amdgcn_global_load_lds((const unsigned*)((const char*)(gbase) + (voff)[_i]), (PG8_LAS unsigned*)(lds + (bufoff) + ldsw + _i * 8192), 16, 0, 0); } while (0)
#define PG8_LDA(dst, b, h) do { _Pragma("unroll") for (int m = 0; m < 4; ++m) _Pragma("unroll") for (int k = 0; k < 2; ++k) dst[m][k] = *(const PG8_LAS bf16x8*)(lds + PG8_SA(b, h) + aoff + m * 2048 + k * 1024); } while (0)
#define PG8_LDB(dst, b, h) do { _Pragma("unroll") for (int n = 0; n < 2; ++n) _Pragma("unroll") for (int k = 0; k < 2; ++k) dst[n][k] = *(const PG8_LAS bf16x8*)(lds + PG8_SB(b, h) + boff + n * 2048 + k * 1024); } while (0)
#define PG8_MMA(ai, bj, At, Bt) do { __builtin_amdgcn_s_setprio(1); _Pragma("unroll") for (int m = 0; m < 4; ++m) _Pragma("unroll") for (int n = 0; n < 2; ++n) _Pragma("unroll") for (int k = 0; k < 2; ++k) \
        acc[ai][bj][m][n] = __builtin_amdgcn_mfma_f32_16x16x32_bf16(Bt[n][k], At[m][k], acc[ai][bj][m][n], 0, 0, 0); __builtin_amdgcn_s_setprio(0); } while (0)
#define PG8_WAIT_V(n) asm volatile("s_waitcnt vmcnt(" #n ")" ::: "memory")
#define PG8_WAIT_L(n) asm volatile("s_waitcnt lgkmcnt(" #n ")" ::: "memory")
#define PG8_BAR __builtin_amdgcn_s_barrier()
#define PG8_SCHED __builtin_amdgcn_sched_barrier(0)
    Unit cur, nxt; int ui = 0;
    if (!S.next(0, cur)) return;
    f32x4 acc[2][2][4][2];
#pragma unroll
    for (int a = 0; a < 2; ++a)
#pragma unroll
        for (int b = 0; b < 2; ++b)
#pragma unroll
            for (int m = 0; m < 4; ++m)
#pragma unroll
                for (int n = 0; n < 2; ++n) acc[a][b][m][n] = (f32x4){0.f, 0.f, 0.f, 0.f};
    bf16x8 At[4][2], B0[2][2], B1[2][2];
    const char* cA = (const char*)g.A + (size_t)cur.pm * tstep + cur.kb; const char* cB = (const char*)g.Bt + (size_t)cur.pn * tstep + cur.kb;
    S.a_ready(cur);
    if constexpr (SP2) {
        PG8_STAGE(PG8_SB(0, 0), cB, voffB); PG8_STAGE(PG8_SB(0, 1), cB + hstep, voffB); PG8_STAGE(PG8_SA(0, 0), cA, voffA); PG8_STAGE(PG8_SA(0, 1), cA + hstep, voffA);
        if (wr == 1) PG8_BAR;
        PG8_WAIT_V(2); PG8_BAR;
        PG8_STAGE(PG8_SB(1, 0), cB + kstep, voffB); PG8_STAGE(PG8_SA(1, 0), cA + kstep, voffA); PG8_STAGE(PG8_SB(1, 1), cB + hstep + kstep, voffB);
        PG8_WAIT_V(6); PG8_BAR;
    } else {
        PG8_STAGE(PG8_SB(0, 0), cB, voffB); PG8_STAGE(PG8_SA(0, 0), cA, voffA); PG8_STAGE(PG8_SB(0, 1), cB + hstep, voffB); PG8_STAGE(PG8_SA(0, 1), cA + hstep, voffA);
        if (wr == 1) PG8_BAR;
        PG8_WAIT_V(4); PG8_BAR;
        PG8_STAGE(PG8_SB(1, 0), cB + kstep, voffB); PG8_STAGE(PG8_SA(1, 0), cA + kstep, voffA); PG8_STAGE(PG8_SB(1, 1), cB + hstep + kstep, voffB);
        PG8_WAIT_V(6); PG8_BAR;
    }
    for (;;) {
        const bool has_next = S.next(ui + 1, nxt);
        const char* nA = has_next ? (const char*)g.A + (size_t)nxt.pm * tstep + nxt.kb : cA; const char* nB = has_next ? (const char*)g.Bt + (size_t)nxt.pn * tstep + nxt.kb : cB;
        for (int t = 0; t < nt; t += 2) {
            const bool last = (t == nt - 2);
            const char* a1 = cA + (size_t)(t + 1) * kstep;
            const char* a2 = last ? nA : cA + (size_t)(t + 2) * kstep; const char* b2 = last ? nB : cB + (size_t)(t + 2) * kstep;
            const char* a3 = a2 + kstep; const char* b3 = b2 + kstep;
            if (last && has_next) S.a_ready(nxt);
            if constexpr (SP2) {
            PG8_LDB(B0, 0, 0); PG8_LDB(B1, 0, 1); PG8_SCHED; PG8_LDA(At, 0, 0); PG8_STAGE(PG8_SA(1, 1), a1 + hstep, voffA);
            PG8_WAIT_V(8); PG8_WAIT_L(0); PG8_BAR; PG8_MMA(0, 0, At, B0); PG8_MMA(0, 1, At, B1); PG8_BAR; PG8_SCHED;
            PG8_LDA(At, 0, 1); PG8_STAGE(PG8_SB(0, 0), b2, voffB); PG8_STAGE(PG8_SB(0, 1), b2 + hstep, voffB); PG8_STAGE(PG8_SA(0, 0), a2, voffA);
            PG8_WAIT_V(8); PG8_WAIT_L(0); PG8_BAR; PG8_MMA(1, 0, At, B0); PG8_MMA(1, 1, At, B1); PG8_BAR; PG8_SCHED;
            PG8_LDB(B0, 1, 0); PG8_LDB(B1, 1, 1); PG8_SCHED; PG8_LDA(At, 1, 0); PG8_STAGE(PG8_SA(0, 1), a2 + hstep, voffA);
            PG8_WAIT_V(8); PG8_WAIT_L(0); PG8_BAR; PG8_MMA(0, 0, At, B0); PG8_MMA(0, 1, At, B1); PG8_BAR; PG8_SCHED;
            PG8_LDA(At, 1, 1); PG8_STAGE(PG8_SB(1, 0), b3, voffB); PG8_STAGE(PG8_SB(1, 1), b3 + hstep, voffB); PG8_STAGE(PG8_SA(1, 0), a3, voffA);
            PG8_WAIT_V(8); PG8_WAIT_L(0); PG8_BAR; PG8_MMA(1, 0, At, B0); PG8_MMA(1, 1, At, B1); PG8_BAR; PG8_SCHED;
            } else {
            PG8_LDB(B0, 0, 0); PG8_SCHED; PG8_LDA(At, 0, 0); PG8_STAGE(PG8_SA(1, 1), a1 + hstep, voffA);
            PG8_WAIT_L(8); PG8_BAR; PG8_WAIT_L(0); PG8_MMA(0, 0, At, B0); PG8_BAR; PG8_SCHED;
            PG8_LDB(B1, 0, 1); PG8_STAGE(PG8_SB(0, 0), b2, voffB);
            PG8_BAR; PG8_WAIT_L(0); PG8_MMA(0, 1, At, B1); PG8_BAR;
            PG8_LDA(At, 0, 1); PG8_STAGE(PG8_SA(0, 0), a2, voffA);
            PG8_BAR; PG8_WAIT_L(0); PG8_MMA(1, 0, At, B0); PG8_BAR; PG8_SCHED;
            PG8_STAGE(PG8_SB(0, 1), b2 + hstep, voffB);
            PG8_WAIT_V(6); PG8_BAR; PG8_MMA(1, 1, At, B1); PG8_BAR;
            PG8_LDB(B0, 1, 0); PG8_SCHED; PG8_LDA(At, 1, 0); PG8_STAGE(PG8_SA(0, 1), a2 + hstep, voffA);
            PG8_WAIT_L(8); PG8_BAR; PG8_WAIT_L(0); PG8_MMA(0, 0, At, B0); PG8_BAR; PG8_SCHED;
            PG8_LDB(B1, 1, 1); PG8_STAGE(PG8_SB(1, 0), b3, voffB);
            PG8_BAR; PG8_WAIT_L(0); PG8_MMA(0, 1, At, B1); PG8_BAR;
            PG8_LDA(At, 1, 1); PG8_STAGE(PG8_SA(1, 0), a3, voffA);
            PG8_BAR; PG8_WAIT_L(0); PG8_MMA(1, 0, At, B0); PG8_BAR; PG8_SCHED;
            PG8_STAGE(PG8_SB(1, 1), b3 + hstep, voffB);
            PG8_WAIT_V(6); PG8_BAR; PG8_MMA(1, 1, At, B1); PG8_BAR;
            }
        }
        if constexpr (ALIGN_EPI) { if (wr == 0) PG8_BAR; }
        if constexpr (!Epi::AFTER_DRAIN) { E(acc, cur, wr, wc, fr, fq); S.done(cur); }
        if (!has_next) break;
#pragma unroll
        for (int a = 0; a < 2; ++a)
#pragma unroll
            for (int b = 0; b < 2; ++b)
#pragma unroll
                for (int m = 0; m < 4; ++m)
#pragma unroll
                    for (int n = 0; n < 2; ++n) acc[a][b][m][n] = (f32x4){0.f, 0.f, 0.f, 0.f};
        cur = nxt; cA = nA; cB = nB; ++ui;
        if constexpr (ALIGN_EPI) { if (wr == 1) PG8_BAR; }
    }
    PG8_WAIT_V(0);
    if constexpr (!ALIGN_EPI) { if (wr == 0) PG8_BAR; }
    PG8_BAR;
    if constexpr (Epi::AFTER_DRAIN) { E.fused(acc, cur, wr, wc, fr, fq, lds, wid, lane); S.done(cur); }
#undef PG8_SA
#undef PG8_SB
#undef PG8_STAGE
#undef PG8_LDA
#undef PG8_LDB
#undef PG8_MMA
#undef PG8_WAIT_V
#undef PG8_WAIT_L
#undef PG8_BAR
#undef PG8_SCHED
}
}
#define LASX __attribute__((address_space(3)))
#define XB_TMO      128
#define XB_XCNT(j)  (256  + 64 * (j))
#define XB_XSUB(j)  (1280 + 64 * (j))
#define XB_XGEN(j)  (2304 + 64 * (j))
#define XB_TOP      3328
#define XB_TOPGEN   3392
#define XCD_BAR_WORDS 3456
#define XB_SPIN_CAP (1u << 18)

__device__ __forceinline__ unsigned xb_ld(unsigned* p)              { return __hip_atomic_load(p, __ATOMIC_RELAXED, __HIP_MEMORY_SCOPE_AGENT); }
__device__ __forceinline__ unsigned xb_add(unsigned* p, unsigned v) { return __hip_atomic_fetch_add(p, v, __ATOMIC_RELAXED, __HIP_MEMORY_SCOPE_AGENT); }
__device__ __forceinline__ unsigned xb_xcc_id() { return (unsigned)__builtin_amdgcn_s_getreg((3 << 11) | 20) & 0xFu; }
#define XB_SPIN(cond, bar) do { unsigned _sp = 0; while (cond) { __builtin_amdgcn_s_sleep(1); \
    if ((++_sp & 255u) == 0u) { if (xb_ld(&(bar)[XB_TMO])) break; if (_sp > XB_SPIN_CAP) { atomicAdd(&(bar)[XB_TMO], 1u); break; } } } } while (0)

struct XcdBarrier {
    unsigned* bar; unsigned x;
    volatile LASX unsigned* st;
};

__device__ __forceinline__ XcdBarrier xcd_barrier_post(unsigned* bar, volatile LASX unsigned* st) {
    XcdBarrier b; b.bar = bar; b.x = xb_xcc_id(); b.st = st;
    if (threadIdx.x == 0) (void)xb_add(&bar[XB_XCNT(b.x)], 1u);
    return b;
}
__device__ __forceinline__ void xcd_barrier_complete(unsigned* bar, unsigned x, unsigned& nloc, unsigned& nx) {
    const unsigned G = gridDim.x * gridDim.y * gridDim.z;
    unsigned sum, cnt, mine, sp = 0u;
    for (;;) {
        sum = 0u; cnt = 0u; mine = 0u;
#pragma unroll
        for (unsigned j = 0; j < 16; ++j) { const unsigned c = xb_ld(&bar[XB_XCNT(j)]); sum += c; cnt += (c > 0u) ? 1u : 0u; mine = (j == x) ? c : mine; }
        if (sum == G) break;
        __builtin_amdgcn_s_sleep(1);
        if ((++sp & 255u) == 0u) { if (xb_ld(&bar[XB_TMO])) break; if (sp > XB_SPIN_CAP) { atomicAdd(&bar[XB_TMO], 1u); break; } }
    }
    nloc = mine > 0u ? mine : 1u; nx = cnt > 0u ? cnt : 1u;
}

__device__ __forceinline__ void xcd_barrier(const XcdBarrier& b) {
    asm volatile("s_waitcnt vmcnt(0)" ::: "memory");
    __syncthreads();
    if (threadIdx.x == 0) {
        unsigned* bar = b.bar;
        __builtin_amdgcn_s_waitcnt(0);
        unsigned nloc = b.st[0], nx = b.st[1];
        if (nloc == 0u) { xcd_barrier_complete(bar, b.x, nloc, nx); b.st[0] = nloc; b.st[1] = nx; }
        const unsigned old = xb_add(&bar[XB_XSUB(b.x)], 1u);
        const unsigned gen = old / nloc;
        if (old + 1u == (gen + 1u) * nloc) {
            __builtin_amdgcn_fence(__ATOMIC_RELEASE, "agent");
            asm volatile("s_waitcnt vmcnt(0)" ::: "memory");
            const unsigned og = xb_add(&bar[XB_TOP], 1u);
            const unsigned tg = og / nx;
            if (og + 1u == (tg + 1u) * nx) xb_add(&bar[XB_TOPGEN], 1u);
            else XB_SPIN(xb_ld(&bar[XB_TOPGEN]) == tg, bar);
            __builtin_amdgcn_fence(__ATOMIC_ACQUIRE, "agent");
            xb_add(&bar[XB_XGEN(b.x)], 1u);
            asm volatile("s_waitcnt vmcnt(0)" ::: "memory");
        } else {
            XB_SPIN(xb_ld(&bar[XB_XGEN(b.x)]) == gen, bar);
            __builtin_amdgcn_fence(__ATOMIC_ACQUIRE, "agent");
            asm volatile("s_waitcnt vmcnt(0)" ::: "memory");
        }
    }
    __syncthreads();
}

#ifndef PROBE_OD
#define PROBE_OD 0
#endif
#ifndef PROBE_GC
#define PROBE_GC 0
#endif
#ifndef PROBE_AA
#define PROBE_AA 0
#endif
#ifndef XEXP
#define XEXP 0
#endif
typedef unsigned short bf16_t;
typedef short bf16x8 __attribute__((ext_vector_type(8)));
typedef float f32x4 __attribute__((ext_vector_type(4)));
typedef unsigned u32x4 __attribute__((ext_vector_type(4)));
typedef unsigned u32x2 __attribute__((ext_vector_type(2)));
#define LAS __attribute__((address_space(3)))

constexpr int NB = 2, SEQ = 8192, LC = 256, TB = SEQ + LC, MT = NB * TB, DM = 1024, NL = 4;
constexpr int IN_DIM = 5824, NPIN = 5888, FF = 2816, FF2 = 5632;
constexpr float EPS = 1e-6f, LOG2E = 1.4426950408889634f;
constexpr int NTHR = 512, NWAVES = 8;
constexpr int LDS_BYTES = 147456;
enum { I_X = 0, I_C, I_CTX, I_CCTX, I_WMOD, I_BMOD, I_NMIX, I_NFFN, I_WIN, I_SINK, I_QNORM, I_KVNORM, I_WUQ, I_WUKV, I_WGATE, I_BGATE, I_HNORM,
       I_WBRA, I_WBRB, I_WBRC, I_WOUT, I_WUP, I_CONVW, I_CONVB, I_WDOWN, I_FNORM, N_IN };

constexpr size_t O_MOD = 0;
constexpr size_t O_BAR = 384 * 1024;
constexpr size_t O_ROPEA = 512 * 1024;
constexpr size_t O_ROPEB = O_ROPEA + 2 * 1024 * 1024;
constexpr size_t O_SSQ = O_ROPEB + 1024 * 1024;
constexpr size_t O_GD = O_SSQ + 256 * 1024;
constexpr size_t O_X = O_GD + 1024 * 1024;
constexpr size_t SZ_X = (size_t)MT * DM * 4;
constexpr size_t O_WIN = O_X + SZ_X;
constexpr size_t O_WUQ = O_WIN + (size_t)NPIN * 1024 * 2;
constexpr size_t O_WUKV = O_WUQ + (size_t)768 * 256 * 2;
constexpr size_t O_WBR = O_WUKV + (size_t)1024 * 256 * 2;
constexpr size_t O_WOUT = O_WBR + (size_t)3 * 1024 * 512 * 2;
constexpr size_t O_WUP = O_WOUT + (size_t)1024 * 1024 * 2;
constexpr size_t O_WDOWN = O_WUP + (size_t)FF2 * 1024 * 2;
constexpr size_t O_HM = O_WDOWN + (size_t)1024 * FF * 2;
constexpr size_t O_MIX = O_HM + (size_t)MT * 1024 * 2;
constexpr size_t O_QA = O_MIX;
constexpr size_t O_KA = O_QA + (size_t)MT * 512 * 2;
constexpr size_t O_VAT = O_KA + (size_t)MT * 128 * 2;
constexpr size_t O_CQB = O_VAT + (size_t)2 * 2 * 64 * TB * 2;
constexpr size_t O_CKVB = O_CQB + (size_t)MT * 256 * 2;
constexpr size_t O_QB = O_CKVB + (size_t)MT * 256 * 2;
constexpr size_t O_KB = O_QB + (size_t)MT * 768 * 2;
constexpr size_t O_VBT = O_KB + (size_t)MT * 768 * 2;
constexpr size_t O_CQ = O_VBT + (size_t)2 * 8 * 64 * TB * 2;
constexpr size_t O_CK = O_CQ + (size_t)MT * 256 * 2;
constexpr size_t O_CV = O_CK + (size_t)MT * 256 * 2;
constexpr size_t O_CR = O_CV + (size_t)MT * 512 * 2;
constexpr size_t O_GLOW = O_CR + (size_t)MT * 512 * 2;
constexpr size_t O_GATES = O_GLOW + (size_t)MT * 32 * 4;
constexpr size_t O_YB = O_GATES + (size_t)MT * 3072 * 2;
constexpr size_t O_END = O_YB + (size_t)MT * 512 * 2;
constexpr size_t O_MACC = O_QB;
static_assert(O_CQ - O_QB == (size_t)MT * 1024 * 4, "MACC overlay");
constexpr size_t O_U = O_MIX;
constexpr size_t O_ACT = O_U + (size_t)MT * FF2 * 2;
static_assert(O_ACT + (size_t)MT * FF * 2 <= O_END, "U|ACT overlay");
constexpr size_t O_ST = O_HM;
static_assert((size_t)2112 * 8192 * 2 <= (size_t)MT * 1024 * 2, "ST overlay");
static_assert(O_END <= (size_t)448 * 1024 * 1024, "workspace budget");

__device__ __forceinline__ unsigned f2bf(float f) { unsigned u = __float_as_uint(f); return (u + 0x7fffu + ((u >> 16) & 1u)) >> 16; }
typedef float f32x2_t __attribute__((ext_vector_type(2))); typedef __bf16 bf16x2_t __attribute__((ext_vector_type(2)));
__device__ __forceinline__ unsigned pk2(float lo, float hi) { f32x2_t v = {lo, hi}; bf16x2_t b = __builtin_convertvector(v, bf16x2_t); return __builtin_bit_cast(unsigned, b); }
__device__ __forceinline__ float bflo(unsigned w) { return __uint_as_float(w << 16); }
__device__ __forceinline__ float bfhi(unsigned w) { return __uint_as_float(w & 0xffff0000u); }
__device__ __forceinline__ float bf2f(bf16_t h) { return __uint_as_float(((unsigned)h) << 16); }
__device__ __forceinline__ u32x4 pack8(const float* v) { u32x4 w; w.x = pk2(v[0], v[1]); w.y = pk2(v[2], v[3]); w.z = pk2(v[4], v[5]); w.w = pk2(v[6], v[7]); return w; }
__device__ __forceinline__ void unpack8(u32x4 w, float* v) { v[0] = bflo(w.x); v[1] = bfhi(w.x); v[2] = bflo(w.y); v[3] = bfhi(w.y); v[4] = bflo(w.z); v[5] = bfhi(w.z); v[6] = bflo(w.w); v[7] = bfhi(w.w); }
__device__ __forceinline__ float wave_sum(float v) {
#pragma unroll
    for (int o = 1; o < 64; o <<= 1) v += __shfl_xor(v, o);
    return v;
}
__device__ __forceinline__ float sigmoidf_(float x) { return 1.f / (1.f + __expf(-x)); }
__device__ __forceinline__ float siluf_(float x) { return x / (1.f + __expf(-x)); }

struct Args { const float* in[N_IN]; float* out; unsigned char* ws; int ph_lo, ph_hi; };

enum { MAT_IN = 0, MAT_UQ, MAT_UKV, MAT_PLAIN };
__device__ __forceinline__ int srcmap(int mat, int p) {
    if (mat == MAT_IN) {
        if (p < 640) { const int w = p & 63; return (p & ~63) + (w >> 1) + 32 * (w & 1); }
        if (p < 1152) return p;
        if (p < 1184) { const int w = p - 1152; return 1152 + (w >> 1) + 16 * (w & 1); }
        if (p < 1216) return 2720 + (p - 1184);
        if (p < 1280) return -1;
        if (p < 2816) return 1184 + (p - 1280);
        return 2752 + (p - 2816);
    }
    if (mat == MAT_UQ) { const int h = p / 96, w = p - h * 96; if (w < 64) return p; const int ww = w - 64; return h * 96 + 64 + (ww >> 1) + 16 * (ww & 1); }
    return p;
}
__device__ __forceinline__ void transpose_item(const float* __restrict__ W, int K, int N, bf16_t* WT, int KD, int item, int mat, const float* __restrict__ ks, float* scr, int lane) {
    const int nkb = KD / 64, pb = item / nkb, kb = item - pb * nkb, p0 = pb * 32, k0 = kb * 64;
    const int src = srcmap(mat, p0 + (lane & 31));
    float tv[32];
#pragma unroll
    for (int i = 0; i < 32; ++i) {
        const int k = k0 + 2 * i + (lane >> 5);
        float v = 0.f;
        if (src >= 0 && k < K) { v = W[(size_t)k * N + src]; if (ks) v *= ks[k]; }
        tv[i] = v;
    }
#pragma unroll
    for (int i = 0; i < 32; ++i) scr[(2 * i + (lane >> 5)) * 33 + (lane & 31)] = tv[i];
    __builtin_amdgcn_fence(__ATOMIC_RELEASE, "workgroup"); __builtin_amdgcn_wave_barrier();
    const int c = lane & 7;
#pragma unroll
    for (int j = 0; j < 4; ++j) {
        const int n = (lane >> 3) + 8 * j; const float* s = scr + (8 * c) * 33 + n;
        u32x4 o; o.x = pk2(s[0 * 33], s[1 * 33]); o.y = pk2(s[2 * 33], s[3 * 33]); o.z = pk2(s[4 * 33], s[5 * 33]); o.w = pk2(s[6 * 33], s[7 * 33]);
        *(u32x4*)(WT + (size_t)(p0 + n) * KD + k0 + 8 * c) = o;
    }
    __builtin_amdgcn_fence(__ATOMIC_RELEASE, "workgroup"); __builtin_amdgcn_wave_barrier();
}

#define EPI_LOOP_BEGIN \
    int fr_l = fr, fq_l = fq; asm volatile("" : "+v"(fr_l), "+v"(fq_l)); \
    _Pragma("unroll") for (int bj = 0; bj < 2; ++bj) { const int c0 = u.pn * 256 + bj * 128 + wc * 32 + 8 * fq_l; \
    _Pragma("unroll") for (int ai = 0; ai < 2; ++ai) _Pragma("unroll") for (int m = 0; m < 4; ++m) { const int t = u.pm * 256 + ai * 128 + wr * 64 + m * 16 + fr_l; \
        float v[8]; { const f32x4 a0 = acc[ai][bj][m][0], a1 = acc[ai][bj][m][1]; v[0] = a0[0]; v[1] = a0[1]; v[2] = a0[2]; v[3] = a0[3]; v[4] = a1[0]; v[5] = a1[1]; v[6] = a1[2]; v[7] = a1[3]; }
#define EPI_LOOP_END asm volatile("" ::: "memory"); } }

struct EpiIn {
    static constexpr bool PERM = true, AFTER_DRAIN = false;
    unsigned char* ws;
    __device__ __forceinline__ void operator()(const f32x4 (&acc)[2][2][4][2], const pg8::Unit& u, int wr, int wc, int fr, int fq) const {
        EPI_LOOP_BEGIN
            const int b = (t >= TB) ? 1 : 0, i = t - b * TB; const bool lat = i >= LC; const int pos = i - LC;
            if (c0 < 640) {
                if (lat) { const float* cs = (const float*)(ws + O_ROPEA) + (size_t)pos * 64 + ((c0 & 63) >> 1);
#pragma unroll
                    for (int p = 0; p < 4; ++p) { const float c = cs[p], s = cs[32 + p], a = v[2 * p], bb = v[2 * p + 1]; v[2 * p] = a * c - bb * s; v[2 * p + 1] = a * s + bb * c; } }
                if (c0 < 512) {
#pragma unroll
                    for (int e = 0; e < 8; ++e) v[e] *= 0.125f * LOG2E;
                    *(u32x4*)((bf16_t*)(ws + O_QA) + (size_t)t * 512 + c0) = pack8(v);
                } else *(u32x4*)((bf16_t*)(ws + O_KA) + (size_t)t * 128 + (c0 - 512)) = pack8(v);
            } else if (c0 < 768) {
                const int cc = c0 - 640, kvh = cc >> 6, d0 = cc & 63;
                bf16_t* dst = (bf16_t*)(ws + O_VAT) + ((size_t)(b * 2 + kvh) * 64 + d0) * TB + i;
#pragma unroll
                for (int e = 0; e < 8; ++e) dst[(size_t)e * TB] = (bf16_t)f2bf(v[e]);
            } else if (c0 < 1152) {
                float s = 0.f;
#pragma unroll
                for (int e = 0; e < 8; ++e) s += v[e] * v[e];
                s += __shfl_xor(s, 16); s += __shfl_xor(s, 32);
                if (c0 < 1024) { *(u32x4*)((bf16_t*)(ws + O_CQB) + (size_t)t * 256 + (c0 - 768)) = pack8(v); if (fq_l == 0) unsafeAtomicAdd((float*)(ws + O_SSQ) + t * 2, s); }
                else { bf16_t* d = (bf16_t*)(ws + O_CKVB) + (size_t)t * 256 + (c0 - 1024); *(u32x4*)d = pack8(v); *(u32x4*)(d + 128) = (u32x4){0u, 0u, 0u, 0u}; if (fq_l == 0) unsafeAtomicAdd((float*)(ws + O_SSQ) + t * 2 + 1, s); }
            } else if (c0 < 1184) {
                if (lat) { const float* cs = (const float*)(ws + O_ROPEB) + (size_t)pos * 32 + ((c0 - 1152) >> 1);
#pragma unroll
                    for (int p = 0; p < 4; ++p) { const float c = cs[p], s = cs[16 + p], a = v[2 * p], bb = v[2 * p + 1]; v[2 * p] = a * c - bb * s; v[2 * p + 1] = a * s + bb * c; } }
                const u32x4 w = pack8(v); bf16_t* d = (bf16_t*)(ws + O_KB) + (size_t)t * 768 + 64 + (c0 - 1152);
#pragma unroll
                for (int h = 0; h < 8; ++h) *(u32x4*)(d + h * 96) = w;
            } else if (c0 < 1216) {
                float* d = (float*)(ws + O_GLOW) + (size_t)t * 32 + (c0 - 1184);
                *(f32x4*)d = (f32x4){v[0], v[1], v[2], v[3]}; *(f32x4*)(d + 4) = (f32x4){v[4], v[5], v[6], v[7]};
            } else if (c0 < 1280) {
            } else if (c0 < 1536) {
#pragma unroll
                for (int e = 0; e < 8; ++e) v[e] *= 0.125f;
                *(u32x4*)((bf16_t*)(ws + O_CQ) + (size_t)t * 256 + (c0 - 1280)) = pack8(v);
            } else if (c0 < 1792) { *(u32x4*)((bf16_t*)(ws + O_CK) + (size_t)t * 256 + (c0 - 1536)) = pack8(v);
            } else if (c0 < 2304) { *(u32x4*)((bf16_t*)(ws + O_CV) + (size_t)t * 512 + (c0 - 1792)) = pack8(v);
            } else if (c0 < 2816) { *(u32x4*)((bf16_t*)(ws + O_CR) + (size_t)t * 512 + (c0 - 2304)) = pack8(v);
            } else {
#pragma unroll
                for (int e = 0; e < 8; ++e) v[e] = sigmoidf_(v[e]);
                *(u32x4*)((bf16_t*)(ws + O_GATES) + (size_t)t * 3072 + (c0 - 2816)) = pack8(v);
            }
        EPI_LOOP_END
    }
};

struct EpiUq {
    static constexpr bool PERM = true, AFTER_DRAIN = false;
    unsigned char* ws;
    __device__ __forceinline__ void operator()(const f32x4 (&acc)[2][2][4][2], const pg8::Unit& u, int wr, int wc, int fr, int fq) const {
        EPI_LOOP_BEGIN
            const int b = (t >= TB) ? 1 : 0, i = t - b * TB; const bool lat = i >= LC; const int pos = i - LC;
            const float rstd = rsqrtf(((const float*)(ws + O_SSQ))[t * 2] * (1.f / 256.f) + EPS) * (0.10206207261596575f * LOG2E);
#pragma unroll
            for (int e = 0; e < 8; ++e) v[e] *= rstd;
            const int h = c0 / 96, w = c0 - h * 96;
            if (w >= 64 && lat) { const float* cs = (const float*)(ws + O_ROPEB) + (size_t)pos * 32 + ((w - 64) >> 1);
#pragma unroll
                for (int p = 0; p < 4; ++p) { const float c = cs[p], s = cs[16 + p], a = v[2 * p], bb = v[2 * p + 1]; v[2 * p] = a * c - bb * s; v[2 * p + 1] = a * s + bb * c; } }
            *(u32x4*)((bf16_t*)(ws + O_QB) + (size_t)t * 768 + c0) = pack8(v);
        EPI_LOOP_END
    }
};
struct EpiUkv {
    static constexpr bool PERM = true, AFTER_DRAIN = false;
    unsigned char* ws;
    __device__ __forceinline__ void operator()(const f32x4 (&acc)[2][2][4][2], const pg8::Unit& u, int wr, int wc, int fr, int fq) const {
        EPI_LOOP_BEGIN
            const int b = (t >= TB) ? 1 : 0, i = t - b * TB;
            const float rstd = rsqrtf(((const float*)(ws + O_SSQ))[t * 2 + 1] * (1.f / 128.f) + EPS);
#pragma unroll
            for (int e = 0; e < 8; ++e) v[e] *= rstd;
            const int h = c0 >> 7, w = c0 & 127;
            if (w < 64) *(u32x4*)((bf16_t*)(ws + O_KB) + (size_t)t * 768 + h * 96 + w) = pack8(v);
            else { bf16_t* dst = (bf16_t*)(ws + O_VBT) + ((size_t)(b * 8 + h) * 64 + (w - 64)) * TB + i;
#pragma unroll
                for (int e = 0; e < 8; ++e) dst[(size_t)e * TB] = (bf16_t)f2bf(v[e]); }
        EPI_LOOP_END
    }
};
template <int PASS> struct EpiMerge {
    static constexpr bool PERM = true, AFTER_DRAIN = false;
    unsigned char* ws;
    __device__ __forceinline__ void operator()(const f32x4 (&acc)[2][2][4][2], const pg8::Unit& u, int wr, int wc, int fr, int fq) const {
        EPI_LOOP_BEGIN
            float g[8]; unpack8(*(const u32x4*)((const bf16_t*)(ws + O_GATES) + (size_t)t * 3072 + PASS * 1024 + c0), g);
            bf16_t* mp = (bf16_t*)(ws + O_HM) + (size_t)t * 1024 + c0;
            if (PASS > 0) { float pv[8]; unpack8(*(const u32x4*)mp, pv);
#pragma unroll
                for (int e = 0; e < 8; ++e) v[e] = pv[e] + g[e] * v[e];
            } else {
#pragma unroll
                for (int e = 0; e < 8; ++e) v[e] *= g[e];
            }
            *(u32x4*)mp = pack8(v);
        EPI_LOOP_END
    }
};
template <int PASS> struct EpiMergePart {
    static constexpr bool PERM = true, AFTER_DRAIN = false;
    unsigned char* ws; int kbstep;
    __device__ __forceinline__ void operator()(const f32x4 (&acc)[2][2][4][2], const pg8::Unit& u, int wr, int wc, int fr, int fq) const {
        const int ks = u.kb / kbstep;
        EPI_LOOP_BEGIN
            float g[8]; unpack8(*(const u32x4*)((const bf16_t*)(ws + O_GATES) + (size_t)t * 3072 + PASS * 1024 + c0), g);
            const int cr = (t >= TB) ? (t - TB + 256) : t;
            float* pp = (float*)(ws + O_CQ) + ((size_t)((PASS * 2 + ks) * 512 + cr)) * 1024 + c0;
            *(f32x4*)pp = (f32x4){g[0] * v[0], g[1] * v[1], g[2] * v[2], g[3] * v[3]}; *(f32x4*)(pp + 4) = (f32x4){g[4] * v[4], g[5] * v[5], g[6] * v[6], g[7] * v[7]};
        EPI_LOOP_END
    }
};
struct EpiResid {
    static constexpr bool PERM = true, AFTER_DRAIN = false;
    unsigned char* ws; const float* modl; int goff;
    __device__ __forceinline__ void operator()(const f32x4 (&acc)[2][2][4][2], const pg8::Unit& u, int wr, int wc, int fr, int fq) const {
        EPI_LOOP_BEGIN
            const int b = (t >= TB) ? 1 : 0, i = t - b * TB; const int r = (i >= LC) ? b : 2;
            const float* gp = modl + r * 6144 + goff + c0;
            const f32x4 g0 = *(const f32x4*)gp, g1 = *(const f32x4*)(gp + 4);
            float* xp = (float*)(ws + O_X) + (size_t)t * 1024 + c0;
            f32x4 x0 = *(const f32x4*)xp, x1 = *(const f32x4*)(xp + 4);
            x0[0] += g0[0] * v[0]; x0[1] += g0[1] * v[1]; x0[2] += g0[2] * v[2]; x0[3] += g0[3] * v[3];
            x1[0] += g1[0] * v[4]; x1[1] += g1[1] * v[5]; x1[2] += g1[2] * v[6]; x1[3] += g1[3] * v[7];
            *(f32x4*)xp = x0; *(f32x4*)(xp + 4) = x1;
        EPI_LOOP_END
    }
};
struct EpiPartial {
    static constexpr bool PERM = true, AFTER_DRAIN = false;
    float* P; int kbstep;
    __device__ __forceinline__ void operator()(const f32x4 (&acc)[2][2][4][2], const pg8::Unit& u, int wr, int wc, int fr, int fq) const {
        const int ks = u.kb / kbstep;
        EPI_LOOP_BEGIN
            const int cr = (t >= TB) ? (t - TB + 256) : t;
            float* pp = P + ((size_t)(ks * 512 + cr)) * 1024 + c0;
            *(f32x4*)pp = (f32x4){v[0], v[1], v[2], v[3]}; *(f32x4*)(pp + 4) = (f32x4){v[4], v[5], v[6], v[7]};
        EPI_LOOP_END
    }
};
struct EpiNull {
    static constexpr bool PERM = true, AFTER_DRAIN = false;
    float* sink;
    __device__ __forceinline__ void operator()(const f32x4 (&acc)[2][2][4][2], const pg8::Unit& u, int wr, int wc, int fr, int fq) const {
        float sacc = 0.f;
        EPI_LOOP_BEGIN
            sacc += v[0] + v[1] + v[2] + v[3] + v[4] + v[5] + v[6] + v[7] + (float)(t + c0) * 1e-30f;
        EPI_LOOP_END
        if (sacc == 1.2345e30f) sink[threadIdx.x] = sacc;
    }
};
struct EpiStore {
    static constexpr bool PERM = true, AFTER_DRAIN = false;
    bf16_t* O; int ldc;
    __device__ __forceinline__ void operator()(const f32x4 (&acc)[2][2][4][2], const pg8::Unit& u, int wr, int wc, int fr, int fq) const {
        EPI_LOOP_BEGIN
            *(u32x4*)(O + (size_t)t * ldc + c0) = pack8(v);
        EPI_LOOP_END
    }
};

template <class Epi> __device__ __forceinline__ void run_gemm(unsigned char* lds, const bf16_t* A, const bf16_t* Bt, int M, int N, int K, const Epi& E) {
    asm volatile("" : "+s"(K), "+s"(M), "+s"(N));
    int gd_ = (int)gridDim.x, bi_ = (int)blockIdx.x; asm volatile("" : "+s"(gd_), "+s"(bi_));
    pg8::Gemm g{A, Bt, M, N, K, K}; pg8::StaticOrder S; S.init(M, N, gd_, bi_);
    pg8::gemm_phase<Epi, pg8::StaticOrder, true, true>((PG8_LAS unsigned char*)lds, g, S, E);
}

struct MainOrder {
    pg8::StaticOrder S;
    __device__ void init(int N, int G_, int c_) { S.init(64 * 256, N, G_, c_); }
    __device__ bool next(int i, pg8::Unit& u) const { if (!S.next(i, u)) return false; u.pm = (u.pm < 32) ? u.pm + 1 : u.pm + 2; return true; }
    __device__ __forceinline__ void a_ready(const pg8::Unit&) const {}
    __device__ __forceinline__ void done(const pg8::Unit&) const {}
};
struct CtxSplitOrder {
    int nN, nsplit, kloop, G, c;
    __device__ bool next(int i, pg8::Unit& u) const {
        const int L = i * G + c; if (L >= 2 * nN * nsplit) return false;
        const int ks = L % nsplit, r = L / nsplit; u.pn = r % nN; u.pm = (r / nN) ? 33 : 0; u.kb = ks * kloop * 2; return true;
    }
    __device__ __forceinline__ void a_ready(const pg8::Unit&) const {}
    __device__ __forceinline__ void done(const pg8::Unit&) const {}
};
template <class Epi> __device__ __forceinline__ void run_gemm_main(unsigned char* lds, const bf16_t* A, const bf16_t* Bt, int N, int K, const Epi& E) {
    asm volatile("" : "+s"(K), "+s"(N));
    int gd_ = (int)gridDim.x, bi_ = (int)blockIdx.x; asm volatile("" : "+s"(gd_), "+s"(bi_));
    pg8::Gemm g{A, Bt, MT, N, K, K}; MainOrder S; S.init(N, gd_, bi_);
    pg8::gemm_phase<Epi, MainOrder, true, true>((PG8_LAS unsigned char*)lds, g, S, E);
}
template <class Epi> __device__ __forceinline__ void run_gemm_ctx(unsigned char* lds, const bf16_t* A, const bf16_t* Bt, int N, int K, int nsplit, const Epi& E, int rot = 0) {
    asm volatile("" : "+s"(K), "+s"(N), "+s"(nsplit));
    int gd_ = (int)gridDim.x, bi_ = (int)blockIdx.x; asm volatile("" : "+s"(gd_), "+s"(bi_));
    bi_ = (bi_ + gd_ - (rot % gd_)) % gd_;
    const int kloop = K / nsplit;
    pg8::Gemm g{A, Bt, MT, N, K, kloop}; CtxSplitOrder S{N / 256, nsplit, kloop, gd_, bi_};
    pg8::gemm_phase<Epi, CtxSplitOrder, true, true>((PG8_LAS unsigned char*)lds, g, S, E);
}

struct NormRow { f32x4 v[4]; float s; };
struct NormPar { const float* src; float* cp; const float* part; const float* gv; const float* sc; const float* sh; bf16_t* orow; int nsl; };
__device__ __forceinline__ void norm_load(NormRow& R, const NormPar& P, int lane) {
    const f32x4* xr = (const f32x4*)P.src + lane; R.s = 0.f;
#pragma unroll
    for (int j = 0; j < 4; ++j) { R.v[j] = xr[64 * j];
        if (P.part) { f32x4 a = (f32x4){0.f, 0.f, 0.f, 0.f};
            for (int q = 0; q < P.nsl; ++q) a = a + ((const f32x4*)(P.part + (size_t)q * 512 * 1024))[64 * j + lane];
            R.v[j] = R.v[j] + ((const f32x4*)P.gv)[64 * j + lane] * a; }
        R.s += (R.v[j][0] * R.v[j][0] + R.v[j][1] * R.v[j][1]) + (R.v[j][2] * R.v[j][2] + R.v[j][3] * R.v[j][3]); }
}
__device__ __forceinline__ void norm_finish(const NormRow& R, const NormPar& P, const float* nw, int lane) {
    if (P.cp) {
#pragma unroll
        for (int j = 0; j < 4; ++j) ((f32x4*)P.cp)[64 * j + lane] = R.v[j];
    }
    const float rstd = rsqrtf(wave_sum(R.s) * (1.f / 1024.f) + EPS);
#pragma unroll
    for (int j = 0; j < 4; ++j) {
        const int idx = 64 * j + lane;
        const f32x4 w = ((const f32x4*)nw)[idx], a = ((const f32x4*)P.sc)[idx], bsh = ((const f32x4*)P.sh)[idx];
        const float y0 = R.v[j][0] * rstd * w[0] * (1.f + a[0]) + bsh[0], y1 = R.v[j][1] * rstd * w[1] * (1.f + a[1]) + bsh[1];
        const float y2 = R.v[j][2] * rstd * w[2] * (1.f + a[2]) + bsh[2], y3 = R.v[j][3] * rstd * w[3] * (1.f + a[3]) + bsh[3];
        u32x2 o; o.x = pk2(y0, y1); o.y = pk2(y2, y3);
        ((u32x2*)P.orow)[idx] = o;
    }
}

#define ATT_THR 4.0f
template <int DQK, bool MASK, int NQ>
__device__ __forceinline__ void attn_unit(unsigned char* lds, const bf16_t* Qg, int ldq, const bf16_t* Kg, int ldk, const bf16_t* Vtg, bf16_t* Og, int ldo,
                                          int qi0, int a0, int n1, int b0, int n2, float m0, bool sink) {
    constexpr int KP = DQK + 8, KBYTES = 64 * KP * 2, VP = 72, VBYTES = 64 * VP * 2, NC = DQK / 32, KCH = DQK / 8, WR = 16 * NQ;
    constexpr int KOFF = 0, VOFF = 2 * KBYTES;
    int tid_ = threadIdx.x; asm volatile("" : "+v"(tid_));
    const int tid = tid_, lane = tid & 63, wid = tid >> 6, ql = lane & 15, g = lane >> 4;
    const int qw0 = qi0 + wid * WR;
    bf16x8 qf[NQ][NC];
#pragma unroll
    for (int qb = 0; qb < NQ; ++qb)
#pragma unroll
        for (int c = 0; c < NC; ++c) qf[qb][c] = *(const bf16x8*)(Qg + (size_t)(qw0 + qb * 16 + ql) * ldq + c * 32 + g * 8);
    f32x4 o[4][NQ];
#pragma unroll
    for (int eb = 0; eb < 4; ++eb)
#pragma unroll
        for (int qb = 0; qb < NQ; ++qb) o[eb][qb] = (f32x4){0.f, 0.f, 0.f, 0.f};
    float mrow[NQ]; f32x4 negm[NQ], ol[NQ];
#pragma unroll
    for (int qb = 0; qb < NQ; ++qb) { mrow[qb] = sink ? m0 : 0.f; const float l0 = sink ? 1.f : 0.f; ol[qb] = (f32x4){l0, l0, l0, l0}; negm[qb] = (f32x4){-mrow[qb], -mrow[qb], -mrow[qb], -mrow[qb]}; }
    const bf16x8 ones = (bf16x8){0x3F80, 0x3F80, 0x3F80, 0x3F80, 0x3F80, 0x3F80, 0x3F80, 0x3F80};
    bool first = !sink;
    int nt = n1 + n2; asm volatile("" : "+s"(nt));
    const int kr0 = tid / KCH, kc0 = tid - kr0 * KCH;
    const int ci1 = tid + 512, kr1 = ci1 / KCH, kc1 = ci1 - kr1 * KCH;
    const bool has1 = (KCH * 64 > 512) && (ci1 < KCH * 64);
    const int ve = tid >> 3, vc = tid & 7;
    const int mA_ = 2 * vc, mB_ = 2 * vc + 1;
    const int voffA = ((mA_ >> 3) * 4 + (mA_ & 3)) * 16 + ((mA_ & 7) >> 2) * 8, voffB = ((mB_ >> 3) * 4 + (mB_ & 3)) * 16 + ((mB_ & 7) >> 2) * 8;
    u32x4 kreg0, kreg1 = (u32x4){0u, 0u, 0u, 0u}, vreg;
#define ATT_TILE(tt) (((tt) < n1) ? (a0 + (tt)) : (b0 + (tt) - n1))
#define ATT_SKIP(kt) (MASK && ((kt) >= 4) && (((kt) * 64 > qw0 + (WR - 1) + 128) || ((kt) * 64 + 63 < qw0 - 128)))
#define ATT_ISSUE(kt) do { kreg0 = *(const u32x4*)(Kg + (size_t)((kt) * 64 + kr0) * ldk + kc0 * 8); \
        if (has1) kreg1 = *(const u32x4*)(Kg + (size_t)((kt) * 64 + kr1) * ldk + kc1 * 8); \
        vreg = *(const u32x4*)(Vtg + (size_t)ve * TB + (kt) * 64 + vc * 8); } while (0)
#define ATT_COMMIT(buf) do { unsigned char* kb_ = lds + KOFF + (buf) * KBYTES; *(u32x4*)(kb_ + kr0 * (KP * 2) + kc0 * 16) = kreg0; \
        if (has1) *(u32x4*)(kb_ + kr1 * (KP * 2) + kc1 * 16) = kreg1; \
        { unsigned char* vrow_ = lds + VOFF + (buf) * VBYTES + ve * (VP * 2); \
          *(u32x2*)(vrow_ + voffA) = (u32x2){vreg.x, vreg.y}; *(u32x2*)(vrow_ + voffB) = (u32x2){vreg.z, vreg.w}; } } while (0)
    { const int kt0 = ATT_TILE(0); ATT_ISSUE(kt0); ATT_COMMIT(0); }
    __syncthreads();
#pragma unroll 1
    for (int tt = 0; tt < nt; ++tt) {
        const int kt = ATT_TILE(tt);
        if (tt + 1 < nt) { const int ktn = ATT_TILE(tt + 1); ATT_ISSUE(ktn); }
        if (!ATT_SKIP(kt)) {
#pragma unroll 1
          for (int hb = 0; hb < 2; ++hb) {
            f32x4 sc[2][NQ];
            { const unsigned char* kb_ = lds + KOFF + (tt & 1) * KBYTES + hb * (32 * KP * 2);
              __builtin_amdgcn_s_setprio(1);
#pragma unroll
              for (int k2 = 0; k2 < 2; ++k2) {
#pragma unroll
                  for (int c = 0; c < NC; ++c) {
                      const bf16x8 kf = *(const bf16x8*)(kb_ + (k2 * 16 + ql) * (KP * 2) + (c * 32 + g * 8) * 2);
#pragma unroll
                      for (int qb = 0; qb < NQ; ++qb) sc[k2][qb] = __builtin_amdgcn_mfma_f32_16x16x32_bf16(kf, qf[qb][c], c == 0 ? negm[qb] : sc[k2][qb], 0, 0, 0);
                  } }
              __builtin_amdgcn_s_setprio(0); }
            if (MASK) { if (kt >= 4) { int dl = kt * 64 + hb * 32 + g * 4 - qw0 - ql; asm volatile("" : "+v"(dl));
#pragma unroll
                for (int k2 = 0; k2 < 2; ++k2)
#pragma unroll
                    for (int qb = 0; qb < NQ; ++qb)
#pragma unroll
                        for (int j = 0; j < 4; ++j) { const int d = dl + (k2 * 16 + j - qb * 16); if (d > 128 || d < -128) sc[k2][qb][j] = -1e30f; } } }
            float am = fmaxf(fmaxf(sc[0][0][0], sc[0][0][1]), sc[0][0][2]); am = fmaxf(fmaxf(am, sc[0][0][3]), sc[1][0][0]); am = fmaxf(fmaxf(am, sc[1][0][1]), sc[1][0][2]); am = fmaxf(am, sc[1][0][3]);
#pragma unroll
            for (int qb = 1; qb < NQ; ++qb) { am = fmaxf(fmaxf(am, sc[0][qb][0]), sc[0][qb][1]); am = fmaxf(fmaxf(am, sc[0][qb][2]), sc[0][qb][3]);
                am = fmaxf(fmaxf(am, sc[1][qb][0]), sc[1][qb][1]); am = fmaxf(fmaxf(am, sc[1][qb][2]), sc[1][qb][3]); }
            if (__any(first || (am > ATT_THR))) {
#pragma unroll
                for (int qb = 0; qb < NQ; ++qb) {
                    float a = fmaxf(fmaxf(sc[0][qb][0], sc[0][qb][1]), sc[0][qb][2]);
                    a = fmaxf(fmaxf(a, sc[0][qb][3]), sc[1][qb][0]); a = fmaxf(fmaxf(a, sc[1][qb][1]), sc[1][qb][2]); a = fmaxf(a, sc[1][qb][3]);
                    { auto r16 = __builtin_amdgcn_permlane16_swap(__float_as_uint(a), __float_as_uint(a), false, false); a = fmaxf(__uint_as_float(r16[0]), __uint_as_float(r16[1])); }
                    { auto r32 = __builtin_amdgcn_permlane32_swap(__float_as_uint(a), __float_as_uint(a), false, false); a = fmaxf(__uint_as_float(r32[0]), __uint_as_float(r32[1])); }
                    const float dlt = first ? a : fmaxf(a, 0.f);
                    mrow[qb] += dlt; negm[qb] = (f32x4){-mrow[qb], -mrow[qb], -mrow[qb], -mrow[qb]};
                    sc[0][qb] = sc[0][qb] - dlt; sc[1][qb] = sc[1][qb] - dlt;
                    if (!first) { const float alpha = __builtin_amdgcn_exp2f(-dlt); ol[qb] = ol[qb] * alpha;
#pragma unroll
                        for (int eb = 0; eb < 4; ++eb) o[eb][qb] = o[eb][qb] * alpha; } }
                first = false; }
            bf16x8 pf[NQ];
#pragma unroll
            for (int qb = 0; qb < NQ; ++qb) {
#pragma unroll
                for (int k2 = 0; k2 < 2; ++k2)
#pragma unroll
                    for (int j = 0; j < 4; ++j) sc[k2][qb][j] = __builtin_amdgcn_exp2f(sc[k2][qb][j]);
                u32x4 w; w.x = pk2(sc[0][qb][0], sc[0][qb][1]); w.y = pk2(sc[0][qb][2], sc[0][qb][3]); w.z = pk2(sc[1][qb][0], sc[1][qb][1]); w.w = pk2(sc[1][qb][2], sc[1][qb][3]);
                pf[qb] = __builtin_bit_cast(bf16x8, w); }
            { const unsigned char* vb_ = lds + VOFF + (tt & 1) * VBYTES + (hb * 4 + g) * 16;
#pragma unroll
              for (int eb = 0; eb < 4; ++eb) {
                  const bf16x8 vf = *(const bf16x8*)(vb_ + (eb * 16 + ql) * (VP * 2));
#pragma unroll
                  for (int qb = 0; qb < NQ; ++qb) o[eb][qb] = __builtin_amdgcn_mfma_f32_16x16x32_bf16(vf, pf[qb], o[eb][qb], 0, 0, 0);
              }
#pragma unroll
              for (int qb = 0; qb < NQ; ++qb) ol[qb] = __builtin_amdgcn_mfma_f32_16x16x32_bf16(ones, pf[qb], ol[qb], 0, 0, 0); }
          }
        }
        if (tt + 1 < nt) ATT_COMMIT((tt + 1) & 1);
        __syncthreads();
    }
#undef ATT_TILE
#undef ATT_SKIP
#undef ATT_ISSUE
#undef ATT_COMMIT
#pragma unroll
    for (int qb = 0; qb < NQ; ++qb) {
        const float inv = 1.f / ol[qb][0];
        bf16_t* op = Og + (size_t)(qw0 + qb * 16 + ql) * ldo + g * 4;
        if (Og)
#pragma unroll
        for (int eb = 0; eb < 4; ++eb) { u32x2 w; w.x = pk2(o[eb][qb][0] * inv, o[eb][qb][1] * inv); w.y = pk2(o[eb][qb][2] * inv, o[eb][qb][3] * inv); *(u32x2*)(op + eb * 16) = w; }
    }
}

constexpr int GL_BS = 0;
constexpr int GL_TOT = GL_BS + 64 * 65 * 4;
constexpr int GL_QE = GL_TOT + 8 * 64 * 4;
constexpr int GL_KE = GL_QE + 64 * 72 * 2;
constexpr int GL_ATT = GL_KE + 64 * 72 * 2;
constexpr int GL_VT = GL_ATT + 64 * 72 * 2;
constexpr int GL_O = GL_VT + 128 * 72 * 2;
constexpr int GL_END = GL_O + 64 * 132 * 4;
static_assert(GL_END <= 131072 && (GL_QE % 16) == 0 && (GL_VT % 16) == 0 && (GL_O % 16) == 0, "GLA LDS map");

__device__ __forceinline__ void gla_decay(unsigned char* lds, const float* glow_t0, const float* Wg  , const float* bg  , int dir) {
    float* Bs = (float*)(lds + GL_BS); float* Tot = (float*)(lds + GL_TOT); float* GLs = (float*)(lds + GL_O);
    int tid_ = threadIdx.x; asm volatile("" : "+v"(tid_)); const int tid = tid_;
    { const int s = tid >> 3, q = tid & 7;
      const float* gp = glow_t0 + (size_t)s * 32 + dir * 16 + q * 2;
      GLs[s * 16 + q * 2] = gp[0]; GLs[s * 16 + q * 2 + 1] = gp[1]; }
    const int d = tid & 63, seg = tid >> 6;
    float w[16];
#pragma unroll
    for (int r = 0; r < 16; ++r) w[r] = Wg[r * 256 + d];
    const float bias = bg[d];
    __syncthreads();
    float loc[8];
#pragma unroll
    for (int k = 0; k < 8; ++k) { const float* gl = GLs + (seg * 8 + k) * 16; float a = bias;
#pragma unroll
        for (int r = 0; r < 16; ++r) a += gl[r] * w[r];
        loc[k] = (fminf(a, 0.f) - __logf(1.f + __expf(-fabsf(a)))) * (1.f / 16.f); }
    float run = 0.f;
    if (dir == 0) {
#pragma unroll
        for (int k = 0; k < 8; ++k) { run += loc[k]; loc[k] = run; }
    } else {
#pragma unroll
        for (int k = 7; k >= 0; --k) { run += loc[k]; loc[k] = run; }
    }
    Tot[seg * 64 + d] = run;
    __syncthreads();
    float off = 0.f;
#pragma unroll
    for (int sg = 0; sg < 8; ++sg) { const float tv = Tot[sg * 64 + d]; if (dir == 0 ? (sg < seg) : (sg > seg)) off += tv; }
#pragma unroll
    for (int k = 0; k < 8; ++k) Bs[(seg * 8 + k) * 65 + d] = loc[k] + off;
    __syncthreads();
}
__device__ __forceinline__ void gla_load_vt(unsigned char* lds, const bf16_t* cv_t0  ) {
    bf16_t* Vt = (bf16_t*)(lds + GL_VT);
    int tid_ = threadIdx.x; asm volatile("" : "+v"(tid_)); const int tid = tid_;
#pragma unroll
    for (int r = 0; r < 2; ++r) { const int ci = tid + 512 * r, s = ci & 63, eg = ci >> 6;
        const u32x4 w = *(const u32x4*)(cv_t0 + (size_t)s * 512 + eg * 8);
        bf16_t* dst = Vt + (eg * 8) * 72 + s;
        dst[0 * 72] = (bf16_t)(w.x & 0xffffu); dst[1 * 72] = (bf16_t)(w.x >> 16); dst[2 * 72] = (bf16_t)(w.y & 0xffffu); dst[3 * 72] = (bf16_t)(w.y >> 16);
        dst[4 * 72] = (bf16_t)(w.z & 0xffffu); dst[5 * 72] = (bf16_t)(w.z >> 16); dst[6 * 72] = (bf16_t)(w.w & 0xffffu); dst[7 * 72] = (bf16_t)(w.w >> 16); }
}
__device__ __forceinline__ int gla_ord(int dir, int k) { return dir == 0 ? k : (k < 4 ? 3 - k : 135 - k); }

__device__ __forceinline__ void gla_state_item(unsigned char* lds, unsigned char* ws, const float* wgate, const float* bgate, int l, int item) {
    const int c = item % 132, dir = (item / 132) & 1, h = (item / 264) & 3, b = item / 1056;
    const int t0 = b * TB + c * 64;
    int tid_ = threadIdx.x; asm volatile("" : "+v"(tid_));
    const int tid = tid_, lane = tid & 63, wid = tid >> 6, ql = lane & 15, g = lane >> 4;
    const u32x4 kraw = *(const u32x4*)((const bf16_t*)(ws + O_CK) + (size_t)(t0 + (tid & 63)) * 256 + h * 64 + (tid >> 6) * 8);
    gla_load_vt(lds, (const bf16_t*)(ws + O_CV) + (size_t)t0 * 512 + h * 128);
    gla_decay(lds, (const float*)(ws + O_GLOW) + (size_t)t0 * 32, wgate + (size_t)((l * 2 + dir) * 16) * 256 + h * 64, bgate + (l * 2 + dir) * 256 + h * 64, dir);
    const float* Bs = (const float*)(lds + GL_BS); bf16_t* KDt = (bf16_t*)(lds + GL_KE);
    const int iend = dir == 0 ? 63 : 0;
    { const int s = tid & 63, dg = tid >> 6;
      float kv[8]; unpack8(kraw, kv);
#pragma unroll
      for (int e = 0; e < 8; ++e) { const int d = dg * 8 + e; KDt[d * 72 + s] = (bf16_t)f2bf(kv[e] * __expf(Bs[iend * 65 + d] - Bs[s * 65 + d])); } }
    if (tid < 64) ((float*)(ws + O_GD))[(size_t)item * 64 + tid] = __expf(Bs[iend * 65 + tid]);
    __syncthreads();
    const bf16_t* Vt = (const bf16_t*)(lds + GL_VT);
    f32x4 acc[4];
#pragma unroll
    for (int cb = 0; cb < 4; ++cb) acc[cb] = (f32x4){0.f, 0.f, 0.f, 0.f};
#pragma unroll
    for (int kk = 0; kk < 2; ++kk) {
        const bf16x8 a = *(const bf16x8*)(Vt + (wid * 16 + ql) * 72 + kk * 32 + g * 8);
#pragma unroll
        for (int cb = 0; cb < 4; ++cb) { const bf16x8 bb = *(const bf16x8*)(KDt + (cb * 16 + ql) * 72 + kk * 32 + g * 8); acc[cb] = __builtin_amdgcn_mfma_f32_16x16x32_bf16(a, bb, acc[cb], 0, 0, 0); }
    }
    bf16_t* st = (bf16_t*)(ws + O_ST) + (size_t)item * 8192;
#pragma unroll
    for (int cb = 0; cb < 4; ++cb)
#pragma unroll
        for (int j = 0; j < 4; ++j) st[(wid * 16 + g * 4 + j) * 64 + cb * 16 + ql] = (bf16_t)f2bf(acc[cb][j]);
    __syncthreads();
}

__device__ __forceinline__ void gla_scan(unsigned char* ws, int bid, int tid, int G) {
    bf16_t* ST = (bf16_t*)(ws + O_ST); const float* GD = (const float*)(ws + O_GD);
    for (int gidx = bid * NTHR + tid; gidx < 16 * 8192; gidx += G * NTHR) {
        const int seq = gidx >> 13, idx = gidx & 8191, d = idx & 63, dir = seq & 1;
        float s = 0.f;
        for (int k0 = 0; k0 < 132; k0 += 33) {
            float uv[33], dv[33];
#pragma unroll
            for (int u = 0; u < 33; ++u) { const int c = gla_ord(dir, k0 + u); uv[u] = bf2f(ST[(size_t)(seq * 132 + c) * 8192 + idx]); dv[u] = GD[(size_t)(seq * 132 + c) * 64 + d]; }
#pragma unroll
            for (int u = 0; u < 33; ++u) { const int c = gla_ord(dir, k0 + u); ST[(size_t)(seq * 132 + c) * 8192 + idx] = (bf16_t)f2bf(s); s = dv[u] * s + uv[u]; }
        }
    }
}

__device__ __forceinline__ void gla_out_item(unsigned char* lds, unsigned char* ws, const float* wgate, const float* bgate, const float* hnorm, int l, int item, bool dowrite = true) {
    const int c = item % 132, h = (item / 132) & 3, b = item / 528;
    const int t0 = b * TB + c * 64;
    int tid_ = threadIdx.x; asm volatile("" : "+v"(tid_));
    const int tid = tid_, lane = tid & 63, wid = tid >> 6, ql = lane & 15, g = lane >> 4;
    const float* Bs = (const float*)(lds + GL_BS);
    bf16_t* QE = (bf16_t*)(lds + GL_QE); bf16_t* KE = (bf16_t*)(lds + GL_KE); bf16_t* ATT = (bf16_t*)(lds + GL_ATT); const bf16_t* Vt = (const bf16_t*)(lds + GL_VT);
    const u32x4 qraw = *(const u32x4*)((const bf16_t*)(ws + O_CQ) + (size_t)(t0 + (tid >> 3)) * 256 + h * 64 + (tid & 7) * 8);
    const u32x4 kraw = *(const u32x4*)((const bf16_t*)(ws + O_CK) + (size_t)(t0 + (tid >> 3)) * 256 + h * 64 + (tid & 7) * 8);
    bf16x8 sfr[2][2];
#pragma unroll
    for (int dd = 0; dd < 2; ++dd)
#pragma unroll
        for (int kk = 0; kk < 2; ++kk) sfr[dd][kk] = *(const bf16x8*)((const bf16_t*)(ws + O_ST) + (size_t)(((b * 4 + h) * 2 + dd) * 132 + c) * 8192 + (wid * 16 + ql) * 64 + kk * 32 + g * 8);
    const u32x4 rraw0 = *(const u32x4*)((const bf16_t*)(ws + O_CR) + (size_t)(t0 + (tid >> 3)) * 512 + h * 128 + (tid & 7) * 16);
    const u32x4 rraw1 = *(const u32x4*)((const bf16_t*)(ws + O_CR) + (size_t)(t0 + (tid >> 3)) * 512 + h * 128 + (tid & 7) * 16 + 8);
    gla_load_vt(lds, (const bf16_t*)(ws + O_CV) + (size_t)t0 * 512 + h * 128);
    f32x4 oacc[4];
#pragma unroll
    for (int rb = 0; rb < 4; ++rb) oacc[rb] = (f32x4){0.f, 0.f, 0.f, 0.f};
    for (int dir = 0; dir < 2; ++dir) {
        gla_decay(lds, (const float*)(ws + O_GLOW) + (size_t)t0 * 32, wgate + (size_t)((l * 2 + dir) * 16) * 256 + h * 64, bgate + (l * 2 + dir) * 256 + h * 64, dir);
        { const int s = tid >> 3, dg = tid & 7;
          float qv[8], kv[8];
          unpack8(qraw, qv);
          unpack8(kraw, kv);
#pragma unroll
          for (int e = 0; e < 8; ++e) { const float bv = Bs[s * 65 + dg * 8 + e]; qv[e] *= __expf(bv); kv[e] *= __expf(-bv); }
          *(u32x4*)(QE + s * 72 + dg * 8) = pack8(qv); *(u32x4*)(KE + s * 72 + dg * 8) = pack8(kv); }
        __syncthreads();
        { const int rb = wid >> 1;
#pragma unroll
          for (int cc = 0; cc < 2; ++cc) { const int cb = (wid & 1) * 2 + cc; f32x4 a4 = (f32x4){0.f, 0.f, 0.f, 0.f};
#pragma unroll
              for (int kk = 0; kk < 2; ++kk) { const bf16x8 a = *(const bf16x8*)(QE + (rb * 16 + ql) * 72 + kk * 32 + g * 8); const bf16x8 bb = *(const bf16x8*)(KE + (cb * 16 + ql) * 72 + kk * 32 + g * 8);
                  a4 = __builtin_amdgcn_mfma_f32_16x16x32_bf16(a, bb, a4, 0, 0, 0); }
#pragma unroll
              for (int j = 0; j < 4; ++j) { const int i = rb * 16 + g * 4 + j, ip = cb * 16 + ql; const bool keep = dir == 0 ? (ip <= i) : (ip >= i); ATT[i * 72 + ip] = (bf16_t)f2bf(keep ? a4[j] : 0.f); } } }
        __syncthreads();
        { const int sidx = ((b * 4 + h) * 2 + dir) * 132 + c;
          const bf16_t* st = (const bf16_t*)(ws + O_ST) + (size_t)sidx * 8192;
#pragma unroll
          for (int kk = 0; kk < 2; ++kk) {
              const bf16x8 bv = *(const bf16x8*)(Vt + (wid * 16 + ql) * 72 + kk * 32 + g * 8);
              const bf16x8 bs = dir == 0 ? sfr[0][kk] : sfr[1][kk];
#pragma unroll
              for (int rb = 0; rb < 4; ++rb) {
                  const bf16x8 a1 = *(const bf16x8*)(ATT + (rb * 16 + ql) * 72 + kk * 32 + g * 8);
                  const bf16x8 a2 = *(const bf16x8*)(QE + (rb * 16 + ql) * 72 + kk * 32 + g * 8);
                  oacc[rb] = __builtin_amdgcn_mfma_f32_16x16x32_bf16(a1, bv, oacc[rb], 0, 0, 0);
                  oacc[rb] = __builtin_amdgcn_mfma_f32_16x16x32_bf16(a2, bs, oacc[rb], 0, 0, 0);
              } } }
        __syncthreads();
    }
    float* Os = (float*)(lds + GL_O);
#pragma unroll
    for (int rb = 0; rb < 4; ++rb)
#pragma unroll
        for (int j = 0; j < 4; ++j) Os[(rb * 16 + g * 4 + j) * 132 + wid * 16 + ql] = oacc[rb][j];
    __syncthreads();
    { const int i = tid >> 3, eg = tid & 7;
      float ov[16]; float ss = 0.f;
#pragma unroll
      for (int e = 0; e < 16; ++e) { ov[e] = Os[i * 132 + eg * 16 + e]; ss += ov[e] * ov[e]; }
      ss += __shfl_xor(ss, 1); ss += __shfl_xor(ss, 2); ss += __shfl_xor(ss, 4);
      const float rstd = rsqrtf(ss * (1.f / 128.f) + EPS);
      const float* gn = hnorm + l * 512 + h * 128 + eg * 16;
      bf16_t* rp = (bf16_t*)(ws + O_CR) + (size_t)(t0 + i) * 512 + h * 128 + eg * 16;
#pragma unroll
      for (int hh = 0; hh < 2; ++hh) { float rv[8]; unpack8(hh == 0 ? rraw0 : rraw1, rv);
#pragma unroll
          for (int e = 0; e < 8; ++e) rv[e] = ov[hh * 8 + e] * rstd * gn[hh * 8 + e] * siluf_(rv[e]);
          if (dowrite) *(u32x4*)(rp + hh * 8) = pack8(rv); } }
    __syncthreads();
}

#ifndef REPK
#define REPK 0
#endif
#ifndef REP_SYNC
#define REP_SYNC 0
#endif
#ifndef ASEL
#define ASEL 31
#endif
#ifndef PM
#define PM 0xffff
#endif
#define ON(k) (((PM) >> (k)) & 1)
typedef const __attribute__((address_space(4))) Args* CArgsP;
__global__ void __launch_bounds__(NTHR, 2) mk_fwd(Args args) {
    extern __shared__ __attribute__((aligned(16))) unsigned char lds[];
    cg::grid_group grid = cg::this_grid();
    volatile LASX unsigned* misc = (volatile LASX unsigned*)((LASX unsigned char*)lds + 131072 + 512);
    if (threadIdx.x < 16) misc[threadIdx.x] = 0u;
    __syncthreads();
    XcdBarrier xbar = xcd_barrier_post((unsigned*)(args.ws + O_BAR), misc + 8);
    if (args.ph_hi < 0) grid.sync();
    int rep = 0;
    for (int ph = args.ph_lo; ph < args.ph_hi; ) {
        int tid_k = threadIdx.x; asm volatile("" : "+v"(tid_k));
        const int tid = tid_k, lane = tid & 63, wid = __builtin_amdgcn_readfirstlane(tid >> 6);
        int G_k = gridDim.x, bid_k = blockIdx.x; asm volatile("" : "+s"(G_k), "+s"(bid_k));
        const int G = G_k, bid = bid_k, gw = bid * NWAVES + wid, NGW = G * NWAVES;
        CArgsP ap = (CArgsP)__builtin_amdgcn_kernarg_segment_ptr(); asm volatile("" : "+s"(ap));
        unsigned char* ws = ap->ws;
        float* MOD = (float*)(ws + O_MOD); float* X = (float*)(ws + O_X); bf16_t* HM = (bf16_t*)(ws + O_HM);
        if (ON(11) && ph == 0) {
            float* sv = (float*)lds; float* red = sv + 3072;
            for (int item = bid; item < 4 * 48; item += G) {
                const int l = item / 48, n0 = (item % 48) * 128;
                for (int idx = tid; idx < 3072; idx += NTHR) { const int r = idx >> 10, k = idx & 1023; const float cv = (r < 2) ? ap->in[I_C][r * 1024 + k] : ap->in[I_CCTX][k]; sv[idx] = siluf_(cv); }
                __syncthreads();
                const int kq = tid >> 7, nn = tid & 127; float a0 = 0.f, a1 = 0.f, a2 = 0.f;
                const float* wp = ap->in[I_WMOD] + ((size_t)l * 1024 + kq * 256) * 6144 + n0 + nn;
#pragma unroll 32
                for (int k = 0; k < 256; ++k) { const float w = wp[(size_t)k * 6144]; a0 += sv[kq * 256 + k] * w; a1 += sv[1024 + kq * 256 + k] * w; a2 += sv[2048 + kq * 256 + k] * w; }
                red[(kq * 3 + 0) * 128 + nn] = a0; red[(kq * 3 + 1) * 128 + nn] = a1; red[(kq * 3 + 2) * 128 + nn] = a2;
                __syncthreads();
                if (tid < 384) { const int r = tid >> 7, n2 = tid & 127; float a = ap->in[I_BMOD][l * 6144 + n0 + n2];
                    for (int q = 0; q < 4; ++q) a += red[(q * 3 + r) * 128 + n2];
                    MOD[(l * 3 + r) * 6144 + n0 + n2] = a; }
                __syncthreads();
            }
            float* RA = (float*)(ws + O_ROPEA); float* RB = (float*)(ws + O_ROPEB);
            for (int idx = bid * NTHR + tid; idx < 8192 * 32; idx += G * NTHR) { const int pos = idx >> 5, j = idx & 31;
                const float inv = exp2f(-(float)(j & 15) * (13.287712379549449f / 16.f)); const float p = (j < 16) ? (float)(pos >> 6) : (float)(pos & 63); const float ang = p * inv;
                RA[pos * 64 + j] = __cosf(ang); RA[pos * 64 + 32 + j] = __sinf(ang); }
            for (int idx = bid * NTHR + tid; idx < 8192 * 16; idx += G * NTHR) { const int pos = idx >> 4, j = idx & 15;
                const float inv = exp2f(-(float)(j & 7) * (13.287712379549449f / 8.f)); const float p = (j < 8) ? (float)(pos >> 6) : (float)(pos & 63); const float ang = p * inv;
                RB[pos * 32 + j] = __cosf(ang); RB[pos * 32 + 16 + j] = __sinf(ang); }
        } else if (ON(12) && ph == 45) {
            for (int r = gw; r < NB * SEQ; r += NGW) { const int b = r >> 13, s = r & 8191;
                const f32x4* xr = (const f32x4*)(X + (size_t)(b * TB + LC + s) * 1024) + lane; f32x4 v[4]; float ss = 0.f;
#pragma unroll
                for (int j = 0; j < 4; ++j) { v[j] = xr[64 * j]; ss += (v[j][0] * v[j][0] + v[j][1] * v[j][1]) + (v[j][2] * v[j][2] + v[j][3] * v[j][3]); }
                const float rstd = rsqrtf(wave_sum(ss) * (1.f / 1024.f) + EPS);
#pragma unroll
                for (int j = 0; j < 4; ++j) { const f32x4 w = ((const f32x4*)ap->in[I_FNORM])[64 * j + lane]; f32x4 o; o[0] = v[j][0] * rstd * w[0]; o[1] = v[j][1] * rstd * w[1]; o[2] = v[j][2] * rstd * w[2]; o[3] = v[j][3] * rstd * w[3];
                    ((f32x4*)(ap->out + (size_t)r * 1024))[64 * j + lane] = o; } }
        } else {
            const int l = (ph - 1) / 11, k = (ph - 1) % 11;
            const float* modl = MOD + l * 3 * 6144;
            if (ON(0) && k == 0) {
                float* scr = (float*)lds + wid * (64 * 33);
                constexpr int I0 = 184 * 16, I1 = I0 + 24 * 4, I2 = I1 + 32 * 4, I3 = I2 + 3 * 32 * 8, I4 = I3 + 32 * 16, I5 = I4 + 176 * 16, I6 = I5 + 32 * 44;
                for (int it = gw; it < I6; it += NGW) {
                    if (it < I0) transpose_item(ap->in[I_WIN] + (size_t)l * 1024 * IN_DIM, 1024, IN_DIM, (bf16_t*)(ws + O_WIN), 1024, it, MAT_IN, nullptr, scr, lane);
                    else if (it < I1) transpose_item(ap->in[I_WUQ] + (size_t)l * 256 * 768, 256, 768, (bf16_t*)(ws + O_WUQ), 256, it - I0, MAT_UQ, ap->in[I_QNORM] + l * 256, scr, lane);
                    else if (it < I2) transpose_item(ap->in[I_WUKV] + (size_t)l * 128 * 1024, 128, 1024, (bf16_t*)(ws + O_WUKV), 256, it - I1, MAT_PLAIN, ap->in[I_KVNORM] + l * 128, scr, lane);
                    else if (it < I3) { const int r = it - I2, br = r / 256; const float* src = (br == 0 ? ap->in[I_WBRA] : (br == 1 ? ap->in[I_WBRB] : ap->in[I_WBRC])) + (size_t)l * 512 * 1024;
                        transpose_item(src, 512, 1024, (bf16_t*)(ws + O_WBR) + (size_t)br * 1024 * 512, 512, r - br * 256, MAT_PLAIN, nullptr, scr, lane); }
                    else if (it < I4) transpose_item(ap->in[I_WOUT] + (size_t)l * 1024 * 1024, 1024, 1024, (bf16_t*)(ws + O_WOUT), 1024, it - I3, MAT_PLAIN, nullptr, scr, lane);
                    else if (it < I5) transpose_item(ap->in[I_WUP] + (size_t)l * 1024 * FF2, 1024, FF2, (bf16_t*)(ws + O_WUP), 1024, it - I4, MAT_PLAIN, nullptr, scr, lane);
                    else transpose_item(ap->in[I_WDOWN] + (size_t)l * FF * 1024, FF, 1024, (bf16_t*)(ws + O_WDOWN), FF, it - I5, MAT_PLAIN, nullptr, scr, lane);
                }
                for (int idx = bid * NTHR + tid; idx < MT * 2; idx += G * NTHR) ((float*)(ws + O_SSQ))[idx] = 0.f;
#define NORM1_PAR(P, t) do { const int b = ((t) >= TB) ? 1 : 0, i = (t) - b * TB, r = (i >= LC) ? b : 2; \
                    P.src = X + (size_t)(t) * 1024; P.cp = nullptr; P.part = nullptr; P.gv = nullptr; P.nsl = 11; \
                    if (l == 0) { P.src = (i >= LC) ? ap->in[I_X] + ((size_t)b * SEQ + (i - LC)) * 1024 : ap->in[I_CTX] + ((size_t)b * LC + i) * 1024; P.cp = X + (size_t)(t) * 1024; } \
                    if (l > 0 && i < LC) { P.part = (const float*)(ws + O_U) + (size_t)(b * 256 + i) * 1024; P.gv = MOD + ((l - 1) * 3 + 2) * 6144 + 5120; P.cp = X + (size_t)(t) * 1024; } \
                    P.sc = modl + r * 6144 + 1024; P.sh = modl + r * 6144; P.orow = HM + (size_t)(t) * 1024; } while (0)
                for (int t = gw; t < MT; t += 2 * NGW) {
                    const int tB = t + NGW; const bool hb = tB < MT;
                    const int tBc = hb ? tB : t;
                    NormPar PA, PB; NormRow RA, RB; NORM1_PAR(PA, t); NORM1_PAR(PB, tBc);
                    norm_load(RA, PA, lane); norm_load(RB, PB, lane);
                    norm_finish(RA, PA, ap->in[I_NMIX] + l * 1024, lane); if (hb) norm_finish(RB, PB, ap->in[I_NMIX] + l * 1024, lane);
                }
#undef NORM1_PAR
            } else if (ON(1) && k == 1) {
                EpiIn E{ws}; run_gemm(lds, HM, (const bf16_t*)(ws + O_WIN), MT, NPIN, 1024, E);
            } else if (ON(2) && k == 2) {
                if (ON(13)) { EpiUq E{ws}; run_gemm(lds, (const bf16_t*)(ws + O_CQB), (const bf16_t*)(ws + O_WUQ), MT, 768, 256, E); }
                if (ON(14)) { EpiUkv E{ws}; run_gemm(lds, (const bf16_t*)(ws + O_CKVB), (const bf16_t*)(ws + O_WUKV), MT, 1024, 256, E); }
                if (ON(15)) for (int item = bid; item < 2112; item += G) gla_state_item(lds, ws, ap->in[I_WGATE], ap->in[I_BGATE], l, item);
            } else if (ON(3) && k == 3) {
                if ((ASEL & 16) && rep == 0) gla_scan(ws, bid, tid, G);
                for (int L = bid; L < (rep == 0 ? 544 : 256); L += G) {
                    const int npass = (PROBE_AA && L >= 256 && L < 768) ? 2 : 1;
                    for (int pass = 0; pass < npass; ++pass) {
                    if ((ASEL & 1) && L < 256) { const int bh_ = (L & 7) + 8 * ((L >> 3) & 1), b = bh_ >> 3, h = bh_ & 7, qs = L >> 4;
                        attn_unit<96, false, 4>(lds, (const bf16_t*)(ws + O_QB) + (size_t)b * TB * 768 + h * 96, 768, (const bf16_t*)(ws + O_KB) + (size_t)b * TB * 768 + h * 96, 768,
                                             (const bf16_t*)(ws + O_VBT) + (size_t)(b * 8 + h) * 64 * TB, (bf16_t*)(ws + O_YB) + (size_t)b * TB * 512 + h * 64, 512, LC + qs * 512, 0, 132, 0, 0, 0.f, false);
                    } else if ((ASEL & 2) && L >= 256 && L < 512) { const int L2 = L - 256, bh_ = (L2 & 7) + 8 * ((L2 >> 3) & 1), b = bh_ >> 3, h = bh_ & 7, qs = L2 >> 4, kvh = h >> 2;
                        const int p0 = qs * 512, lo = (p0 - 128 < 0) ? 0 : p0 - 128, hi = (p0 + 640 > SEQ) ? SEQ : p0 + 640;
                        bf16_t* qo = (bf16_t*)(ws + O_QA) + (size_t)b * TB * 512 + h * 64;
                        attn_unit<64, true, 4>(lds, qo, 512, (const bf16_t*)(ws + O_KA) + (size_t)b * TB * 128 + kvh * 64, 128, (const bf16_t*)(ws + O_VAT) + (size_t)(b * 2 + kvh) * 64 * TB,
                                            qo, 512, LC + p0, 0, 4, (lo + LC) / 64, (hi - lo) / 64, ap->in[I_SINK][l * 8 + h] * LOG2E, true);
                    } else if ((ASEL & 4) && L >= 512 && L < 528) { const int L2 = L - 512, b = L2 >> 3, h = L2 & 7;
                        attn_unit<96, false, 2>(lds, (const bf16_t*)(ws + O_QB) + (size_t)b * TB * 768 + h * 96, 768, (const bf16_t*)(ws + O_KB) + (size_t)b * TB * 768 + h * 96, 768,
                                             (const bf16_t*)(ws + O_VBT) + (size_t)(b * 8 + h) * 64 * TB, (bf16_t*)(ws + O_YB) + (size_t)b * TB * 512 + h * 64, 512, 0, 0, 4, 0, 0, 0.f, false);
                    } else if ((ASEL & 8) && L >= 528) { const int L2 = L - 528, b = L2 >> 3, h = L2 & 7, kvh = h >> 2;
                        bf16_t* qo = (bf16_t*)(ws + O_QA) + (size_t)b * TB * 512 + h * 64;
                        attn_unit<64, false, 2>(lds, qo, 512, (const bf16_t*)(ws + O_KA) + (size_t)b * TB * 128 + kvh * 64, 128, (const bf16_t*)(ws + O_VAT) + (size_t)(b * 2 + kvh) * 64 * TB,
                                             qo, 512, 0, 0, 4, 0, 0, ap->in[I_SINK][l * 8 + h] * LOG2E, true);
                    }
                    }
                }
            } else if (ON(4) && k == 4) {
                if (PROBE_GC) for (int item = bid; item < 1056; item += G) gla_out_item(lds, ws, ap->in[I_WGATE], ap->in[I_BGATE], ap->in[I_HNORM], l, item, false);
                for (int item = bid; item < 1056; item += G) gla_out_item(lds, ws, ap->in[I_WGATE], ap->in[I_BGATE], ap->in[I_HNORM], l, item);
            } else if (ON(5) && k == 5) {
                { EpiMerge<0> E{ws}; run_gemm_main(lds, (const bf16_t*)(ws + O_QA), (const bf16_t*)(ws + O_WBR), 1024, 512, E); }
                { EpiMerge<1> E{ws}; run_gemm_main(lds, (const bf16_t*)(ws + O_YB), (const bf16_t*)(ws + O_WBR) + (size_t)1024 * 512, 1024, 512, E); }
                { EpiMerge<2> E{ws}; run_gemm_main(lds, (const bf16_t*)(ws + O_CR), (const bf16_t*)(ws + O_WBR) + (size_t)2 * 1024 * 512, 1024, 512, E); }
                { EpiMergePart<0> E{ws, 256 * 2}; run_gemm_ctx(lds, (const bf16_t*)(ws + O_QA), (const bf16_t*)(ws + O_WBR), 1024, 512, 2, E, 64); }
                { EpiMergePart<1> E{ws, 256 * 2}; run_gemm_ctx(lds, (const bf16_t*)(ws + O_YB), (const bf16_t*)(ws + O_WBR) + (size_t)1024 * 512, 1024, 512, 2, E, 96); }
                { EpiMergePart<2> E{ws, 256 * 2}; run_gemm_ctx(lds, (const bf16_t*)(ws + O_CR), (const bf16_t*)(ws + O_WBR) + (size_t)2 * 1024 * 512, 1024, 512, 2, E, 128); }
            } else if (ON(6) && k == 6) {
                for (int r = gw; r < 512; r += NGW) { const int t = (r < 256) ? r : (TB + r - 256);
                    const f32x4* sp = (const f32x4*)((const float*)(ws + O_CQ) + (size_t)r * 1024);
#pragma unroll
                    for (int j = 0; j < 4; ++j) { f32x4 a = sp[64 * j + lane];
#pragma unroll
                        for (int q = 1; q < 6; ++q) a = a + sp[(size_t)q * 512 * 256 + 64 * j + lane];
                        u32x2 o; o.x = pk2(a[0], a[1]); o.y = pk2(a[2], a[3]); ((u32x2*)(HM + (size_t)t * 1024))[64 * j + lane] = o; } }
                xcd_barrier(xbar);
                if (PROBE_OD) { EpiNull E{(float*)(ws + O_SSQ)}; run_gemm_main(lds, HM, (const bf16_t*)(ws + O_WOUT), 1024, 1024, E); run_gemm_ctx(lds, HM, (const bf16_t*)(ws + O_WOUT), 1024, 1024, 4, E); }
                { EpiResid E{ws, modl, 2048}; run_gemm_main(lds, HM, (const bf16_t*)(ws + O_WOUT), 1024, 1024, E); }
                { EpiPartial E{(float*)(ws + O_GATES), 256 * 2}; run_gemm_ctx(lds, HM, (const bf16_t*)(ws + O_WOUT), 1024, 1024, 4, E); }
            } else if (ON(7) && k == 7) {
#define NORM2_PAR(P, t) do { const int b = ((t) >= TB) ? 1 : 0, i = (t) - b * TB, r = (i >= LC) ? b : 2; \
                    P.src = X + (size_t)(t) * 1024; P.cp = nullptr; P.part = nullptr; P.gv = nullptr; P.nsl = 4; \
                    if (i < LC) { P.part = (const float*)(ws + O_GATES) + (size_t)(b * 256 + i) * 1024; P.gv = modl + 2 * 6144 + 2048; P.cp = X + (size_t)(t) * 1024; } \
                    P.sc = modl + r * 6144 + 4096; P.sh = modl + r * 6144 + 3072; P.orow = HM + (size_t)(t) * 1024; } while (0)
                for (int t = gw; t < MT; t += 2 * NGW) {
                    const int tB = t + NGW; const bool hb = tB < MT;
                    const int tBc = hb ? tB : t;
                    NormPar PA, PB; NormRow RA, RB; NORM2_PAR(PA, t); NORM2_PAR(PB, tBc);
                    norm_load(RA, PA, lane); norm_load(RB, PB, lane);
                    norm_finish(RA, PA, ap->in[I_NFFN] + l * 1024, lane); if (hb) norm_finish(RB, PB, ap->in[I_NFFN] + l * 1024, lane);
                }
#undef NORM2_PAR
            } else if (ON(8) && k == 8) {
                EpiStore E{(bf16_t*)(ws + O_U), FF2}; run_gemm(lds, HM, (const bf16_t*)(ws + O_WUP), MT, FF2, 1024, E);
            } else if (ON(9) && k == 9) {
                const bf16_t* U = (const bf16_t*)(ws + O_U); bf16_t* ACT = (bf16_t*)(ws + O_ACT);
                const float* cw = ap->in[I_CONVW] + (size_t)l * 3 * FF2; const float* cb = ap->in[I_CONVB] + (size_t)l * FF2;
#pragma unroll 1
                for (int idx = bid * NTHR + tid; idx < (MT / 16) * 352; idx += G * NTHR) {
                    const int tb = idx / 352, j0 = (idx - tb * 352) * 8; const int t0 = tb * 16; const int b = (t0 >= TB) ? 1 : 0, i0 = t0 - b * TB;
                    float wg0[8], wg1[8], wg2[8], bg[8], wv0[8], wv1[8], wv2[8], bv[8];
#pragma unroll
                    for (int e = 0; e < 8; ++e) { wg0[e] = cw[j0 + e]; wg1[e] = cw[FF2 + j0 + e]; wg2[e] = cw[2 * FF2 + j0 + e]; bg[e] = cb[j0 + e];
                        wv0[e] = cw[FF + j0 + e]; wv1[e] = cw[FF2 + FF + j0 + e]; wv2[e] = cw[2 * FF2 + FF + j0 + e]; bv[e] = cb[FF + j0 + e]; }
                    const bf16_t* up = U + (size_t)t0 * FF2 + j0;
                    u32x4 gp_ = (u32x4){0u, 0u, 0u, 0u}, vp_ = (u32x4){0u, 0u, 0u, 0u};
                    if (i0 != 0 && i0 != LC) { gp_ = *(const u32x4*)(up - FF2); vp_ = *(const u32x4*)(up - FF2 + FF); }
                    u32x4 gc_ = *(const u32x4*)up, vc_ = *(const u32x4*)(up + FF);
#pragma unroll 4
                    for (int r = 0; r < 16; ++r) {
                        u32x4 gn_ = (u32x4){0u, 0u, 0u, 0u}, vn_ = (u32x4){0u, 0u, 0u, 0u};
                        const int ii = i0 + r;
                        if (ii != LC - 1 && ii != TB - 1) { gn_ = *(const u32x4*)(up + (size_t)(r + 1) * FF2); vn_ = *(const u32x4*)(up + (size_t)(r + 1) * FF2 + FF); }
                        float gm[8], gc[8], gn[8], vm[8], vc[8], vn[8], o[8];
                        unpack8(gp_, gm); unpack8(gc_, gc); unpack8(gn_, gn); unpack8(vp_, vm); unpack8(vc_, vc); unpack8(vn_, vn);
#pragma unroll
                        for (int e = 0; e < 8; ++e) {
                            const float a = wg0[e] * gm[e] + wg1[e] * gc[e] + wg2[e] * gn[e] + bg[e];
                            const float v = wv0[e] * vm[e] + wv1[e] * vc[e] + wv2[e] * vn[e] + bv[e];
                            o[e] = siluf_(a) * v;
                        }
                        *(u32x4*)(ACT + (size_t)(t0 + r) * FF + j0) = pack8(o);
                        gp_ = gc_; vp_ = vc_; gc_ = gn_; vc_ = vn_;
                    }
                }
            } else if (ON(10) && k == 10) {
                if (PROBE_OD) { EpiNull E{(float*)(ws + O_SSQ)}; run_gemm_main(lds, (const bf16_t*)(ws + O_ACT), (const bf16_t*)(ws + O_WDOWN), 1024, FF, E); run_gemm_ctx(lds, (const bf16_t*)(ws + O_ACT), (const bf16_t*)(ws + O_WDOWN), 1024, FF, 11, E); }
                { EpiResid E{ws, modl, 5120}; run_gemm_main(lds, (const bf16_t*)(ws + O_ACT), (const bf16_t*)(ws + O_WDOWN), 1024, FF, E); }
                { EpiPartial E{(float*)(ws + O_U), 256 * 2}; run_gemm_ctx(lds, (const bf16_t*)(ws + O_ACT), (const bf16_t*)(ws + O_WDOWN), 1024, FF, 11, E); }
            }
        }
        { const int kk_ = (ph >= 1 && ph <= 44) ? (ph - 1) % 11 : 15;
          const bool again = (rep == 0) && (((REPK) >> kk_) & 1);
          if (again) rep = 1; else { rep = 0; ++ph; }
          if (again || ph < args.ph_hi) { xcd_barrier(xbar); if (REP_SYNC) xcd_barrier(xbar); } }
    }
}

constexpr int N_PHASES = 46;
extern "C" void kernel_launch(void* const* d_in, const int* in_sizes, int n_in, void* d_out, int out_size, void* d_ws, size_t ws_size, hipStream_t stream) {
    static int grid = 0;
    if (grid == 0) {
        if (n_in != N_IN || ws_size < O_END) { fprintf(stderr, "kernel_launch: bad shapes: n_in %d ws %zu (need %zu)\n", n_in, ws_size, (size_t)O_END); grid = -1; return; }
        int dev = 0, cus = 0, per_cu = 0;
        hipGetDevice(&dev); hipDeviceGetAttribute(&cus, hipDeviceAttributeMultiprocessorCount, dev);
        if (hipFuncSetAttribute((const void*)mk_fwd, hipFuncAttributeMaxDynamicSharedMemorySize, LDS_BYTES) != hipSuccess) { fprintf(stderr, "kernel_launch: hipFuncSetAttribute failed\n"); grid = -1; return; }
        hipOccupancyMaxActiveBlocksPerMultiprocessor(&per_cu, (const void*)mk_fwd, NTHR, LDS_BYTES);
        (void)hipGetLastError();
        if (per_cu < 1) per_cu = 1;
        grid = cus * 1;
        fprintf(stderr, "kernel_launch: cus %d per_cu %d grid %d\n", cus, per_cu, grid);
    }
    if (grid < 0) return;
    if (hipMemsetAsync((char*)d_ws + O_BAR, 0, 16384, stream) != hipSuccess) { fprintf(stderr, "kernel_launch: memset failed\n"); return; }
    Args a{};
    for (int i = 0; i < N_IN; ++i) a.in[i] = (const float*)d_in[i];
    a.out = (float*)d_out; a.ws = (unsigned char*)d_ws;
#if ONE_LAUNCH
    a.ph_lo = 0; a.ph_hi = N_PHASES;
    void* kargs[] = {&a};
    hipError_t e = hipLaunchCooperativeKernel((const void*)mk_fwd, dim3(grid), dim3(NTHR), kargs, LDS_BYTES, stream);
    if (e != hipSuccess) fprintf(stderr, "cooperative launch failed: %s (grid %d)\n", hipGetErrorString(e), grid);
#else
    for (int ph = 0; ph < N_PHASES; ++ph) { a.ph_lo = ph; a.ph_hi = ph + 1; hipLaunchKernelGGL(mk_fwd, dim3(grid), dim3(NTHR), LDS_BYTES, stream, a); }
#endif
}
```

```cpp
#include <hip/hip_runtime.h>
#include <hip/hip_cooperative_groups.h>
#include <cstdio>
#include <cstdint>
namespace cg = cooperative_groups;
#ifndef ONE_LAUNCH
#define ONE_LAUNCH 1
#endif
namespace pg8 {
#define PG8_LAS __attribute__((address_space(3)))
typedef unsigned short bf16_t;
typedef short bf16x8 __attribute__((ext_vector_type(8)));
typedef float f32x4 __attribute__((ext_vector_type(4)));
typedef unsigned u32x4 __attribute__((ext_vector_type(4)));
constexpr int BM = 256, BK = 64, HALF = 128, HTB = HALF * BK * 2  , STAGE_BYTES = 8 * HTB, NXCD = 8, WGM = 8;

__host__ __device__ __forceinline__ int lds_byte(int r, int c) { const int st = (r >> 4) * 2 + (c >> 5), rr = r & 15, cc = c & 31, ob = rr * 64 + cc * 2; return st * 1024 + (ob ^ (((ob >> 9) & 1) << 5)); }
__host__ __device__ __forceinline__ void stage_rc(int b, int& R, int& C) { const int st = b / 1024, sb = b % 1024, swz = sb ^ (((sb >> 9) & 1) << 5); R = (st >> 1) * 16 + swz / 64; C = (st & 1) * 32 + (swz % 64) / 2; }
__host__ __device__ __forceinline__ int perm32(int rho) { const int n = rho >> 4, i = rho & 15; return 8 * (i >> 2) + 4 * n + (i & 3); }

struct Unit { int pm, pn, kb; };
struct Gemm { const bf16_t* A; const bf16_t* Bt; int M, N, K, Kloop; };

struct StaticOrder {
    int nM, nN, nwg, G, c;
    __host__ __device__ void init(int M, int N, int G_, int c_) { nM = M / BM; nN = N / BM; nwg = nM * nN; G = G_; c = c_; }
    __host__ __device__ bool next(int i, Unit& u) const {
        const long L = (long)i * G + c; if (L >= nwg) return false;
        int wgid = (int)L; { const int q = nwg / NXCD, r = nwg % NXCD, xcd = wgid % NXCD, off = wgid / NXCD; wgid = (xcd < r ? xcd * (q + 1) : r * (q + 1) + (xcd - r) * q) + off; }
        const int nig = WGM * nN, gid = wgid / nig, fm = gid * WGM, gsz = (nM - fm) < WGM ? (nM - fm) : WGM;
        u.pm = fm + ((wgid % nig) % gsz); u.pn = (wgid % nig) / gsz; u.kb = 0; return true;
    }
    __device__ __forceinline__ void a_ready(const Unit&) const {}
    __device__ __forceinline__ void done(const Unit&) const {}
};

__device__ __forceinline__ unsigned cvt_pk_bf16(float lo, float hi) { unsigned r; asm volatile("v_cvt_pk_bf16_f32 %0, %1, %2" : "=v"(r) : "v"(lo), "v"(hi)); return r; }
template <class Epi, class Sched, bool ALIGN_EPI = false, bool SP2 = false>
__device__ __forceinline__ void gemm_phase(PG8_LAS unsigned char* lds, const Gemm g, const Sched& S, const Epi& E) {
    int tid_ = threadIdx.x; asm volatile("" : "+v"(tid_));
    const int tid = tid_, wid = __builtin_amdgcn_readfirstlane(tid >> 6), lane = tid & 63, wr = wid >> 2, wc = wid & 3, fr = lane & 15, fq = lane >> 4;
    const int K = g.K, nt = g.Kloop / BK;
    unsigned voffA[2], voffB[2];
#pragma unroll
    for (int i = 0; i < 2; ++i) { int R, C; stage_rc(tid * 16 + i * 8192, R, C); const int Rb = Epi::PERM ? ((R & ~31) + perm32(R & 31)) : R;
        voffA[i] = (unsigned)(R * K + C) * 2u; voffB[i] = (unsigned)(Rb * K + C) * 2u; }
    const size_t kstep = (size_t)(BK * 2);
    const size_t hstep = (size_t)HALF * K * 2;
    const size_t tstep = 2 * hstep;
    const unsigned ldsw = (unsigned)wid * 1024u;
    const int aoff = lds_byte(wr * 64 + fr, fq * 8), boff = lds_byte(wc * 32 + fr, fq * 8);
#define PG8_SA(b, h) (((b) * 2 + (h)) * HTB)
#define PG8_SB(b, h) ((4 + (b) * 2 + (h)) * HTB)
#define PG8_STAGE(bufoff, gbase, voff) do { _Pragma("unroll") for (int _i = 0; _i < 2; ++_i) \
        __builtin_amdgcn_global_load_lds((const unsigned*)((const char*)(gbase) + (voff)[_i]), (PG8_LAS unsigned*)(lds + (bufoff) + ldsw + _i * 8192), 16, 0, 0); } while (0)
#define PG8_LDA(dst, b, h) do { _Pragma("unroll") for (int m = 0; m < 4; ++m) _Pragma("unroll") for (int k = 0; k < 2; ++k) dst[m][k] = *(const PG8_LAS bf16x8*)(lds + PG8_SA(b, h) + aoff + m * 2048 + k * 1024); } while (0)
#define PG8_LDB(dst, b, h) do { _Pragma("unroll") for (int n = 0; n < 2; ++n) _Pragma("unroll") for (int k = 0; k < 2; ++k) dst[n][k] = *(const PG8_LAS bf16x8*)(lds + PG8_SB(b, h) + boff + n * 2048 + k * 1024); } while (0)
#define PG8_MMA(ai, bj, At, Bt) do { __builtin_amdgcn_s_setprio(1); _Pragma("unroll") for (int m = 0; m < 4; ++m) _Pragma("unroll") for (int n = 0; n < 2; ++n) _Pragma("unroll") for (int k = 0; k < 2; ++k) \
        acc[ai][bj][m][n] = __builtin_amdgcn_mfma_f32_16x16x32_bf16(Bt[n][k], At[m][k], acc[ai][bj][m][n], 0, 0, 0); __builtin_amdgcn_s_setprio(0); } while (0)
#define PG8_WAIT_V(n) asm volatile("s_waitcnt vmcnt(" #n ")" ::: "memory")
#define PG8_WAIT_L(n) asm volatile("s_waitcnt lgkmcnt(" #n ")" ::: "memory")
#define PG8_BAR __builtin_amdgcn_s_barrier()
#define PG8_SCHED __builtin_amdgcn_sched_barrier(0)
    Unit cur, nxt; int ui = 0;
    if (!S.next(0, cur)) return;
    f32x4 acc[2][2][4][2];
#pragma unroll
    for (int a = 0; a < 2; ++a)
#pragma unroll
        for (int b = 0; b < 2; ++b)
#pragma unroll
            for (int m = 0; m < 4; ++m)
#pragma unroll
                for (int n = 0; n < 2; ++n) acc[a][b][m][n] = (f32x4){0.f, 0.f, 0.f, 0.f};
    bf16x8 At[4][2], B0[2][2], B1[2][2];
    const char* cA = (const char*)g.A + (size_t)cur.pm * tstep + cur.kb; const char* cB = (const char*)g.Bt + (size_t)cur.pn * tstep + cur.kb;
    S.a_ready(cur);
    if constexpr (SP2) {
        PG8_STAGE(PG8_SB(0, 0), cB, voffB); PG8_STAGE(PG8_SB(0, 1), cB + hstep, voffB); PG8_STAGE(PG8_SA(0, 0), cA, voffA); PG8_STAGE(PG8_SA(0, 1), cA + hstep, voffA);
        if (wr == 1) PG8_BAR;
        PG8_WAIT_V(2); PG8_BAR;
        PG8_STAGE(PG8_SB(1, 0), cB + kstep, voffB); PG8_STAGE(PG8_SA(1, 0), cA + kstep, voffA); PG8_STAGE(PG8_SB(1, 1), cB + hstep + kstep, voffB);
        PG8_WAIT_V(6); PG8_BAR;
    } else {
        PG8_STAGE(PG8_SB(0, 0), cB, voffB); PG8_STAGE(PG8_SA(0, 0), cA, voffA); PG8_STAGE(PG8_SB(0, 1), cB + hstep, voffB); PG8_STAGE(PG8_SA(0, 1), cA + hstep, voffA);
        if (wr == 1) PG8_BAR;
        PG8_WAIT_V(4); PG8_BAR;
        PG8_STAGE(PG8_SB(1, 0), cB + kstep, voffB); PG8_STAGE(PG8_SA(1, 0), cA + kstep, voffA); PG8_STAGE(PG8_SB(1, 1), cB + hstep + kstep, voffB);
        PG8_WAIT_V(6); PG8_BAR;
    }
    for (;;) {
        const bool has_next = S.next(ui + 1, nxt);
        const char* nA = has_next ? (const char*)g.A + (size_t)nxt.pm * tstep + nxt.kb : cA; const char* nB = has_next ? (const char*)g.Bt + (size_t)nxt.pn * tstep + nxt.kb : cB;
        for (int t = 0; t < nt; t += 2) {
            const bool last = (t == nt - 2);
            const char* a1 = cA + (size_t)(t + 1) * kstep;
            const char* a2 = last ? nA : cA + (size_t)(t + 2) * kstep; const char* b2 = last ? nB : cB + (size_t)(t + 2) * kstep;
            const char* a3 = a2 + kstep; const char* b3 = b2 + kstep;
            if (last && has_next) S.a_ready(nxt);
            if constexpr (SP2) {
            PG8_LDB(B0, 0, 0); PG8_LDB(B1, 0, 1); PG8_SCHED; PG8_LDA(At, 0, 0); PG8_STAGE(PG8_SA(1, 1), a1 + hstep, voffA);
            PG8_WAIT_V(8); PG8_WAIT_L(0); PG8_BAR; PG8_MMA(0, 0, At, B0); PG8_MMA(0, 1, At, B1); PG8_BAR; PG8_SCHED;
            PG8_LDA(At, 0, 1); PG8_STAGE(PG8_SB(0, 0), b2, voffB); PG8_STAGE(PG8_SB(0, 1), b2 + hstep, voffB); PG8_STAGE(PG8_SA(0, 0), a2, voffA);
            PG8_WAIT_V(8); PG8_WAIT_L(0); PG8_BAR; PG8_MMA(1, 0, At, B0); PG8_MMA(1, 1, At, B1); PG8_BAR; PG8_SCHED;
            PG8_LDB(B0, 1, 0); PG8_LDB(B1, 1, 1); PG8_SCHED; PG8_LDA(At, 1, 0); PG8_STAGE(PG8_SA(0, 1), a2 + hstep, voffA);
            PG8_WAIT_V(8); PG8_WAIT_L(0); PG8_BAR; PG8_MMA(0, 0, At, B0); PG8_MMA(0, 1, At, B1); PG8_BAR; PG8_SCHED;
            PG8_LDA(At, 1, 1); PG8_STAGE(PG8_SB(1, 0), b3, voffB); PG8_STAGE(PG8_SB(1, 1), b3 + hstep, voffB); PG8_STAGE(PG8_SA(1, 0), a3, voffA);
            PG8_WAIT_V(8); PG8_WAIT_L(0); PG8_BAR; PG8_MMA(1, 0, At, B0); PG8_MMA(1, 1, At, B1); PG8_BAR; PG8_SCHED;
            } else {
            PG8_LDB(B0, 0, 0); PG8_SCHED; PG8_LDA(At, 0, 0); PG8_STAGE(PG8_SA(1, 1), a1 + hstep, voffA);
            PG8_WAIT_L(8); PG8_BAR; PG8_WAIT_L(0); PG8_MMA(0, 0, At, B0); PG8_BAR; PG8_SCHED;
            PG8_LDB(B1, 0, 1); PG8_STAGE(PG8_SB(0, 0), b2, voffB);
            PG8_BAR; PG8_WAIT_L(0); PG8_MMA(0, 1, At, B1); PG8_BAR;
            PG8_LDA(At, 0, 1); PG8_STAGE(PG8_SA(0, 0), a2, voffA);
            PG8_BAR; PG8_WAIT_L(0); PG8_MMA(1, 0, At, B0); PG8_BAR; PG8_SCHED;
            PG8_STAGE(PG8_SB(0, 1), b2 + hstep, voffB);
            PG8_WAIT_V(6); PG8_BAR; PG8_MMA(1, 1, At, B1); PG8_BAR;
            PG8_LDB(B0, 1, 0); PG8_SCHED; PG8_LDA(At, 1, 0); PG8_STAGE(PG8_SA(0, 1), a2 + hstep, voffA);
            PG8_WAIT_L(8); PG8_BAR; PG8_WAIT_L(0); PG8_MMA(0, 0, At, B0); PG8_BAR; PG8_SCHED;
            PG8_LDB(B1, 1, 1); PG8_STAGE(PG8_SB(1, 0), b3, voffB);
            PG8_BAR; PG8_WAIT_L(0); PG8_MMA(0, 1, At, B1); PG8_BAR;
            PG8_LDA(At, 1, 1); PG8_STAGE(PG8_SA(1, 0), a3, voffA);
            PG8_BAR; PG8_WAIT_L(0); PG8_MMA(1, 0, At, B0); PG8_BAR; PG8_SCHED;
            PG8_STAGE(PG8_SB(1, 1), b3 + hstep, voffB);
            PG8_WAIT_V(6); PG8_BAR; PG8_MMA(1, 1, At, B1); PG8_BAR;
            }
        }
        if constexpr (ALIGN_EPI) { if (wr == 0) PG8_BAR; }
        if constexpr (!Epi::AFTER_DRAIN) { E(acc, cur, wr, wc, fr, fq); S.done(cur); }
        if (!has_next) break;
#pragma unroll
        for (int a = 0; a < 2; ++a)
#pragma unroll
            for (int b = 0; b < 2; ++b)
#pragma unroll
                for (int m = 0; m < 4; ++m)
#pragma unroll
                    for (int n = 0; n < 2; ++n) acc[a][b][m][n] = (f32x4){0.f, 0.f, 0.f, 0.f};
        cur = nxt; cA = nA; cB = nB; ++ui;
        if constexpr (ALIGN_EPI) { if (wr == 1) PG8_BAR; }
    }
    PG8_WAIT_V(0);
    if constexpr (!ALIGN_EPI) { if (wr == 0) PG8_BAR; }
    PG8_BAR;
    if constexpr (Epi::AFTER_DRAIN) { E.fused(acc, cur, wr, wc, fr, fq, lds, wid, lane); S.done(cur); }
#undef PG8_SA
#undef PG8_SB
#undef PG8_STAGE
#undef PG8_LDA
#undef PG8_LDB
#undef PG8_MMA
#undef PG8_WAIT_V
#undef PG8_WAIT_L
#undef PG8_BAR
#undef PG8_SCHED
}
}
#define LASX __attribute__((address_space(3)))
#define XB_TMO      128
#define XB_XCNT(j)  (256  + 64 * (j))
#define XB_XSUB(j)  (1280 + 64 * (j))
#define XB_XGEN(j)  (2304 + 64 * (j))
#define XB_TOP      3328
#define XB_TOPGEN   3392
#define XCD_BAR_WORDS 3456
#define XB_SPIN_CAP (1u << 18)

__device__ __forceinline__ unsigned xb_ld(unsigned* p)              { return __hip_atomic_load(p, __ATOMIC_RELAXED, __HIP_MEMORY_SCOPE_AGENT); }
__device__ __forceinline__ unsigned xb_add(unsigned* p, unsigned v) { return __hip_atomic_fetch_add(p, v, __ATOMIC_RELAXED, __HIP_MEMORY_SCOPE_AGENT); }
__device__ __forceinline__ unsigned xb_xcc_id() { return (unsigned)__builtin_amdgcn_s_getreg((3 << 11) | 20) & 0xFu; }
#define XB_SPIN(cond, bar) do { unsigned _sp = 0; while (cond) { __builtin_amdgcn_s_sleep(1); \
    if ((++_sp & 255u) == 0u) { if (xb_ld(&(bar)[XB_TMO])) break; if (_sp > XB_SPIN_CAP) { atomicAdd(&(bar)[XB_TMO], 1u); break; } } } } while (0)

struct XcdBarrier {
    unsigned* bar; unsigned x;
    volatile LASX unsigned* st;
};

__device__ __forceinline__ XcdBarrier xcd_barrier_post(unsigned* bar, volatile LASX unsigned* st) {
    XcdBarrier b; b.bar = bar; b.x = xb_xcc_id(); b.st = st;
    if (threadIdx.x == 0) (void)xb_add(&bar[XB_XCNT(b.x)], 1u);
    return b;
}
__device__ __forceinline__ void xcd_barrier_complete(unsigned* bar, unsigned x, unsigned& nloc, unsigned& nx) {
    const unsigned G = gridDim.x * gridDim.y * gridDim.z;
    unsigned sum, cnt, mine, sp = 0u;
    for (;;) {
        sum = 0u; cnt = 0u; mine = 0u;
#pragma unroll
        for (unsigned j = 0; j < 16; ++j) { const unsigned c = xb_ld(&bar[XB_XCNT(j)]); sum += c; cnt += (c > 0u) ? 1u : 0u; mine = (j == x) ? c : mine; }
        if (sum == G) break;
        __builtin_amdgcn_s_sleep(1);
        if ((++sp & 255u) == 0u) { if (xb_ld(&bar[XB_TMO])) break; if (sp > XB_SPIN_CAP) { atomicAdd(&bar[XB_TMO], 1u); break; } }
    }
    nloc = mine > 0u ? mine : 1u; nx = cnt > 0u ? cnt : 1u;
}

__device__ __forceinline__ void xcd_barrier(const XcdBarrier& b) {
    asm volatile("s_waitcnt vmcnt(0)" ::: "memory");
    __syncthreads();
    if (threadIdx.x == 0) {
        unsigned* bar = b.bar;
        __builtin_amdgcn_s_waitcnt(0);
        unsigned nloc = b.st[0], nx = b.st[1];
        if (nloc == 0u) { xcd_barrier_complete(bar, b.x, nloc, nx); b.st[0] = nloc; b.st[1] = nx; }
        const unsigned old = xb_add(&bar[XB_XSUB(b.x)], 1u);
        const unsigned gen = old / nloc;
        if (old + 1u == (gen + 1u) * nloc) {
            __builtin_amdgcn_fence(__ATOMIC_RELEASE, "agent");
            asm volatile("s_waitcnt vmcnt(0)" ::: "memory");
            const unsigned og = xb_add(&bar[XB_TOP], 1u);
            const unsigned tg = og / nx;
            if (og + 1u == (tg + 1u) * nx) xb_add(&bar[XB_TOPGEN], 1u);
            else XB_SPIN(xb_ld(&bar[XB_TOPGEN]) == tg, bar);
            __builtin_amdgcn_fence(__ATOMIC_ACQUIRE, "agent");
            xb_add(&bar[XB_XGEN(b.x)], 1u);
            asm volatile("s_waitcnt vmcnt(0)" ::: "memory");
        } else {
            XB_SPIN(xb_ld(&bar[XB_XGEN(b.x)]) == gen, bar);
            __builtin_amdgcn_fence(__ATOMIC_ACQUIRE, "agent");
            asm volatile("s_waitcnt vmcnt(0)" ::: "memory");
        }
    }
    __syncthreads();
}

#ifndef PROBE_OD
#define PROBE_OD 0
#endif
#ifndef PROBE_GC
#define PROBE_GC 0
#endif
#ifndef PROBE_AA
#define PROBE_AA 0
#endif
#ifndef XEXP
#define XEXP 0
#endif
typedef unsigned short bf16_t;
typedef short bf16x8 __attribute__((ext_vector_type(8)));
typedef float f32x4 __attribute__((ext_vector_type(4)));
typedef unsigned u32x4 __attribute__((ext_vector_type(4)));
typedef unsigned u32x2 __attribute__((ext_vector_type(2)));
#define LAS __attribute__((address_space(3)))

constexpr int NB = 2, SEQ = 8192, LC = 256, TB = SEQ + LC, MT = NB * TB, DM = 1024, NL = 4;
constexpr int IN_DIM = 5824, NPIN = 5888, FF = 2816, FF2 = 5632;
constexpr float EPS = 1e-6f, LOG2E = 1.4426950408889634f;
constexpr int NTHR = 512, NWAVES = 8;
constexpr int LDS_BYTES = 147456;
enum { I_X = 0, I_C, I_CTX, I_CCTX, I_WMOD, I_BMOD, I_NMIX, I_NFFN, I_WIN, I_SINK, I_QNORM, I_KVNORM, I_WUQ, I_WUKV, I_WGATE, I_BGATE, I_HNORM,
       I_WBRA, I_WBRB, I_WBRC, I_WOUT, I_WUP, I_CONVW, I_CONVB, I_WDOWN, I_FNORM, N_IN };

constexpr size_t O_MOD = 0;
constexpr size_t O_BAR = 384 * 1024;
constexpr size_t O_ROPEA = 512 * 1024;
constexpr size_t O_ROPEB = O_ROPEA + 2 * 1024 * 1024;
constexpr size_t O_SSQ = O_ROPEB + 1024 * 1024;
constexpr size_t O_GD = O_SSQ + 256 * 1024;
constexpr size_t O_X = O_GD + 1024 * 1024;
constexpr size_t SZ_X = (size_t)MT * DM * 4;
constexpr size_t O_WIN = O_X + SZ_X;
constexpr size_t O_WUQ = O_WIN + (size_t)NPIN * 1024 * 2;
constexpr size_t O_WUKV = O_WUQ + (size_t)768 * 256 * 2;
constexpr size_t O_WBR = O_WUKV + (size_t)1024 * 256 * 2;
constexpr size_t O_WOUT = O_WBR + (size_t)3 * 1024 * 512 * 2;
constexpr size_t O_WUP = O_WOUT + (size_t)1024 * 1024 * 2;
constexpr size_t O_WDOWN = O_WUP + (size_t)FF2 * 1024 * 2;
constexpr size_t O_HM = O_WDOWN + (size_t)1024 * FF * 2;
constexpr size_t O_MIX = O_HM + (size_t)MT * 1024 * 2;
constexpr size_t O_QA = O_MIX;
constexpr size_t O_KA = O_QA + (size_t)MT * 512 * 2;
constexpr size_t O_VAT = O_KA + (size_t)MT * 128 * 2;
constexpr size_t O_CQB = O_VAT + (size_t)2 * 2 * 64 * TB * 2;
constexpr size_t O_CKVB = O_CQB + (size_t)MT * 256 * 2;
constexpr size_t O_QB = O_CKVB + (size_t)MT * 256 * 2;
constexpr size_t O_KB = O_QB + (size_t)MT * 768 * 2;
constexpr size_t O_VBT = O_KB + (size_t)MT * 768 * 2;
constexpr size_t O_CQ = O_VBT + (size_t)2 * 8 * 64 * TB * 2;
constexpr size_t O_CK = O_CQ + (size_t)MT * 256 * 2;
constexpr size_t O_CV = O_CK + (size_t)MT * 256 * 2;
constexpr size_t O_CR = O_CV + (size_t)MT * 512 * 2;
constexpr size_t O_GLOW = O_CR + (size_t)MT * 512 * 2;
constexpr size_t O_GATES = O_GLOW + (size_t)MT * 32 * 4;
constexpr size_t O_YB = O_GATES + (size_t)MT * 3072 * 2;
constexpr size_t O_END = O_YB + (size_t)MT * 512 * 2;
constexpr size_t O_MACC = O_QB;
static_assert(O_CQ - O_QB == (size_t)MT * 1024 * 4, "MACC overlay");
constexpr size_t O_U = O_MIX;
constexpr size_t O_ACT = O_U + (size_t)MT * FF2 * 2;
static_assert(O_ACT + (size_t)MT * FF * 2 <= O_END, "U|ACT overlay");
constexpr size_t O_ST = O_HM;
static_assert((size_t)2112 * 8192 * 2 <= (size_t)MT * 1024 * 2, "ST overlay");
static_assert(O_END <= (size_t)448 * 1024 * 1024, "workspace budget");

__device__ __forceinline__ unsigned f2bf(float f) { unsigned u = __float_as_uint(f); return (u + 0x7fffu + ((u >> 16) & 1u)) >> 16; }
typedef float f32x2_t __attribute__((ext_vector_type(2))); typedef __bf16 bf16x2_t __attribute__((ext_vector_type(2)));
__device__ __forceinline__ unsigned pk2(float lo, float hi) { f32x2_t v = {lo, hi}; bf16x2_t b = __builtin_convertvector(v, bf16x2_t); return __builtin_bit_cast(unsigned, b); }
__device__ __forceinline__ float bflo(unsigned w) { return __uint_as_float(w << 16); }
__device__ __forceinline__ float bfhi(unsigned w) { return __uint_as_float(w & 0xffff0000u); }
__device__ __forceinline__ float bf2f(bf16_t h) { return __uint_as_float(((unsigned)h) << 16); }
__device__ __forceinline__ u32x4 pack8(const float* v) { u32x4 w; w.x = pk2(v[0], v[1]); w.y = pk2(v[2], v[3]); w.z = pk2(v[4], v[5]); w.w = pk2(v[6], v[7]); return w; }
__device__ __forceinline__ void unpack8(u32x4 w, float* v) { v[0] = bflo(w.x); v[1] = bfhi(w.x); v[2] = bflo(w.y); v[3] = bfhi(w.y); v[4] = bflo(w.z); v[5] = bfhi(w.z); v[6] = bflo(w.w); v[7] = bfhi(w.w); }
__device__ __forceinline__ float wave_sum(float v) {
#pragma unroll
    for (int o = 1; o < 64; o <<= 1) v += __shfl_xor(v, o);
    return v;
}
__device__ __forceinline__ float sigmoidf_(float x) { return 1.f / (1.f + __expf(-x)); }
__device__ __forceinline__ float siluf_(float x) { return x / (1.f + __expf(-x)); }

struct Args { const float* in[N_IN]; float* out; unsigned char* ws; int ph_lo, ph_hi; };

enum { MAT_IN = 0, MAT_UQ, MAT_UKV, MAT_PLAIN };
__device__ __forceinline__ int srcmap(int mat, int p) {
    if (mat == MAT_IN) {
        if (p < 640) { const int w = p & 63; return (p & ~63) + (w >> 1) + 32 * (w & 1); }
        if (p < 1152) return p;
        if (p < 1184) { const int w = p - 1152; return 1152 + (w >> 1) + 16 * (w & 1); }
        if (p < 1216) return 2720 + (p - 1184);
        if (p < 1280) return -1;
        if (p < 2816) return 1184 + (p - 1280);
        return 2752 + (p - 2816);
    }
    if (mat == MAT_UQ) { const int h = p / 96, w = p - h * 96; if (w < 64) return p; const int ww = w - 64; return h * 96 + 64 + (ww >> 1) + 16 * (ww & 1); }
    return p;
}
__device__ __forceinline__ void transpose_item(const float* __restrict__ W, int K, int N, bf16_t* WT, int KD, int item, int mat, const float* __restrict__ ks, float* scr, int lane) {
    const int nkb = KD / 64, pb = item / nkb, kb = item - pb * nkb, p0 = pb * 32, k0 = kb * 64;
    const int src = srcmap(mat, p0 + (lane & 31));
    float tv[32];
#pragma unroll
    for (int i = 0; i < 32; ++i) {
        const int k = k0 + 2 * i + (lane >> 5);
        float v = 0.f;
        if (src >= 0 && k < K) { v = W[(size_t)k * N + src]; if (ks) v *= ks[k]; }
        tv[i] = v;
    }
#pragma unroll
    for (int i = 0; i < 32; ++i) scr[(2 * i + (lane >> 5)) * 33 + (lane & 31)] = tv[i];
    __builtin_amdgcn_fence(__ATOMIC_RELEASE, "workgroup"); __builtin_amdgcn_wave_barrier();
    const int c = lane & 7;
#pragma unroll
    for (int j = 0; j < 4; ++j) {
        const int n = (lane >> 3) + 8 * j; const float* s = scr + (8 * c) * 33 + n;
        u32x4 o; o.x = pk2(s[0 * 33], s[1 * 33]); o.y = pk2(s[2 * 33], s[3 * 33]); o.z = pk2(s[4 * 33], s[5 * 33]); o.w = pk2(s[6 * 33], s[7 * 33]);
        *(u32x4*)(WT + (size_t)(p0 + n) * KD + k0 + 8 * c) = o;
    }
    __builtin_amdgcn_fence(__ATOMIC_RELEASE, "workgroup"); __builtin_amdgcn_wave_barrier();
}

#define EPI_LOOP_BEGIN \
    int fr_l = fr, fq_l = fq; asm volatile("" : "+v"(fr_l), "+v"(fq_l)); \
    _Pragma("unroll") for (int bj = 0; bj < 2; ++bj) { const int c0 = u.pn * 256 + bj * 128 + wc * 32 + 8 * fq_l; \
    _Pragma("unroll") for (int ai = 0; ai < 2; ++ai) _Pragma("unroll") for (int m = 0; m < 4; ++m) { const int t = u.pm * 256 + ai * 128 + wr * 64 + m * 16 + fr_l; \
        float v[8]; { const f32x4 a0 = acc[ai][bj][m][0], a1 = acc[ai][bj][m][1]; v[0] = a0[0]; v[1] = a0[1]; v[2] = a0[2]; v[3] = a0[3]; v[4] = a1[0]; v[5] = a1[1]; v[6] = a1[2]; v[7] = a1[3]; }
#define EPI_LOOP_END asm volatile("" ::: "memory"); } }

struct EpiIn {
    static constexpr bool PERM = true, AFTER_DRAIN = false;
    unsigned char* ws;
    __device__ __forceinline__ void operator()(const f32x4 (&acc)[2][2][4][2], const pg8::Unit& u, int wr, int wc, int fr, int fq) const {
        EPI_LOOP_BEGIN
            const int b = (t >= TB) ? 1 : 0, i = t - b * TB; const bool lat = i >= LC; const int pos = i - LC;
            if (c0 < 640) {
                if (lat) { const float* cs = (const float*)(ws + O_ROPEA) + (size_t)pos * 64 + ((c0 & 63) >> 1);
#pragma unroll
                    for (int p = 0; p < 4; ++p) { const float c = cs[p], s = cs[32 + p], a = v[2 * p], bb = v[2 * p + 1]; v[2 * p] = a * c - bb * s; v[2 * p + 1] = a * s + bb * c; } }
                if (c0 < 512) {
#pragma unroll
                    for (int e = 0; e < 8; ++e) v[e] *= 0.125f * LOG2E;
                    *(u32x4*)((bf16_t*)(ws + O_QA) + (size_t)t * 512 + c0) = pack8(v);
                } else *(u32x4*)((bf16_t*)(ws + O_KA) + (size_t)t * 128 + (c0 - 512)) = pack8(v);
            } else if (c0 < 768) {
                const int cc = c0 - 640, kvh = cc >> 6, d0 = cc & 63;
                bf16_t* dst = (bf16_t*)(ws + O_VAT) + ((size_t)(b * 2 + kvh) * 64 + d0) * TB + i;
#pragma unroll
                for (int e = 0; e < 8; ++e) dst[(size_t)e * TB] = (bf16_t)f2bf(v[e]);
            } else if (c0 < 1152) {
                float s = 0.f;
#pragma unroll
                for (int e = 0; e < 8; ++e) s += v[e] * v[e];
                s += __shfl_xor(s, 16); s += __shfl_xor(s, 32);
                if (c0 < 1024) { *(u32x4*)((bf16_t*)(ws + O_CQB) + (size_t)t * 256 + (c0 - 768)) = pack8(v); if (fq_l == 0) unsafeAtomicAdd((float*)(ws + O_SSQ) + t * 2, s); }
                else { bf16_t* d = (bf16_t*)(ws + O_CKVB) + (size_t)t * 256 + (c0 - 1024); *(u32x4*)d = pack8(v); *(u32x4*)(d + 128) = (u32x4){0u, 0u, 0u, 0u}; if (fq_l == 0) unsafeAtomicAdd((float*)(ws + O_SSQ) + t * 2 + 1, s); }
            } else if (c0 < 1184) {
                if (lat) { const float* cs = (const float*)(ws + O_ROPEB) + (size_t)pos * 32 + ((c0 - 1152) >> 1);
#pragma unroll
                    for (int p = 0; p < 4; ++p) { const float c = cs[p], s = cs[16 + p], a = v[2 * p], bb = v[2 * p + 1]; v[2 * p] = a * c - bb * s; v[2 * p + 1] = a * s + bb * c; } }
                const u32x4 w = pack8(v); bf16_t* d = (bf16_t*)(ws + O_KB) + (size_t)t * 768 + 64 + (c0 - 1152);
#pragma unroll
                for (int h = 0; h < 8; ++h) *(u32x4*)(d + h * 96) = w;
            } else if (c0 < 1216) {
                float* d = (float*)(ws + O_GLOW) + (size_t)t * 32 + (c0 - 1184);
                *(f32x4*)d = (f32x4){v[0], v[1], v[2], v[3]}; *(f32x4*)(d + 4) = (f32x4){v[4], v[5], v[6], v[7]};
            } else if (c0 < 1280) {
            } else if (c0 < 1536) {
#pragma unroll
                for (int e = 0; e < 8; ++e) v[e] *= 0.125f;
                *(u32x4*)((bf16_t*)(ws + O_CQ) + (size_t)t * 256 + (c0 - 1280)) = pack8(v);
            } else if (c0 < 1792) { *(u32x4*)((bf16_t*)(ws + O_CK) + (size_t)t * 256 + (c0 - 1536)) = pack8(v);
            } else if (c0 < 2304) { *(u32x4*)((bf16_t*)(ws + O_CV) + (size_t)t * 512 + (c0 - 1792)) = pack8(v);
            } else if (c0 < 2816) { *(u32x4*)((bf16_t*)(ws + O_CR) + (size_t)t * 512 + (c0 - 2304)) = pack8(v);
            } else {
#pragma unroll
                for (int e = 0; e < 8; ++e) v[e] = sigmoidf_(v[e]);
                *(u32x4*)((bf16_t*)(ws + O_GATES) + (size_t)t * 3072 + (c0 - 2816)) = pack8(v);
            }
        EPI_LOOP_END
    }
};

struct EpiUq {
    static constexpr bool PERM = true, AFTER_DRAIN = false;
    unsigned char* ws;
    __device__ __forceinline__ void operator()(const f32x4 (&acc)[2][2][4][2], const pg8::Unit& u, int wr, int wc, int fr, int fq) const {
        EPI_LOOP_BEGIN
            const int b = (t >= TB) ? 1 : 0, i = t - b * TB; const bool lat = i >= LC; const int pos = i - LC;
            const float rstd = rsqrtf(((const float*)(ws + O_SSQ))[t * 2] * (1.f / 256.f) + EPS) * (0.10206207261596575f * LOG2E);
#pragma unroll
            for (int e = 0; e < 8; ++e) v[e] *= rstd;
            const int h = c0 / 96, w = c0 - h * 96;
            if (w >= 64 && lat) { const float* cs = (const float*)(ws + O_ROPEB) + (size_t)pos * 32 + ((w - 64) >> 1);
#pragma unroll
                for (int p = 0; p < 4; ++p) { const float c = cs[p], s = cs[16 + p], a = v[2 * p], bb = v[2 * p + 1]; v[2 * p] = a * c - bb * s; v[2 * p + 1] = a * s + bb * c; } }
            *(u32x4*)((bf16_t*)(ws + O_QB) + (size_t)t * 768 + c0) = pack8(v);
        EPI_LOOP_END
    }
};
struct EpiUkv {
    static constexpr bool PERM = true, AFTER_DRAIN = false;
    unsigned char* ws;
    __device__ __forceinline__ void operator()(const f32x4 (&acc)[2][2][4][2], const pg8::Unit& u, int wr, int wc, int fr, int fq) const {
        EPI_LOOP_BEGIN
            const int b = (t >= TB) ? 1 : 0, i = t - b * TB;
            const float rstd = rsqrtf(((const float*)(ws + O_SSQ))[t * 2 + 1] * (1.f / 128.f) + EPS);
#pragma unroll
            for (int e = 0; e < 8; ++e) v[e] *= rstd;
            const int h = c0 >> 7, w = c0 & 127;
            if (w < 64) *(u32x4*)((bf16_t*)(ws + O_KB) + (size_t)t * 768 + h * 96 + w) = pack8(v);
            else { bf16_t* dst = (bf16_t*)(ws + O_VBT) + ((size_t)(b * 8 + h) * 64 + (w - 64)) * TB + i;
#pragma unroll
                for (int e = 0; e < 8; ++e) dst[(size_t)e * TB] = (bf16_t)f2bf(v[e]); }
        EPI_LOOP_END
    }
};
template <int PASS> struct EpiMerge {
    static constexpr bool PERM = true, AFTER_DRAIN = false;
    unsigned char* ws;
    __device__ __forceinline__ void operator()(const f32x4 (&acc)[2][2][4][2], const pg8::Unit& u, int wr, int wc, int fr, int fq) const {
        EPI_LOOP_BEGIN
            float g[8]; unpack8(*(const u32x4*)((const bf16_t*)(ws + O_GATES) + (size_t)t * 3072 + PASS * 1024 + c0), g);
            bf16_t* mp = (bf16_t*)(ws + O_HM) + (size_t)t * 1024 + c0;
            if (PASS > 0) { float pv[8]; unpack8(*(const u32x4*)mp, pv);
#pragma unroll
                for (int e = 0; e < 8; ++e) v[e] = pv[e] + g[e] * v[e];
            } else {
#pragma unroll
                for (int e = 0; e < 8; ++e) v[e] *= g[e];
            }
            *(u32x4*)mp = pack8(v);
        EPI_LOOP_END
    }
};
template <int PASS> struct EpiMergePart {
    static constexpr bool PERM = true, AFTER_DRAIN = false;
    unsigned char* ws; int kbstep;
    __device__ __forceinline__ void operator()(const f32x4 (&acc)[2][2][4][2], const pg8::Unit& u, int wr, int wc, int fr, int fq) const {
        const int ks = u.kb / kbstep;
        EPI_LOOP_BEGIN
            float g[8]; unpack8(*(const u32x4*)((const bf16_t*)(ws + O_GATES) + (size_t)t * 3072 + PASS * 1024 + c0), g);
            const int cr = (t >= TB) ? (t - TB + 256) : t;
            float* pp = (float*)(ws + O_CQ) + ((size_t)((PASS * 2 + ks) * 512 + cr)) * 1024 + c0;
            *(f32x4*)pp = (f32x4){g[0] * v[0], g[1] * v[1], g[2] * v[2], g[3] * v[3]}; *(f32x4*)(pp + 4) = (f32x4){g[4] * v[4], g[5] * v[5], g[6] * v[6], g[7] * v[7]};
        EPI_LOOP_END
    }
};
struct EpiResid {
    static constexpr bool PERM = true, AFTER_DRAIN = false;
    unsigned char* ws; const float* modl; int goff;
    __device__ __forceinline__ void operator()(const f32x4 (&acc)[2][2][4][2], const pg8::Unit& u, int wr, int wc, int fr, int fq) const {
        EPI_LOOP_BEGIN
            const int b = (t >= TB) ? 1 : 0, i = t - b * TB; const int r = (i >= LC) ? b : 2;
            const float* gp = modl + r * 6144 + goff + c0;
            const f32x4 g0 = *(const f32x4*)gp, g1 = *(const f32x4*)(gp + 4);
            float* xp = (float*)(ws + O_X) + (size_t)t * 1024 + c0;
            f32x4 x0 = *(const f32x4*)xp, x1 = *(const f32x4*)(xp + 4);
            x0[0] += g0[0] * v[0]; x0[1] += g0[1] * v[1]; x0[2] += g0[2] * v[2]; x0[3] += g0[3] * v[3];
            x1[0] += g1[0] * v[4]; x1[1] += g1[1] * v[5]; x1[2] += g1[2] * v[6]; x1[3] += g1[3] * v[7];
            *(f32x4*)xp = x0; *(f32x4*)(xp + 4) = x1;
        EPI_LOOP_END
    }
};
struct EpiPartial {
    static constexpr bool PERM = true, AFTER_DRAIN = false;
    float* P; int kbstep;
    __device__ __forceinline__ void operator()(const f32x4 (&acc)[2][2][4][2], const pg8::Unit& u, int wr, int wc, int fr, int fq) const {
        const int ks = u.kb / kbstep;
        EPI_LOOP_BEGIN
            const int cr = (t >= TB) ? (t - TB + 256) : t;
            float* pp = P + ((size_t)(ks * 512 + cr)) * 1024 + c0;
            *(f32x4*)pp = (f32x4){v[0], v[1], v[2], v[3]}; *(f32x4*)(pp + 4) = (f32x4){v[4], v[5], v[6], v[7]};
        EPI_LOOP_END
    }
};
struct EpiNull {
    static constexpr bool PERM = true, AFTER_DRAIN = false;
    float* sink;
    __device__ __forceinline__ void operator()(const f32x4 (&acc)[2][2][4][2], const pg8::Unit& u, int wr, int wc, int fr, int fq) const {
        float sacc = 0.f;
        EPI_LOOP_BEGIN
            sacc += v[0] + v[1] + v[2] + v[3] + v[4] + v[5] + v[6] + v[7] + (float)(t + c0) * 1e-30f;
        EPI_LOOP_END
        if (sacc == 1.2345e30f) sink[threadIdx.x] = sacc;
    }
};
struct EpiStore {
    static constexpr bool PERM = true, AFTER_DRAIN = false;
    bf16_t* O; int ldc;
    __device__ __forceinline__ void operator()(const f32x4 (&acc)[2][2][4][2], const pg8::Unit& u, int wr, int wc, int fr, int fq) const {
        EPI_LOOP_BEGIN
            *(u32x4*)(O + (size_t)t * ldc + c0) = pack8(v);
        EPI_LOOP_END
    }
};

template <class Epi> __device__ __forceinline__ void run_gemm(unsigned char* lds, const bf16_t* A, const bf16_t* Bt, int M, int N, int K, const Epi& E) {
    asm volatile("" : "+s"(K), "+s"(M), "+s"(N));
    int gd_ = (int)gridDim.x, bi_ = (int)blockIdx.x; asm volatile("" : "+s"(gd_), "+s"(bi_));
    pg8::Gemm g{A, Bt, M, N, K, K}; pg8::StaticOrder S; S.init(M, N, gd_, bi_);
    pg8::gemm_phase<Epi, pg8::StaticOrder, true, true>((PG8_LAS unsigned char*)lds, g, S, E);
}

struct MainOrder {
    pg8::StaticOrder S;
    __device__ void init(int N, int G_, int c_) { S.init(64 * 256, N, G_, c_); }
    __device__ bool next(int i, pg8::Unit& u) const { if (!S.next(i, u)) return false; u.pm = (u.pm < 32) ? u.pm + 1 : u.pm + 2; return true; }
    __device__ __forceinline__ void a_ready(const pg8::Unit&) const {}
    __device__ __forceinline__ void done(const pg8::Unit&) const {}
};
struct CtxSplitOrder {
    int nN, nsplit, kloop, G, c;
    __device__ bool next(int i, pg8::Unit& u) const {
        const int L = i * G + c; if (L >= 2 * nN * nsplit) return false;
        const int ks = L % nsplit, r = L / nsplit; u.pn = r % nN; u.pm = (r / nN) ? 33 : 0; u.kb = ks * kloop * 2; return true;
    }
    __device__ __forceinline__ void a_ready(const pg8::Unit&) const {}
    __device__ __forceinline__ void done(const pg8::Unit&) const {}
};
template <class Epi> __device__ __forceinline__ void run_gemm_main(unsigned char* lds, const bf16_t* A, const bf16_t* Bt, int N, int K, const Epi& E) {
    asm volatile("" : "+s"(K), "+s"(N));
    int gd_ = (int)gridDim.x, bi_ = (int)blockIdx.x; asm volatile("" : "+s"(gd_), "+s"(bi_));
    pg8::Gemm g{A, Bt, MT, N, K, K}; MainOrder S; S.init(N, gd_, bi_);
    pg8::gemm_phase<Epi, MainOrder, true, true>((PG8_LAS unsigned char*)lds, g, S, E);
}
template <class Epi> __device__ __forceinline__ void run_gemm_ctx(unsigned char* lds, const bf16_t* A, const bf16_t* Bt, int N, int K, int nsplit, const Epi& E, int rot = 0) {
    asm volatile("" : "+s"(K), "+s"(N), "+s"(nsplit));
    int gd_ = (int)gridDim.x, bi_ = (int)blockIdx.x; asm volatile("" : "+s"(gd_), "+s"(bi_));
    bi_ = (bi_ + gd_ - (rot % gd_)) % gd_;
    const int kloop = K / nsplit;
    pg8::Gemm g{A, Bt, MT, N, K, kloop}; CtxSplitOrder S{N / 256, nsplit, kloop, gd_, bi_};
    pg8::gemm_phase<Epi, CtxSplitOrder, true, true>((PG8_LAS unsigned char*)lds, g, S, E);
}

struct NormRow { f32x4 v[4]; float s; };
struct NormPar { const float* src; float* cp; const float* part; const float* gv; const float* sc; const float* sh; bf16_t* orow; int nsl; };
__device__ __forceinline__ void norm_load(NormRow& R, const NormPar& P, int lane) {
    const f32x4* xr = (const f32x4*)P.src + lane; R.s = 0.f;
#pragma unroll
    for (int j = 0; j < 4; ++j) { R.v[j] = xr[64 * j];
        if (P.part) { f32x4 a = (f32x4){0.f, 0.f, 0.f, 0.f};
            for (int q = 0; q < P.nsl; ++q) a = a + ((const f32x4*)(P.part + (size_t)q * 512 * 1024))[64 * j + lane];
            R.v[j] = R.v[j] + ((const f32x4*)P.gv)[64 * j + lane] * a; }
        R.s += (R.v[j][0] * R.v[j][0] + R.v[j][1] * R.v[j][1]) + (R.v[j][2] * R.v[j][2] + R.v[j][3] * R.v[j][3]); }
}
__device__ __forceinline__ void norm_finish(const NormRow& R, const NormPar& P, const float* nw, int lane) {
    if (P.cp) {
#pragma unroll
        for (int j = 0; j < 4; ++j) ((f32x4*)P.cp)[64 * j + lane] = R.v[j];
    }
    const float rstd = rsqrtf(wave_sum(R.s) * (1.f / 1024.f) + EPS);
#pragma unroll
    for (int j = 0; j < 4; ++j) {
        const int idx = 64 * j + lane;
        const f32x4 w = ((const f32x4*)nw)[idx], a = ((const f32x4*)P.sc)[idx], bsh = ((const f32x4*)P.sh)[idx];
        const float y0 = R.v[j][0] * rstd * w[0] * (1.f + a[0]) + bsh[0], y1 = R.v[j][1] * rstd * w[1] * (1.f + a[1]) + bsh[1];
        const float y2 = R.v[j][2] * rstd * w[2] * (1.f + a[2]) + bsh[2], y3 = R.v[j][3] * rstd * w[3] * (1.f + a[3]) + bsh[3];
        u32x2 o; o.x = pk2(y0, y1); o.y = pk2(y2, y3);
        ((u32x2*)P.orow)[idx] = o;
    }
}

#define ATT_THR 4.0f
template <int DQK, bool MASK, int NQ>
__device__ __forceinline__ void attn_unit(unsigned char* lds, const bf16_t* Qg, int ldq, const bf16_t* Kg, int ldk, const bf16_t* Vtg, bf16_t* Og, int ldo,
                                          int qi0, int a0, int n1, int b0, int n2, float m0, bool sink) {
    constexpr int KCH = DQK / 8, KBYTES = KCH * 1024, VP = 72, VBYTES = 64 * VP * 2, NC = DQK / 32, WR = 16 * NQ;
    constexpr int KOFF = 0, VOFF = 2 * KBYTES;
    int tid_ = threadIdx.x; asm volatile("" : "+v"(tid_));
    const int tid = tid_, lane = tid & 63, wid = tid >> 6, ql = lane & 15, g = lane >> 4;
    const int qw0 = qi0 + wid * WR;
    bf16x8 qf[NQ][NC];
#pragma unroll
    for (int qb = 0; qb < NQ; ++qb)
#pragma unroll
        for (int c = 0; c < NC; ++c) qf[qb][c] = *(const bf16x8*)(Qg + (size_t)(qw0 + qb * 16 + ql) * ldq + c * 32 + g * 8);
    f32x4 o[4][NQ];
#pragma unroll
    for (int eb = 0; eb < 4; ++eb)
#pragma unroll
        for (int qb = 0; qb < NQ; ++qb) o[eb][qb] = (f32x4){0.f, 0.f, 0.f, 0.f};
    float mrow[NQ]; f32x4 negm[NQ], ol[NQ];
#pragma unroll
    for (int qb = 0; qb < NQ; ++qb) { mrow[qb] = sink ? m0 : 0.f; const float l0 = sink ? 1.f : 0.f; ol[qb] = (f32x4){l0, l0, l0, l0}; negm[qb] = (f32x4){-mrow[qb], -mrow[qb], -mrow[qb], -mrow[qb]}; }
    const bf16x8 ones = (bf16x8){0x3F80, 0x3F80, 0x3F80, 0x3F80, 0x3F80, 0x3F80, 0x3F80, 0x3F80};
    bool first = !sink;
    int nt = n1 + n2; asm volatile("" : "+s"(nt));
    const int kr0 = tid & 63, kc0 = tid >> 6;
    const int ci1 = tid + 512, kr1 = ci1 & 63, kc1 = ci1 >> 6;
    const bool has1 = (KCH * 64 > 512) && (ci1 < KCH * 64);
    const int ve = tid >> 3, vc = tid & 7;
    const int mA_ = 2 * vc, mB_ = 2 * vc + 1;
    const int voffA = ((mA_ >> 3) * 4 + (mA_ & 3)) * 16 + ((mA_ & 7) >> 2) * 8, voffB = ((mB_ >> 3) * 4 + (mB_ & 3)) * 16 + ((mB_ & 7) >> 2) * 8;
    u32x4 kreg0, kreg1 = (u32x4){0u, 0u, 0u, 0u}, vreg;
#define ATT_TILE(tt) (((tt) < n1) ? (a0 + (tt)) : (b0 + (tt) - n1))
#define ATT_SKIP(kt) (MASK && ((kt) >= 4) && (((kt) * 64 > qw0 + (WR - 1) + 128) || ((kt) * 64 + 63 < qw0 - 128)))
#define ATT_ISSUE(kt) do { kreg0 = *(const u32x4*)(Kg + (size_t)((kt) * 64 + kr0) * ldk + kc0 * 8); \
        if (has1) kreg1 = *(const u32x4*)(Kg + (size_t)((kt) * 64 + kr1) * ldk + kc1 * 8); \
        vreg = *(const u32x4*)(Vtg + (size_t)ve * TB + (kt) * 64 + vc * 8); } while (0)
#define ATT_COMMIT(buf) do { unsigned char* kb_ = lds + KOFF + (buf) * KBYTES; *(u32x4*)(kb_ + kc0 * 1024 + kr0 * 16) = kreg0; \
        if (has1) *(u32x4*)(kb_ + kc1 * 1024 + kr1 * 16) = kreg1; \
        { unsigned char* vrow_ = lds + VOFF + (buf) * VBYTES + ve * (VP * 2); \
          *(u32x2*)(vrow_ + voffA) = (u32x2){vreg.x, vreg.y}; *(u32x2*)(vrow_ + voffB) = (u32x2){vreg.z, vreg.w}; } } while (0)
    { const int kt0 = ATT_TILE(0); ATT_ISSUE(kt0); ATT_COMMIT(0); }
    __syncthreads();
#pragma unroll 1
    for (int tt = 0; tt < nt; ++tt) {
        const int kt = ATT_TILE(tt);
        if (tt + 1 < nt) { const int ktn = ATT_TILE(tt + 1); ATT_ISSUE(ktn); }
        if (!ATT_SKIP(kt)) {
#pragma unroll 1
          for (int hb = 0; hb < 2; ++hb) {
            f32x4 sc[2][NQ];
            { const unsigned char* kb_ = lds + KOFF + (tt & 1) * KBYTES + hb * 512 + g * 1024 + ql * 16;
              __builtin_amdgcn_s_setprio(1);
#pragma unroll
              for (int k2 = 0; k2 < 2; ++k2) {
#pragma unroll
                  for (int c = 0; c < NC; ++c) {
                      const bf16x8 kf = *(const bf16x8*)(kb_ + c * 4096 + k2 * 256);
#pragma unroll
                      for (int qb = 0; qb < NQ; ++qb) sc[k2][qb] = __builtin_amdgcn_mfma_f32_16x16x32_bf16(kf, qf[qb][c], c == 0 ? negm[qb] : sc[k2][qb], 0, 0, 0);
                  } }
              __builtin_amdgcn_s_setprio(0); }
            if (MASK) { if (kt >= 4) { int dl = kt * 64 + hb * 32 + g * 4 - qw0 - ql; asm volatile("" : "+v"(dl));
#pragma unroll
                for (int k2 = 0; k2 < 2; ++k2)
#pragma unroll
                    for (int qb = 0; qb < NQ; ++qb)
#pragma unroll
                        for (int j = 0; j < 4; ++j) { const int d = dl + (k2 * 16 + j - qb * 16); if (d > 128 || d < -128) sc[k2][qb][j] = -1e30f; } } }
            float am = fmaxf(fmaxf(sc[0][0][0], sc[0][0][1]), sc[0][0][2]); am = fmaxf(fmaxf(am, sc[0][0][3]), sc[1][0][0]); am = fmaxf(fmaxf(am, sc[1][0][1]), sc[1][0][2]); am = fmaxf(am, sc[1][0][3]);
#pragma unroll
            for (int qb = 1; qb < NQ; ++qb) { am = fmaxf(fmaxf(am, sc[0][qb][0]), sc[0][qb][1]); am = fmaxf(fmaxf(am, sc[0][qb][2]), sc[0][qb][3]);
                am = fmaxf(fmaxf(am, sc[1][qb][0]), sc[1][qb][1]); am = fmaxf(fmaxf(am, sc[1][qb][2]), sc[1][qb][3]); }
            if (__any(first || (am > ATT_THR))) {
#pragma unroll
                for (int qb = 0; qb < NQ; ++qb) {
                    float a = fmaxf(fmaxf(sc[0][qb][0], sc[0][qb][1]), sc[0][qb][2]);
                    a = fmaxf(fmaxf(a, sc[0][qb][3]), sc[1][qb][0]); a = fmaxf(fmaxf(a, sc[1][qb][1]), sc[1][qb][2]); a = fmaxf(a, sc[1][qb][3]);
                    { auto r16 = __builtin_amdgcn_permlane16_swap(__float_as_uint(a), __float_as_uint(a), false, false); a = fmaxf(__uint_as_float(r16[0]), __uint_as_float(r16[1])); }
                    { auto r32 = __builtin_amdgcn_permlane32_swap(__float_as_uint(a), __float_as_uint(a), false, false); a = fmaxf(__uint_as_float(r32[0]), __uint_as_float(r32[1])); }
                    const float dlt = first ? a : fmaxf(a, 0.f);
                    mrow[qb] += dlt; negm[qb] = (f32x4){-mrow[qb], -mrow[qb], -mrow[qb], -mrow[qb]};
                    sc[0][qb] = sc[0][qb] - dlt; sc[1][qb] = sc[1][qb] - dlt;
                    if (!first) { const float alpha = __builtin_amdgcn_exp2f(-dlt); ol[qb] = ol[qb] * alpha;
#pragma unroll
                        for (int eb = 0; eb < 4; ++eb) o[eb][qb] = o[eb][qb] * alpha; } }
                first = false; }
            bf16x8 pf[NQ];
#pragma unroll
            for (int qb = 0; qb < NQ; ++qb) {
#pragma unroll
                for (int k2 = 0; k2 < 2; ++k2)
#pragma unroll
                    for (int j = 0; j < 4; ++j) sc[k2][qb][j] = __builtin_amdgcn_exp2f(sc[k2][qb][j]);
                u32x4 w; w.x = pk2(sc[0][qb][0], sc[0][qb][1]); w.y = pk2(sc[0][qb][2], sc[0][qb][3]); w.z = pk2(sc[1][qb][0], sc[1][qb][1]); w.w = pk2(sc[1][qb][2], sc[1][qb][3]);
                pf[qb] = __builtin_bit_cast(bf16x8, w); }
            { const unsigned char* vb_ = lds + VOFF + (tt & 1) * VBYTES + (hb * 4 + g) * 16;
#pragma unroll
              for (int eb = 0; eb < 4; ++eb) {
                  const bf16x8 vf = *(const bf16x8*)(vb_ + (eb * 16 + ql) * (VP * 2));
#pragma unroll
                  for (int qb = 0; qb < NQ; ++qb) o[eb][qb] = __builtin_amdgcn_mfma_f32_16x16x32_bf16(vf, pf[qb], o[eb][qb], 0, 0, 0);
              }
#pragma unroll
              for (int qb = 0; qb < NQ; ++qb) ol[qb] = __builtin_amdgcn_mfma_f32_16x16x32_bf16(ones, pf[qb], ol[qb], 0, 0, 0); }
          }
        }
        if (tt + 1 < nt) ATT_COMMIT((tt + 1) & 1);
        __syncthreads();
    }
#undef ATT_TILE
#undef ATT_SKIP
#undef ATT_ISSUE
#undef ATT_COMMIT
#pragma unroll
    for (int qb = 0; qb < NQ; ++qb) {
        const float inv = 1.f / ol[qb][0];
        bf16_t* op = Og + (size_t)(qw0 + qb * 16 + ql) * ldo + g * 4;
        if (Og)
#pragma unroll
        for (int eb = 0; eb < 4; ++eb) { u32x2 w; w.x = pk2(o[eb][qb][0] * inv, o[eb][qb][1] * inv); w.y = pk2(o[eb][qb][2] * inv, o[eb][qb][3] * inv); *(u32x2*)(op + eb * 16) = w; }
    }
}

constexpr int GL_BS = 0;
constexpr int GL_TOT = GL_BS + 64 * 65 * 4;
constexpr int GL_QE = GL_TOT + 8 * 64 * 4;
constexpr int GL_KE = GL_QE + 64 * 72 * 2;
constexpr int GL_ATT = GL_KE + 64 * 72 * 2;
constexpr int GL_VT = GL_ATT + 64 * 72 * 2;
constexpr int GL_O = GL_VT + 128 * 72 * 2;
constexpr int GL_END = GL_O + 64 * 132 * 4;
static_assert(GL_END <= 131072 && (GL_QE % 16) == 0 && (GL_VT % 16) == 0 && (GL_O % 16) == 0, "GLA LDS map");

__device__ __forceinline__ void gla_decay(unsigned char* lds, const float* glow_t0, const float* Wg  , const float* bg  , int dir) {
    float* Bs = (float*)(lds + GL_BS); float* Tot = (float*)(lds + GL_TOT); float* GLs = (float*)(lds + GL_O);
    int tid_ = threadIdx.x; asm volatile("" : "+v"(tid_)); const int tid = tid_;
    { const int s = tid >> 3, q = tid & 7;
      const float* gp = glow_t0 + (size_t)s * 32 + dir * 16 + q * 2;
      GLs[s * 16 + q * 2] = gp[0]; GLs[s * 16 + q * 2 + 1] = gp[1]; }
    const int d = tid & 63, seg = tid >> 6;
    float w[16];
#pragma unroll
    for (int r = 0; r < 16; ++r) w[r] = Wg[r * 256 + d];
    const float bias = bg[d];
    __syncthreads();
    float loc[8];
#pragma unroll
    for (int k = 0; k < 8; ++k) { const float* gl = GLs + (seg * 8 + k) * 16; float a = bias;
#pragma unroll
        for (int r = 0; r < 16; ++r) a += gl[r] * w[r];
        loc[k] = (fminf(a, 0.f) - __logf(1.f + __expf(-fabsf(a)))) * (1.f / 16.f); }
    float run = 0.f;
    if (dir == 0) {
#pragma unroll
        for (int k = 0; k < 8; ++k) { run += loc[k]; loc[k] = run; }
    } else {
#pragma unroll
        for (int k = 7; k >= 0; --k) { run += loc[k]; loc[k] = run; }
    }
    Tot[seg * 64 + d] = run;
    __syncthreads();
    float off = 0.f;
#pragma unroll
    for (int sg = 0; sg < 8; ++sg) { const float tv = Tot[sg * 64 + d]; if (dir == 0 ? (sg < seg) : (sg > seg)) off += tv; }
#pragma unroll
    for (int k = 0; k < 8; ++k) Bs[(seg * 8 + k) * 65 + d] = loc[k] + off;
    __syncthreads();
}
__device__ __forceinline__ void gla_load_vt(unsigned char* lds, const bf16_t* cv_t0  ) {
    bf16_t* Vt = (bf16_t*)(lds + GL_VT);
    int tid_ = threadIdx.x; asm volatile("" : "+v"(tid_)); const int tid = tid_;
#pragma unroll
    for (int r = 0; r < 2; ++r) { const int ci = tid + 512 * r, s = ci & 63, eg = ci >> 6;
        const u32x4 w = *(const u32x4*)(cv_t0 + (size_t)s * 512 + eg * 8);
        bf16_t* dst = Vt + (eg * 8) * 72 + s;
        dst[0 * 72] = (bf16_t)(w.x & 0xffffu); dst[1 * 72] = (bf16_t)(w.x >> 16); dst[2 * 72] = (bf16_t)(w.y & 0xffffu); dst[3 * 72] = (bf16_t)(w.y >> 16);
        dst[4 * 72] = (bf16_t)(w.z & 0xffffu); dst[5 * 72] = (bf16_t)(w.z >> 16); dst[6 * 72] = (bf16_t)(w.w & 0xffffu); dst[7 * 72] = (bf16_t)(w.w >> 16); }
}
__device__ __forceinline__ int gla_ord(int dir, int k) { return dir == 0 ? k : (k < 4 ? 3 - k : 135 - k); }

__device__ __forceinline__ void gla_state_item(unsigned char* lds, unsigned char* ws, const float* wgate, const float* bgate, int l, int item) {
    const int c = item % 132, dir = (item / 132) & 1, h = (item / 264) & 3, b = item / 1056;
    const int t0 = b * TB + c * 64;
    int tid_ = threadIdx.x; asm volatile("" : "+v"(tid_));
    const int tid = tid_, lane = tid & 63, wid = tid >> 6, ql = lane & 15, g = lane >> 4;
    const u32x4 kraw = *(const u32x4*)((const bf16_t*)(ws + O_CK) + (size_t)(t0 + (tid & 63)) * 256 + h * 64 + (tid >> 6) * 8);
    gla_load_vt(lds, (const bf16_t*)(ws + O_CV) + (size_t)t0 * 512 + h * 128);
    gla_decay(lds, (const float*)(ws + O_GLOW) + (size_t)t0 * 32, wgate + (size_t)((l * 2 + dir) * 16) * 256 + h * 64, bgate + (l * 2 + dir) * 256 + h * 64, dir);
    const float* Bs = (const float*)(lds + GL_BS); bf16_t* KDt = (bf16_t*)(lds + GL_KE);
    const int iend = dir == 0 ? 63 : 0;
    { const int s = tid & 63, dg = tid >> 6;
      float kv[8]; unpack8(kraw, kv);
#pragma unroll
      for (int e = 0; e < 8; ++e) { const int d = dg * 8 + e; KDt[d * 72 + s] = (bf16_t)f2bf(kv[e] * __expf(Bs[iend * 65 + d] - Bs[s * 65 + d])); } }
    if (tid < 64) ((float*)(ws + O_GD))[(size_t)item * 64 + tid] = __expf(Bs[iend * 65 + tid]);
    __syncthreads();
    const bf16_t* Vt = (const bf16_t*)(lds + GL_VT);
    f32x4 acc[4];
#pragma unroll
    for (int cb = 0; cb < 4; ++cb) acc[cb] = (f32x4){0.f, 0.f, 0.f, 0.f};
#pragma unroll
    for (int kk = 0; kk < 2; ++kk) {
        const bf16x8 a = *(const bf16x8*)(Vt + (wid * 16 + ql) * 72 + kk * 32 + g * 8);
#pragma unroll
        for (int cb = 0; cb < 4; ++cb) { const bf16x8 bb = *(const bf16x8*)(KDt + (cb * 16 + ql) * 72 + kk * 32 + g * 8); acc[cb] = __builtin_amdgcn_mfma_f32_16x16x32_bf16(a, bb, acc[cb], 0, 0, 0); }
    }
    bf16_t* st = (bf16_t*)(ws + O_ST) + (size_t)item * 8192;
#pragma unroll
    for (int cb = 0; cb < 4; ++cb)
#pragma unroll
        for (int j = 0; j < 4; ++j) st[(wid * 16 + g * 4 + j) * 64 + cb * 16 + ql] = (bf16_t)f2bf(acc[cb][j]);
    __syncthreads();
}

__device__ __forceinline__ void gla_scan(unsigned char* ws, int bid, int tid, int G) {
    bf16_t* ST = (bf16_t*)(ws + O_ST); const float* GD = (const float*)(ws + O_GD);
    for (int gidx = bid * NTHR + tid; gidx < 16 * 8192; gidx += G * NTHR) {
        const int seq = gidx >> 13, idx = gidx & 8191, d = idx & 63, dir = seq & 1;
        float s = 0.f;
        for (int k0 = 0; k0 < 132; k0 += 33) {
            float uv[33], dv[33];
#pragma unroll
            for (int u = 0; u < 33; ++u) { const int c = gla_ord(dir, k0 + u); uv[u] = bf2f(ST[(size_t)(seq * 132 + c) * 8192 + idx]); dv[u] = GD[(size_t)(seq * 132 + c) * 64 + d]; }
#pragma unroll
            for (int u = 0; u < 33; ++u) { const int c = gla_ord(dir, k0 + u); ST[(size_t)(seq * 132 + c) * 8192 + idx] = (bf16_t)f2bf(s); s = dv[u] * s + uv[u]; }
        }
    }
}

__device__ __forceinline__ void gla_out_item(unsigned char* lds, unsigned char* ws, const float* wgate, const float* bgate, const float* hnorm, int l, int item, bool dowrite = true) {
    const int c = item % 132, h = (item / 132) & 3, b = item / 528;
    const int t0 = b * TB + c * 64;
    int tid_ = threadIdx.x; asm volatile("" : "+v"(tid_));
    const int tid = tid_, lane = tid & 63, wid = tid >> 6, ql = lane & 15, g = lane >> 4;
    const float* Bs = (const float*)(lds + GL_BS);
    bf16_t* QE = (bf16_t*)(lds + GL_QE); bf16_t* KE = (bf16_t*)(lds + GL_KE); bf16_t* ATT = (bf16_t*)(lds + GL_ATT); const bf16_t* Vt = (const bf16_t*)(lds + GL_VT);
    const u32x4 qraw = *(const u32x4*)((const bf16_t*)(ws + O_CQ) + (size_t)(t0 + (tid >> 3)) * 256 + h * 64 + (tid & 7) * 8);
    const u32x4 kraw = *(const u32x4*)((const bf16_t*)(ws + O_CK) + (size_t)(t0 + (tid >> 3)) * 256 + h * 64 + (tid & 7) * 8);
    bf16x8 sfr[2][2];
#pragma unroll
    for (int dd = 0; dd < 2; ++dd)
#pragma unroll
        for (int kk = 0; kk < 2; ++kk) sfr[dd][kk] = *(const bf16x8*)((const bf16_t*)(ws + O_ST) + (size_t)(((b * 4 + h) * 2 + dd) * 132 + c) * 8192 + (wid * 16 + ql) * 64 + kk * 32 + g * 8);
    const u32x4 rraw0 = *(const u32x4*)((const bf16_t*)(ws + O_CR) + (size_t)(t0 + (tid >> 3)) * 512 + h * 128 + (tid & 7) * 16);
    const u32x4 rraw1 = *(const u32x4*)((const bf16_t*)(ws + O_CR) + (size_t)(t0 + (tid >> 3)) * 512 + h * 128 + (tid & 7) * 16 + 8);
    gla_load_vt(lds, (const bf16_t*)(ws + O_CV) + (size_t)t0 * 512 + h * 128);
    f32x4 oacc[4];
#pragma unroll
    for (int rb = 0; rb < 4; ++rb) oacc[rb] = (f32x4){0.f, 0.f, 0.f, 0.f};
    for (int dir = 0; dir < 2; ++dir) {
        gla_decay(lds, (const float*)(ws + O_GLOW) + (size_t)t0 * 32, wgate + (size_t)((l * 2 + dir) * 16) * 256 + h * 64, bgate + (l * 2 + dir) * 256 + h * 64, dir);
        { const int s = tid >> 3, dg = tid & 7;
          float qv[8], kv[8];
          unpack8(qraw, qv);
          unpack8(kraw, kv);
#pragma unroll
          for (int e = 0; e < 8; ++e) { const float bv = Bs[s * 65 + dg * 8 + e]; qv[e] *= __expf(bv); kv[e] *= __expf(-bv); }
          *(u32x4*)(QE + s * 72 + dg * 8) = pack8(qv); *(u32x4*)(KE + s * 72 + dg * 8) = pack8(kv); }
        __syncthreads();
        { const int rb = wid >> 1;
#pragma unroll
          for (int cc = 0; cc < 2; ++cc) { const int cb = (wid & 1) * 2 + cc; f32x4 a4 = (f32x4){0.f, 0.f, 0.f, 0.f};
#pragma unroll
              for (int kk = 0; kk < 2; ++kk) { const bf16x8 a = *(const bf16x8*)(QE + (rb * 16 + ql) * 72 + kk * 32 + g * 8); const bf16x8 bb = *(const bf16x8*)(KE + (cb * 16 + ql) * 72 + kk * 32 + g * 8);
                  a4 = __builtin_amdgcn_mfma_f32_16x16x32_bf16(a, bb, a4, 0, 0, 0); }
#pragma unroll
              for (int j = 0; j < 4; ++j) { const int i = rb * 16 + g * 4 + j, ip = cb * 16 + ql; const bool keep = dir == 0 ? (ip <= i) : (ip >= i); ATT[i * 72 + ip] = (bf16_t)f2bf(keep ? a4[j] : 0.f); } } }
        __syncthreads();
        { const int sidx = ((b * 4 + h) * 2 + dir) * 132 + c;
          const bf16_t* st = (const bf16_t*)(ws + O_ST) + (size_t)sidx * 8192;
#pragma unroll
          for (int kk = 0; kk < 2; ++kk) {
              const bf16x8 bv = *(const bf16x8*)(Vt + (wid * 16 + ql) * 72 + kk * 32 + g * 8);
              const bf16x8 bs = dir == 0 ? sfr[0][kk] : sfr[1][kk];
#pragma unroll
              for (int rb = 0; rb < 4; ++rb) {
                  const bf16x8 a1 = *(const bf16x8*)(ATT + (rb * 16 + ql) * 72 + kk * 32 + g * 8);
                  const bf16x8 a2 = *(const bf16x8*)(QE + (rb * 16 + ql) * 72 + kk * 32 + g * 8);
                  oacc[rb] = __builtin_amdgcn_mfma_f32_16x16x32_bf16(a1, bv, oacc[rb], 0, 0, 0);
                  oacc[rb] = __builtin_amdgcn_mfma_f32_16x16x32_bf16(a2, bs, oacc[rb], 0, 0, 0);
              } } }
        __syncthreads();
    }
    float* Os = (float*)(lds + GL_O);
#pragma unroll
    for (int rb = 0; rb < 4; ++rb)
#pragma unroll
        for (int j = 0; j < 4; ++j) Os[(rb * 16 + g * 4 + j) * 132 + wid * 16 + ql] = oacc[rb][j];
    __syncthreads();
    { const int i = tid >> 3, eg = tid & 7;
      float ov[16]; float ss = 0.f;
#pragma unroll
      for (int e = 0; e < 16; ++e) { ov[e] = Os[i * 132 + eg * 16 + e]; ss += ov[e] * ov[e]; }
      ss += __shfl_xor(ss, 1); ss += __shfl_xor(ss, 2); ss += __shfl_xor(ss, 4);
      const float rstd = rsqrtf(ss * (1.f / 128.f) + EPS);
      const float* gn = hnorm + l * 512 + h * 128 + eg * 16;
      bf16_t* rp = (bf16_t*)(ws + O_CR) + (size_t)(t0 + i) * 512 + h * 128 + eg * 16;
#pragma unroll
      for (int hh = 0; hh < 2; ++hh) { float rv[8]; unpack8(hh == 0 ? rraw0 : rraw1, rv);
#pragma unroll
          for (int e = 0; e < 8; ++e) rv[e] = ov[hh * 8 + e] * rstd * gn[hh * 8 + e] * siluf_(rv[e]);
          if (dowrite) *(u32x4*)(rp + hh * 8) = pack8(rv); } }
    __syncthreads();
}

#ifndef REPK
#define REPK 0
#endif
#ifndef REP_SYNC
#define REP_SYNC 0
#endif
#ifndef ASEL
#define ASEL 31
#endif
#ifndef PM
#define PM 0xffff
#endif
#define ON(k) (((PM) >> (k)) & 1)
typedef const __attribute__((address_space(4))) Args* CArgsP;
__global__ void __launch_bounds__(NTHR, 2) mk_fwd(Args args) {
    extern __shared__ __attribute__((aligned(16))) unsigned char lds[];
    cg::grid_group grid = cg::this_grid();
    volatile LASX unsigned* misc = (volatile LASX unsigned*)((LASX unsigned char*)lds + 131072 + 512);
    if (threadIdx.x < 16) misc[threadIdx.x] = 0u;
    __syncthreads();
    XcdBarrier xbar = xcd_barrier_post((unsigned*)(args.ws + O_BAR), misc + 8);
    if (args.ph_hi < 0) grid.sync();
    int rep = 0;
    for (int ph = args.ph_lo; ph < args.ph_hi; ) {
        int tid_k = threadIdx.x; asm volatile("" : "+v"(tid_k));
        const int tid = tid_k, lane = tid & 63, wid = __builtin_amdgcn_readfirstlane(tid >> 6);
        int G_k = gridDim.x, bid_k = blockIdx.x; asm volatile("" : "+s"(G_k), "+s"(bid_k));
        const int G = G_k, bid = bid_k, gw = bid * NWAVES + wid, NGW = G * NWAVES;
        CArgsP ap = (CArgsP)__builtin_amdgcn_kernarg_segment_ptr(); asm volatile("" : "+s"(ap));
        unsigned char* ws = ap->ws;
        float* MOD = (float*)(ws + O_MOD); float* X = (float*)(ws + O_X); bf16_t* HM = (bf16_t*)(ws + O_HM);
        if (ON(11) && ph == 0) {
            float* sv = (float*)lds; float* red = sv + 3072;
            for (int item = bid; item < 4 * 48; item += G) {
                const int l = item / 48, n0 = (item % 48) * 128;
                for (int idx = tid; idx < 3072; idx += NTHR) { const int r = idx >> 10, k = idx & 1023; const float cv = (r < 2) ? ap->in[I_C][r * 1024 + k] : ap->in[I_CCTX][k]; sv[idx] = siluf_(cv); }
                __syncthreads();
                const int kq = tid >> 7, nn = tid & 127; float a0 = 0.f, a1 = 0.f, a2 = 0.f;
                const float* wp = ap->in[I_WMOD] + ((size_t)l * 1024 + kq * 256) * 6144 + n0 + nn;
#pragma unroll 32
                for (int k = 0; k < 256; ++k) { const float w = wp[(size_t)k * 6144]; a0 += sv[kq * 256 + k] * w; a1 += sv[1024 + kq * 256 + k] * w; a2 += sv[2048 + kq * 256 + k] * w; }
                red[(kq * 3 + 0) * 128 + nn] = a0; red[(kq * 3 + 1) * 128 + nn] = a1; red[(kq * 3 + 2) * 128 + nn] = a2;
                __syncthreads();
                if (tid < 384) { const int r = tid >> 7, n2 = tid & 127; float a = ap->in[I_BMOD][l * 6144 + n0 + n2];
                    for (int q = 0; q < 4; ++q) a += red[(q * 3 + r) * 128 + n2];
                    MOD[(l * 3 + r) * 6144 + n0 + n2] = a; }
                __syncthreads();
            }
            float* RA = (float*)(ws + O_ROPEA); float* RB = (float*)(ws + O_ROPEB);
            for (int idx = bid * NTHR + tid; idx < 8192 * 32; idx += G * NTHR) { const int pos = idx >> 5, j = idx & 31;
                const float inv = exp2f(-(float)(j & 15) * (13.287712379549449f / 16.f)); const float p = (j < 16) ? (float)(pos >> 6) : (float)(pos & 63); const float ang = p * inv;
                RA[pos * 64 + j] = __cosf(ang); RA[pos * 64 + 32 + j] = __sinf(ang); }
            for (int idx = bid * NTHR + tid; idx < 8192 * 16; idx += G * NTHR) { const int pos = idx >> 4, j = idx & 15;
                const float inv = exp2f(-(float)(j & 7) * (13.287712379549449f / 8.f)); const float p = (j < 8) ? (float)(pos >> 6) : (float)(pos & 63); const float ang = p * inv;
                RB[pos * 32 + j] = __cosf(ang); RB[pos * 32 + 16 + j] = __sinf(ang); }
        } else if (ON(12) && ph == 45) {
            for (int r = gw; r < NB * SEQ; r += NGW) { const int b = r >> 13, s = r & 8191;
                const f32x4* xr = (const f32x4*)(X + (size_t)(b * TB + LC + s) * 1024) + lane; f32x4 v[4]; float ss = 0.f;
#pragma unroll
                for (int j = 0; j < 4; ++j) { v[j] = xr[64 * j]; ss += (v[j][0] * v[j][0] + v[j][1] * v[j][1]) + (v[j][2] * v[j][2] + v[j][3] * v[j][3]); }
                const float rstd = rsqrtf(wave_sum(ss) * (1.f / 1024.f) + EPS);
#pragma unroll
                for (int j = 0; j < 4; ++j) { const f32x4 w = ((const f32x4*)ap->in[I_FNORM])[64 * j + lane]; f32x4 o; o[0] = v[j][0] * rstd * w[0]; o[1] = v[j][1] * rstd * w[1]; o[2] = v[j][2] * rstd * w[2]; o[3] = v[j][3] * rstd * w[3];
                    ((f32x4*)(ap->out + (size_t)r * 1024))[64 * j + lane] = o; } }
        } else {
            const int l = (ph - 1) / 11, k = (ph - 1) % 11;
            const float* modl = MOD + l * 3 * 6144;
            if (ON(0) && k == 0) {
                float* scr = (float*)lds + wid * (64 * 33);
                constexpr int I0 = 184 * 16, I1 = I0 + 24 * 4, I2 = I1 + 32 * 4, I3 = I2 + 3 * 32 * 8, I4 = I3 + 32 * 16, I5 = I4 + 176 * 16, I6 = I5 + 32 * 44;
                for (int it = gw; it < I6; it += NGW) {
                    if (it < I0) transpose_item(ap->in[I_WIN] + (size_t)l * 1024 * IN_DIM, 1024, IN_DIM, (bf16_t*)(ws + O_WIN), 1024, it, MAT_IN, nullptr, scr, lane);
                    else if (it < I1) transpose_item(ap->in[I_WUQ] + (size_t)l * 256 * 768, 256, 768, (bf16_t*)(ws + O_WUQ), 256, it - I0, MAT_UQ, ap->in[I_QNORM] + l * 256, scr, lane);
                    else if (it < I2) transpose_item(ap->in[I_WUKV] + (size_t)l * 128 * 1024, 128, 1024, (bf16_t*)(ws + O_WUKV), 256, it - I1, MAT_PLAIN, ap->in[I_KVNORM] + l * 128, scr, lane);
                    else if (it < I3) { const int r = it - I2, br = r / 256; const float* src = (br == 0 ? ap->in[I_WBRA] : (br == 1 ? ap->in[I_WBRB] : ap->in[I_WBRC])) + (size_t)l * 512 * 1024;
                        transpose_item(src, 512, 1024, (bf16_t*)(ws + O_WBR) + (size_t)br * 1024 * 512, 512, r - br * 256, MAT_PLAIN, nullptr, scr, lane); }
                    else if (it < I4) transpose_item(ap->in[I_WOUT] + (size_t)l * 1024 * 1024, 1024, 1024, (bf16_t*)(ws + O_WOUT), 1024, it - I3, MAT_PLAIN, nullptr, scr, lane);
                    else if (it < I5) transpose_item(ap->in[I_WUP] + (size_t)l * 1024 * FF2, 1024, FF2, (bf16_t*)(ws + O_WUP), 1024, it - I4, MAT_PLAIN, nullptr, scr, lane);
                    else transpose_item(ap->in[I_WDOWN] + (size_t)l * FF * 1024, FF, 1024, (bf16_t*)(ws + O_WDOWN), FF, it - I5, MAT_PLAIN, nullptr, scr, lane);
                }
                for (int idx = bid * NTHR + tid; idx < MT * 2; idx += G * NTHR) ((float*)(ws + O_SSQ))[idx] = 0.f;
#define NORM1_PAR(P, t) do { const int b = ((t) >= TB) ? 1 : 0, i = (t) - b * TB, r = (i >= LC) ? b : 2; \
                    P.src = X + (size_t)(t) * 1024; P.cp = nullptr; P.part = nullptr; P.gv = nullptr; P.nsl = 11; \
                    if (l == 0) { P.src = (i >= LC) ? ap->in[I_X] + ((size_t)b * SEQ + (i - LC)) * 1024 : ap->in[I_CTX] + ((size_t)b * LC + i) * 1024; P.cp = X + (size_t)(t) * 1024; } \
                    if (l > 0 && i < LC) { P.part = (const float*)(ws + O_U) + (size_t)(b * 256 + i) * 1024; P.gv = MOD + ((l - 1) * 3 + 2) * 6144 + 5120; P.cp = X + (size_t)(t) * 1024; } \
                    P.sc = modl + r * 6144 + 1024; P.sh = modl + r * 6144; P.orow = HM + (size_t)(t) * 1024; } while (0)
                for (int t = gw; t < MT; t += 2 * NGW) {
                    const int tB = t + NGW; const bool hb = tB < MT;
                    const int tBc = hb ? tB : t;
                    NormPar PA, PB; NormRow RA, RB; NORM1_PAR(PA, t); NORM1_PAR(PB, tBc);
                    norm_load(RA, PA, lane); norm_load(RB, PB, lane);
                    norm_finish(RA, PA, ap->in[I_NMIX] + l * 1024, lane); if (hb) norm_finish(RB, PB, ap->in[I_NMIX] + l * 1024, lane);
                }
#undef NORM1_PAR
            } else if (ON(1) && k == 1) {
                EpiIn E{ws}; run_gemm(lds, HM, (const bf16_t*)(ws + O_WIN), MT, NPIN, 1024, E);
            } else if (ON(2) && k == 2) {
                if (ON(13)) { EpiUq E{ws}; run_gemm(lds, (const bf16_t*)(ws + O_CQB), (const bf16_t*)(ws + O_WUQ), MT, 768, 256, E); }
                if (ON(14)) { EpiUkv E{ws}; run_gemm(lds, (const bf16_t*)(ws + O_CKVB), (const bf16_t*)(ws + O_WUKV), MT, 1024, 256, E); }
                if (ON(15)) for (int item = bid; item < 2112; item += G) gla_state_item(lds, ws, ap->in[I_WGATE], ap->in[I_BGATE], l, item);
            } else if (ON(3) && k == 3) {
                if ((ASEL & 16) && rep == 0) gla_scan(ws, bid, tid, G);
                for (int L = bid; L < (rep == 0 ? 544 : 256); L += G) {
                    const int npass = (PROBE_AA && L >= 256 && L < 768) ? 2 : 1;
                    for (int pass = 0; pass < npass; ++pass) {
                    if ((ASEL & 1) && L < 256) { const int bh_ = (L & 7) + 8 * ((L >> 3) & 1), b = bh_ >> 3, h = bh_ & 7, qs = L >> 4;
                        attn_unit<96, false, 4>(lds, (const bf16_t*)(ws + O_QB) + (size_t)b * TB * 768 + h * 96, 768, (const bf16_t*)(ws + O_KB) + (size_t)b * TB * 768 + h * 96, 768,
                                             (const bf16_t*)(ws + O_VBT) + (size_t)(b * 8 + h) * 64 * TB, (bf16_t*)(ws + O_YB) + (size_t)b * TB * 512 + h * 64, 512, LC + qs * 512, 0, 132, 0, 0, 0.f, false);
                    } else if ((ASEL & 2) && L >= 256 && L < 512) { const int L2 = L - 256, bh_ = (L2 & 7) + 8 * ((L2 >> 3) & 1), b = bh_ >> 3, h = bh_ & 7, qs = L2 >> 4, kvh = h >> 2;
                        const int p0 = qs * 512, lo = (p0 - 128 < 0) ? 0 : p0 - 128, hi = (p0 + 640 > SEQ) ? SEQ : p0 + 640;
                        bf16_t* qo = (bf16_t*)(ws + O_QA) + (size_t)b * TB * 512 + h * 64;
                        attn_unit<64, true, 4>(lds, qo, 512, (const bf16_t*)(ws + O_KA) + (size_t)b * TB * 128 + kvh * 64, 128, (const bf16_t*)(ws + O_VAT) + (size_t)(b * 2 + kvh) * 64 * TB,
                                            qo, 512, LC + p0, 0, 4, (lo + LC) / 64, (hi - lo) / 64, ap->in[I_SINK][l * 8 + h] * LOG2E, true);
                    } else if ((ASEL & 4) && L >= 512 && L < 528) { const int L2 = L - 512, b = L2 >> 3, h = L2 & 7;
                        attn_unit<96, false, 2>(lds, (const bf16_t*)(ws + O_QB) + (size_t)b * TB * 768 + h * 96, 768, (const bf16_t*)(ws + O_KB) + (size_t)b * TB * 768 + h * 96, 768,
                                             (const bf16_t*)(ws + O_VBT) + (size_t)(b * 8 + h) * 64 * TB, (bf16_t*)(ws + O_YB) + (size_t)b * TB * 512 + h * 64, 512, 0, 0, 4, 0, 0, 0.f, false);
                    } else if ((ASEL & 8) && L >= 528) { const int L2 = L - 528, b = L2 >> 3, h = L2 & 7, kvh = h >> 2;
                        bf16_t* qo = (bf16_t*)(ws + O_QA) + (size_t)b * TB * 512 + h * 64;
                        attn_unit<64, false, 2>(lds, qo, 512, (const bf16_t*)(ws + O_KA) + (size_t)b * TB * 128 + kvh * 64, 128, (const bf16_t*)(ws + O_VAT) + (size_t)(b * 2 + kvh) * 64 * TB,
                                             qo, 512, 0, 0, 4, 0, 0, ap->in[I_SINK][l * 8 + h] * LOG2E, true);
                    }
                    }
                }
            } else if (ON(4) && k == 4) {
                if (PROBE_GC) for (int item = bid; item < 1056; item += G) gla_out_item(lds, ws, ap->in[I_WGATE], ap->in[I_BGATE], ap->in[I_HNORM], l, item, false);
                for (int item = bid; item < 1056; item += G) gla_out_item(lds, ws, ap->in[I_WGATE], ap->in[I_BGATE], ap->in[I_HNORM], l, item);
            } else if (ON(5) && k == 5) {
                { EpiMerge<0> E{ws}; run_gemm_main(lds, (const bf16_t*)(ws + O_QA), (const bf16_t*)(ws + O_WBR), 1024, 512, E); }
                { EpiMerge<1> E{ws}; run_gemm_main(lds, (const bf16_t*)(ws + O_YB), (const bf16_t*)(ws + O_WBR) + (size_t)1024 * 512, 1024, 512, E); }
                { EpiMerge<2> E{ws}; run_gemm_main(lds, (const bf16_t*)(ws + O_CR), (const bf16_t*)(ws + O_WBR) + (size_t)2 * 1024 * 512, 1024, 512, E); }
                { EpiMergePart<0> E{ws, 256 * 2}; run_gemm_ctx(lds, (const bf16_t*)(ws + O_QA), (const bf16_t*)(ws + O_WBR), 1024, 512, 2, E, 64); }
                { EpiMergePart<1> E{ws, 256 * 2}; run_gemm_ctx(lds, (const bf16_t*)(ws + O_YB), (const bf16_t*)(ws + O_WBR) + (size_t)1024 * 512, 1024, 512, 2, E, 96); }
                { EpiMergePart<2> E{ws, 256 * 2}; run_gemm_ctx(lds, (const bf16_t*)(ws + O_CR), (const bf16_t*)(ws + O_WBR) + (size_t)2 * 1024 * 512, 1024, 512, 2, E, 128); }
            } else if (ON(6) && k == 6) {
                for (int r = gw; r < 512; r += NGW) { const int t = (r < 256) ? r : (TB + r - 256);
                    const f32x4* sp = (const f32x4*)((const float*)(ws + O_CQ) + (size_t)r * 1024);
#pragma unroll
                    for (int j = 0; j < 4; ++j) { f32x4 a = sp[64 * j + lane];
#pragma unroll
                        for (int q = 1; q < 6; ++q) a = a + sp[(size_t)q * 512 * 256 + 64 * j + lane];
                        u32x2 o; o.x = pk2(a[0], a[1]); o.y = pk2(a[2], a[3]); ((u32x2*)(HM + (size_t)t * 1024))[64 * j + lane] = o; } }
                xcd_barrier(xbar);
                if (PROBE_OD) { EpiNull E{(float*)(ws + O_SSQ)}; run_gemm_main(lds, HM, (const bf16_t*)(ws + O_WOUT), 1024, 1024, E); run_gemm_ctx(lds, HM, (const bf16_t*)(ws + O_WOUT), 1024, 1024, 4, E); }
                { EpiResid E{ws, modl, 2048}; run_gemm_main(lds, HM, (const bf16_t*)(ws + O_WOUT), 1024, 1024, E); }
                { EpiPartial E{(float*)(ws + O_GATES), 256 * 2}; run_gemm_ctx(lds, HM, (const bf16_t*)(ws + O_WOUT), 1024, 1024, 4, E); }
            } else if (ON(7) && k == 7) {
#define NORM2_PAR(P, t) do { const int b = ((t) >= TB) ? 1 : 0, i = (t) - b * TB, r = (i >= LC) ? b : 2; \
                    P.src = X + (size_t)(t) * 1024; P.cp = nullptr; P.part = nullptr; P.gv = nullptr; P.nsl = 4; \
                    if (i < LC) { P.part = (const float*)(ws + O_GATES) + (size_t)(b * 256 + i) * 1024; P.gv = modl + 2 * 6144 + 2048; P.cp = X + (size_t)(t) * 1024; } \
                    P.sc = modl + r * 6144 + 4096; P.sh = modl + r * 6144 + 3072; P.orow = HM + (size_t)(t) * 1024; } while (0)
                for (int t = gw; t < MT; t += 2 * NGW) {
                    const int tB = t + NGW; const bool hb = tB < MT;
                    const int tBc = hb ? tB : t;
                    NormPar PA, PB; NormRow RA, RB; NORM2_PAR(PA, t); NORM2_PAR(PB, tBc);
                    norm_load(RA, PA, lane); norm_load(RB, PB, lane);
                    norm_finish(RA, PA, ap->in[I_NFFN] + l * 1024, lane); if (hb) norm_finish(RB, PB, ap->in[I_NFFN] + l * 1024, lane);
                }
#undef NORM2_PAR
            } else if (ON(8) && k == 8) {
                EpiStore E{(bf16_t*)(ws + O_U), FF2}; run_gemm(lds, HM, (const bf16_t*)(ws + O_WUP), MT, FF2, 1024, E);
            } else if (ON(9) && k == 9) {
                const bf16_t* U = (const bf16_t*)(ws + O_U); bf16_t* ACT = (bf16_t*)(ws + O_ACT);
                const float* cw = ap->in[I_CONVW] + (size_t)l * 3 * FF2; const float* cb = ap->in[I_CONVB] + (size_t)l * FF2;
#pragma unroll 1
                for (int idx = bid * NTHR + tid; idx < (MT / 16) * 352; idx += G * NTHR) {
                    const int tb = idx / 352, j0 = (idx - tb * 352) * 8; const int t0 = tb * 16; const int b = (t0 >= TB) ? 1 : 0, i0 = t0 - b * TB;
                    float wg0[8], wg1[8], wg2[8], bg[8], wv0[8], wv1[8], wv2[8], bv[8];
#pragma unroll
                    for (int e = 0; e < 8; ++e) { wg0[e] = cw[j0 + e]; wg1[e] = cw[FF2 + j0 + e]; wg2[e] = cw[2 * FF2 + j0 + e]; bg[e] = cb[j0 + e];
                        wv0[e] = cw[FF + j0 + e]; wv1[e] = cw[FF2 + FF + j0 + e]; wv2[e] = cw[2 * FF2 + FF + j0 + e]; bv[e] = cb[FF + j0 + e]; }
                    const bf16_t* up = U + (size_t)t0 * FF2 + j0;
                    u32x4 gp_ = (u32x4){0u, 0u, 0u, 0u}, vp_ = (u32x4){0u, 0u, 0u, 0u};
                    if (i0 != 0 && i0 != LC) { gp_ = *(const u32x4*)(up - FF2); vp_ = *(const u32x4*)(up - FF2 + FF); }
                    u32x4 gc_ = *(const u32x4*)up, vc_ = *(const u32x4*)(up + FF);
#pragma unroll 4
                    for (int r = 0; r < 16; ++r) {
                        u32x4 gn_ = (u32x4){0u, 0u, 0u, 0u}, vn_ = (u32x4){0u, 0u, 0u, 0u};
                        const int ii = i0 + r;
                        if (ii != LC - 1 && ii != TB - 1) { gn_ = *(const u32x4*)(up + (size_t)(r + 1) * FF2); vn_ = *(const u32x4*)(up + (size_t)(r + 1) * FF2 + FF); }
                        float gm[8], gc[8], gn[8], vm[8], vc[8], vn[8], o[8];
                        unpack8(gp_, gm); unpack8(gc_, gc); unpack8(gn_, gn); unpack8(vp_, vm); unpack8(vc_, vc); unpack8(vn_, vn);
#pragma unroll
                        for (int e = 0; e < 8; ++e) {
                            const float a = wg0[e] * gm[e] + wg1[e] * gc[e] + wg2[e] * gn[e] + bg[e];
                            const float v = wv0[e] * vm[e] + wv1[e] * vc[e] + wv2[e] * vn[e] + bv[e];
                            o[e] = siluf_(a) * v;
                        }
                        *(u32x4*)(ACT + (size_t)(t0 + r) * FF + j0) = pack8(o);
                        gp_ = gc_; vp_ = vc_; gc_ = gn_; vc_ = vn_;
                    }
                }
            } else if (ON(10) && k == 10) {
                if (PROBE_OD) { EpiNull E{(float*)(ws + O_SSQ)}; run_gemm_main(lds, (const bf16_t*)(ws + O_ACT), (const bf16_t*)(ws + O_WDOWN), 1024, FF, E); run_gemm_ctx(lds, (const bf16_t*)(ws + O_ACT), (const bf16_t*)(ws + O_WDOWN), 1024, FF, 11, E); }
                { EpiResid E{ws, modl, 5120}; run_gemm_main(lds, (const bf16_t*)(ws + O_ACT), (const bf16_t*)(ws + O_WDOWN), 1024, FF, E); }
                { EpiPartial E{(float*)(ws + O_U), 256 * 2}; run_gemm_ctx(lds, (const bf16_t*)(ws + O_ACT), (const bf16_t*)(ws + O_WDOWN), 1024, FF, 11, E); }
            }
        }
        { const int kk_ = (ph >= 1 && ph <= 44) ? (ph - 1) % 11 : 15;
          const bool again = (rep == 0) && (((REPK) >> kk_) & 1);
          if (again) rep = 1; else { rep = 0; ++ph; }
          if (again || ph < args.ph_hi) { xcd_barrier(xbar); if (REP_SYNC) xcd_barrier(xbar); } }
    }
}

constexpr int N_PHASES = 46;
extern "C" void kernel_launch(void* const* d_in, const int* in_sizes, int n_in, void* d_out, int out_size, void* d_ws, size_t ws_size, hipStream_t stream) {
    static int grid = 0;
    if (grid == 0) {
        if (n_in != N_IN || ws_size < O_END) { fprintf(stderr, "kernel_launch: bad shapes: n_in %d ws %zu (need %zu)\n", n_in, ws_size, (size_t)O_END); grid = -1; return; }
        int dev = 0, cus = 0, per_cu = 0;
        hipGetDevice(&dev); hipDeviceGetAttribute(&cus, hipDeviceAttributeMultiprocessorCount, dev);
        if (hipFuncSetAttribute((const void*)mk_fwd, hipFuncAttributeMaxDynamicSharedMemorySize, LDS_BYTES) != hipSuccess) { fprintf(stderr, "kernel_launch: hipFuncSetAttribute failed\n"); grid = -1; return; }
        hipOccupancyMaxActiveBlocksPerMultiprocessor(&per_cu, (const void*)mk_fwd, NTHR, LDS_BYTES);
        (void)hipGetLastError();
        if (per_cu < 1) per_cu = 1;
        grid = cus * 1;
        fprintf(stderr, "kernel_launch: cus %d per_cu %d grid %d\n", cus, per_cu, grid);
    }
    if (grid < 0) return;
    if (hipMemsetAsync((char*)d_ws + O_BAR, 0, 16384, stream) != hipSuccess) { fprintf(stderr, "kernel_launch: memset failed\n"); return; }
    Args a{};
    for (int i = 0; i < N_IN; ++i) a.in[i] = (const float*)d_in[i];
    a.out = (float*)d_out; a.ws = (unsigned char*)d_ws;
#if ONE_LAUNCH
    a.ph_lo = 0; a.ph_hi = N_PHASES;
    void* kargs[] = {&a};
    hipError_t e = hipLaunchCooperativeKernel((const void*)mk_fwd, dim3(grid), dim3(NTHR), kargs, LDS_BYTES, stream);
    if (e != hipSuccess) fprintf(stderr, "cooperative launch failed: %s (grid %d)\n", hipGetErrorString(e), grid);
#else
    for (int ph = 0; ph < N_PHASES; ++ph) { a.ph_lo = ph; a.ph_hi = ph + 1; hipLaunchKernelGGL(mk_fwd, dim3(grid), dim3(NTHR), LDS_BYTES, stream, a); }
#endif
}
```
